# Optimizing an MI355X kernel written in HIP

```python
import math
import jax
import jax.numpy as jnp
from jax import lax
import numpy as np

D_MODEL = 2048
BATCH = 4
SEQ = 2048
DEPTH = 2


CHUNK = 64
Q_BLOCK = 128
N_MIXERS = 2
RMS_EPS = 1e-6
NEG_INF = -1e30

MLA_HEADS = 16
MLA_Q_RANK = 512
MLA_KV_RANK = 512
MLA_NOPE = 128
MLA_ROPE = 64
MLA_V = 128
MLA_QK = MLA_NOPE + MLA_ROPE
MLA_IN = MLA_Q_RANK + MLA_KV_RANK + MLA_ROPE
ROPE_THETA = 10000.0

FOX_HEADS = 16
FOX_HEAD_DIM = D_MODEL // FOX_HEADS
FOX_IN = 4 * D_MODEL + FOX_HEADS

PEER_HEADS = 8
PEER_N_KEYS = 128
PEER_N_EXPERTS = PEER_N_KEYS * PEER_N_KEYS
PEER_D_KEY = 256
PEER_D_HALF = PEER_D_KEY // 2
PEER_TOPK = 16
PEER_TOKEN_BLOCK = 128

kernel_name = 'hybrid_mla_fox_peer_streaming_encoder'


def rms_norm(x, g):
    xf = x.astype(jnp.float32)
    y = xf * lax.rsqrt(jnp.mean(xf * xf, axis=-1, keepdims=True) + RMS_EPS)
    return (y * g.astype(jnp.float32)).astype(x.dtype)


def rotate(x, cos, sin):
    x1, x2 = jnp.split(x, 2, axis=-1)
    return jnp.concatenate([x1 * cos - x2 * sin, x2 * cos + x1 * sin], axis=-1)


def blocked_attention(q, k, v, scale, chunk_causal, log_decay=None):
    seq = q.shape[1]
    outs = []
    for qb in range(seq // Q_BLOCK):
        q0 = qb * Q_BLOCK
        q1 = q0 + Q_BLOCK
        logits = jnp.einsum('bqhd,bkhd->bhqk', q[:, q0:q1], k[:, :q1]).astype(jnp.float32) * scale
        t = jnp.arange(q0, q1)[:, None]
        s = jnp.arange(q1)[None, :]
        if chunk_causal:
            allowed = (s // CHUNK) <= (t // CHUNK)
        else:
            allowed = s <= t
        if log_decay is not None:
            logits = logits + (log_decay[:, :, q0:q1, None] - log_decay[:, :, None, :q1])
        logits = jnp.where(allowed, logits, NEG_INF)
        p = jax.nn.softmax(logits, axis=-1).astype(v.dtype)
        outs.append(jnp.einsum('bhqk,bkhd->bqhd', p, v[:, :q1]))
    return jnp.concatenate(outs, axis=1)


def mla_mixer(h, cos, sin, w_in, g_qa, w_qb, g_kva, w_kvb, g_q, g_k, w_o):
    b, s, _ = h.shape
    z = h @ w_in
    c_q, c_kv, k_rope = jnp.split(z, [MLA_Q_RANK, MLA_Q_RANK + MLA_KV_RANK], axis=-1)
    q = (rms_norm(c_q, g_qa) @ w_qb).reshape(b, s, MLA_HEADS, MLA_QK)
    kv = (rms_norm(c_kv, g_kva) @ w_kvb).reshape(b, s, MLA_HEADS, MLA_NOPE + MLA_V)
    k_nope, v = jnp.split(kv, [MLA_NOPE], axis=-1)
    k_rope = jnp.broadcast_to(k_rope[:, :, None, :], (b, s, MLA_HEADS, MLA_ROPE))
    k = jnp.concatenate([k_nope, k_rope], axis=-1)
    q = rms_norm(q, g_q)
    k = rms_norm(k, g_k)
    q = jnp.concatenate([q[..., :MLA_NOPE], rotate(q[..., MLA_NOPE:], cos, sin)], axis=-1)
    k = jnp.concatenate([k[..., :MLA_NOPE], rotate(k[..., MLA_NOPE:], cos, sin)], axis=-1)
    o = blocked_attention(q, k, v, 1.0 / math.sqrt(MLA_QK), chunk_causal=True)
    return o.reshape(b, s, MLA_HEADS * MLA_V) @ w_o


def fox_mixer(h, w_in, b_f, g_q, g_k, w_o):
    b, s, _ = h.shape
    z = h @ w_in
    q, k, v, gate, f_logit = jnp.split(z, [D_MODEL, 2 * D_MODEL, 3 * D_MODEL, 4 * D_MODEL], axis=-1)
    q = rms_norm(q.reshape(b, s, FOX_HEADS, FOX_HEAD_DIM), g_q)
    k = rms_norm(k.reshape(b, s, FOX_HEADS, FOX_HEAD_DIM), g_k)
    v = v.reshape(b, s, FOX_HEADS, FOX_HEAD_DIM)
    log_f = jax.nn.log_sigmoid((f_logit + b_f).astype(jnp.float32))
    c = jnp.cumsum(log_f, axis=1).transpose(0, 2, 1)
    o = blocked_attention(q, k, v, 1.0 / math.sqrt(FOX_HEAD_DIM), chunk_causal=False, log_decay=c)
    o = o.reshape(b, s, D_MODEL) * jax.nn.sigmoid(gate)
    return o @ w_o


def peer_ffn(h, w_q, sub_keys, u, v):
    b, s, d = h.shape
    t = b * s
    x = h.reshape(t, d)
    q = (x @ w_q).reshape(t, PEER_HEADS, 2, PEER_D_HALF)
    scores = jnp.einsum('thcd,cnd->thcn', q, sub_keys).astype(jnp.float32)
    top_s, top_i = lax.top_k(scores, PEER_TOPK)
    cand_s = top_s[..., 0, :, None] + top_s[..., 1, None, :]
    cand_i = top_i[..., 0, :, None] * PEER_N_KEYS + top_i[..., 1, None, :]
    cand_s = cand_s.reshape(t, PEER_HEADS, PEER_TOPK * PEER_TOPK)
    cand_i = cand_i.reshape(t, PEER_HEADS, PEER_TOPK * PEER_TOPK)
    best_s, pos = lax.top_k(cand_s, PEER_TOPK)
    idx = jnp.take_along_axis(cand_i, pos, axis=-1)
    g = jax.nn.softmax(best_s, axis=-1).astype(h.dtype)
    n_sel = PEER_HEADS * PEER_TOPK
    n_blk = t // PEER_TOKEN_BLOCK
    xb = x.reshape(n_blk, PEER_TOKEN_BLOCK, d)
    ib = idx.reshape(n_blk, PEER_TOKEN_BLOCK, n_sel)
    gb = g.reshape(n_blk, PEER_TOKEN_BLOCK, n_sel)

    def one_block(args):
        x_blk, i_blk, g_blk = args
        u_sel = u[i_blk]
        a = jax.nn.gelu(jnp.einsum('tkd,td->tk', u_sel, x_blk), approximate=False) * g_blk
        return jnp.einsum('tk,tkd->td', a, v[i_blk])

    out = lax.map(one_block, (xb, ib, gb))
    return out.reshape(b, s, d)


def setup_inputs(seed: int = 0) -> dict:
    key = jax.random.key(seed)
    ks = jax.random.split(key, 24)
    f32 = jnp.float32
    n_a = (DEPTH + N_MIXERS - 1) // N_MIXERS
    n_b = DEPTH // N_MIXERS

    def nrm(k, shape, scale):
        return jax.random.normal(k, shape, f32) * scale

    def gain(k, shape):
        return 1.0 + 0.02 * jax.random.normal(k, shape, f32)

    x = jax.random.normal(ks[0], (BATCH, SEQ, D_MODEL), f32)
    start = jax.random.randint(ks[1], (BATCH, 1), 0, 8 * SEQ, dtype=jnp.int32)
    positions = (start + jnp.arange(SEQ, dtype=jnp.int32)[None, :]).astype(jnp.int32)
    fox_b_f = jnp.linspace(1.0, 6.0, FOX_HEADS, dtype=f32)[None, :] + 0.1 * jax.random.normal(ks[15], (n_b, FOX_HEADS), f32)
    return {
        'x': x,
        'positions': positions,
        'norm_mix_g': gain(ks[2], (DEPTH, D_MODEL)),
        'norm_ffn_g': gain(ks[3], (DEPTH, D_MODEL)),
        'mla_w_in': nrm(ks[4], (n_a, D_MODEL, MLA_IN), D_MODEL ** -0.5),
        'mla_g_qa': gain(ks[5], (n_a, MLA_Q_RANK)),
        'mla_w_qb': nrm(ks[6], (n_a, MLA_Q_RANK, MLA_HEADS * MLA_QK), MLA_Q_RANK ** -0.5),
        'mla_g_kva': gain(ks[7], (n_a, MLA_KV_RANK)),
        'mla_w_kvb': nrm(ks[8], (n_a, MLA_KV_RANK, MLA_HEADS * (MLA_NOPE + MLA_V)), MLA_KV_RANK ** -0.5),
        'mla_g_q': gain(ks[9], (n_a, MLA_QK)),
        'mla_g_k': gain(ks[10], (n_a, MLA_QK)),
        'mla_w_o': nrm(ks[11], (n_a, MLA_HEADS * MLA_V, D_MODEL), (MLA_HEADS * MLA_V) ** -0.5),
        'fox_w_in': nrm(ks[12], (n_b, D_MODEL, FOX_IN), D_MODEL ** -0.5),
        'fox_b_f': fox_b_f,
        'fox_g_q': gain(ks[13], (n_b, FOX_HEAD_DIM)),
        'fox_g_k': gain(ks[14], (n_b, FOX_HEAD_DIM)),
        'fox_w_o': nrm(ks[16], (n_b, D_MODEL, D_MODEL), D_MODEL ** -0.5),
        'peer_w_q': nrm(ks[17], (DEPTH, D_MODEL, PEER_HEADS * PEER_D_KEY), D_MODEL ** -0.5),
        'peer_sub_keys': nrm(ks[18], (DEPTH, 2, PEER_N_KEYS, PEER_D_HALF), PEER_D_HALF ** -0.5),
        'peer_u': nrm(ks[19], (DEPTH, PEER_N_EXPERTS, D_MODEL), D_MODEL ** -0.5),
        'peer_v': nrm(ks[20], (DEPTH, PEER_N_EXPERTS, D_MODEL), PEER_HEADS ** -0.5),
    }


def reference(x, positions, norm_mix_g, norm_ffn_g, mla_w_in, mla_g_qa, mla_w_qb, mla_g_kva, mla_w_kvb, mla_g_q, mla_g_k, mla_w_o, fox_w_in, fox_b_f, fox_g_q, fox_g_k, fox_w_o, peer_w_q, peer_sub_keys, peer_u, peer_v):
    inv_freq = ROPE_THETA ** (-jnp.arange(0, MLA_ROPE, 2, dtype=jnp.float32) / MLA_ROPE)
    ang = positions.astype(jnp.float32)[..., None] * inv_freq
    cos = jnp.cos(ang)[:, :, None, :].astype(x.dtype)
    sin = jnp.sin(ang)[:, :, None, :].astype(x.dtype)
    for i in range(DEPTH):
        j = i // N_MIXERS
        h = rms_norm(x, norm_mix_g[i])
        if i % N_MIXERS == 0:
            y = mla_mixer(h, cos, sin, mla_w_in[j], mla_g_qa[j], mla_w_qb[j], mla_g_kva[j], mla_w_kvb[j], mla_g_q[j], mla_g_k[j], mla_w_o[j])
        else:
            y = fox_mixer(h, fox_w_in[j], fox_b_f[j], fox_g_q[j], fox_g_k[j], fox_w_o[j])
        x = x + y
        h = rms_norm(x, norm_ffn_g[i])
        x = x + peer_ffn(h, peer_w_q[i], peer_sub_keys[i], peer_u[i], peer_v[i])
    return x
```

```cpp
#include <hip/hip_runtime.h>
#include <cstdio>
#include <cstdint>
namespace pg8 {
#define PG8_LAS __attribute__((address_space(3)))
typedef unsigned short bf16_t;
typedef short bf16x8 __attribute__((ext_vector_type(8)));
typedef float f32x4 __attribute__((ext_vector_type(4)));
typedef unsigned u32x4 __attribute__((ext_vector_type(4)));
typedef unsigned u32x2 __attribute__((ext_vector_type(2)));
constexpr int BM = 256, BK = 64, HALF = 128, HTB = HALF * BK * 2  , STAGE_BYTES = 8 * HTB, NXCD = 8, WGM = 8;

__host__ __device__ __forceinline__ int lds_byte(int r, int c) { const int st = (r >> 4) * 2 + (c >> 5), rr = r & 15, cc = c & 31, ob = rr * 64 + cc * 2; return st * 1024 + (ob ^ (((ob >> 9) & 1) << 5)); }
__host__ __device__ __forceinline__ void stage_rc(int b, int& R, int& C) { const int st = b / 1024, sb = b % 1024, swz = sb ^ (((sb >> 9) & 1) << 5); R = (st >> 1) * 16 + swz / 64; C = (st & 1) * 32 + (swz % 64) / 2; }
__host__ __device__ __forceinline__ int perm32(int rho) { const int n = rho >> 4, i = rho & 15; return 8 * (i >> 2) + 4 * n + (i & 3); }

struct Unit { int pm, pn; };
struct Gemm { const bf16_t* A; const bf16_t* Bt; int M, N, K, lda, ldb; };

struct StaticOrder {
    int nM, nN, nwg, G, c;
    __host__ __device__ void init(int M, int N, int G_, int c_) { nM = M / BM; nN = N / BM; nwg = nM * nN; G = G_; c = c_; }
    __host__ __device__ bool next(int i, Unit& u) const {
        const long L = (long)i * G + c; if (L >= nwg) return false;
        int wgid = (int)L; { const int q = nwg / NXCD, r = nwg % NXCD, xcd = wgid % NXCD, off = wgid / NXCD; wgid = (xcd < r ? xcd * (q + 1) : r * (q + 1) + (xcd - r) * q) + off; }
        const int nig = WGM * nN, gid = wgid / nig, fm = gid * WGM, gsz = (nM - fm) < WGM ? (nM - fm) : WGM;
        u.pm = fm + ((wgid % nig) % gsz); u.pn = (wgid % nig) / gsz; return true;
    }
    __device__ __forceinline__ void a_ready(const Unit&) const {}
    __device__ __forceinline__ void done(const Unit&) const {}
};

__device__ __forceinline__ unsigned cvt_pk_bf16(float lo, float hi) { unsigned r; asm volatile("v_cvt_pk_bf16_f32 %0, %1, %2" : "=v"(r) : "v"(lo), "v"(hi)); return r; }

constexpr float RMS_EPS = 1e-6f;

__device__ __forceinline__ float slot_sum(const float* p, int ns) { float s = 0.f; for (int i = 0; i < ns; ++i) s += p[i]; return s; }
struct EpiRowScale {
    static constexpr bool PERM = true, AFTER_DRAIN = false, HAS_INIT = false;
    bf16_t* O; int ldc; const float* ssq_in; int ns_in; float inv_k; float* ssq_out0; float* ssq_out1; int t0, t1, ns_out;
    float* ksq = nullptr; int kt0 = 0, kt1 = 0;
    __device__ __forceinline__ void operator()(const f32x4 (&acc)[2][2][4][2], const Unit& u, int wr, int wc, int fr, int fq) const {
        const int row0 = u.pm * BM + wr * 64 + fr, col0 = u.pn * BM + wc * 32 + 8 * fq;
        float* sdst = (u.pn < t0) ? ssq_out0 + u.pn * 4 + wc : ((u.pn < t1) ? ssq_out1 + (u.pn - t0) * 4 + wc : nullptr);
#pragma unroll
        for (int ai = 0; ai < 2; ++ai)
#pragma unroll
            for (int m = 0; m < 4; ++m) {
                const int row = row0 + ai * HALF + m * 16;
                const float rs = ssq_in ? __builtin_amdgcn_rsqf(slot_sum(ssq_in + (size_t)row * ns_in, ns_in) * inv_k + RMS_EPS) : 1.f;
                bf16_t* rowp = O + (size_t)row * ldc + col0; float sq = 0.f, sqh[2];
#pragma unroll
                for (int bj = 0; bj < 2; ++bj) { const f32x4 v0 = acc[ai][bj][m][0] * rs, v1 = acc[ai][bj][m][1] * rs;
                    sqh[bj] = (v0[0] * v0[0] + v0[1] * v0[1]) + (v0[2] * v0[2] + v0[3] * v0[3]) + (v1[0] * v1[0] + v1[1] * v1[1]) + (v1[2] * v1[2] + v1[3] * v1[3]); sq += sqh[bj];
                    u32x4 w; w.x = cvt_pk_bf16(v0[0], v0[1]); w.y = cvt_pk_bf16(v0[2], v0[3]); w.z = cvt_pk_bf16(v1[0], v1[1]); w.w = cvt_pk_bf16(v1[2], v1[3]);
                    *(u32x4*)(rowp + bj * HALF) = w; }
                if (sdst) { sq += __shfl_xor(sq, 16); sq += __shfl_xor(sq, 32); if (fq == 0) sdst[(size_t)row * ns_out] = sq; }
                if (ksq && u.pn >= kt0 && u.pn < kt1) {
#pragma unroll
                    for (int bj = 0; bj < 2; ++bj) { float q = sqh[bj]; q += __shfl_xor(q, 16); q += __shfl_xor(q, 32); if (fq == 0) ksq[((size_t)(2 * (u.pn - kt0) + bj) * 8192 + row) * 4 + wc] = q; } }
            }
    }
};
struct EpiColScale {
    static constexpr bool PERM = true, AFTER_DRAIN = false, HAS_INIT = false;
    bf16_t* O; int ldc; const float* ssq_in; int ns_in; float inv_k;
    __device__ __forceinline__ void operator()(const f32x4 (&acc)[2][2][4][2], const Unit& u, int wr, int wc, int fr, int fq) const {
        const int row0 = u.pm * BM + wr * 64 + fr, col0 = u.pn * BM + wc * 32 + 8 * fq;
        f32x4 cs[2][2];
#pragma unroll
        for (int bj = 0; bj < 2; ++bj)
#pragma unroll
            for (int n = 0; n < 2; ++n) { const float* sp = ssq_in + (size_t)(col0 + bj * HALF + 4 * n) * ns_in; const f32x4 s = (f32x4){slot_sum(sp, ns_in), slot_sum(sp + ns_in, ns_in), slot_sum(sp + 2 * ns_in, ns_in), slot_sum(sp + 3 * ns_in, ns_in)};
                cs[bj][n] = (f32x4){__builtin_amdgcn_rsqf(s[0] * inv_k + RMS_EPS), __builtin_amdgcn_rsqf(s[1] * inv_k + RMS_EPS), __builtin_amdgcn_rsqf(s[2] * inv_k + RMS_EPS), __builtin_amdgcn_rsqf(s[3] * inv_k + RMS_EPS)}; }
#pragma unroll
        for (int ai = 0; ai < 2; ++ai)
#pragma unroll
            for (int m = 0; m < 4; ++m) { bf16_t* rowp = O + (size_t)(row0 + ai * HALF + m * 16) * ldc + col0;
#pragma unroll
                for (int bj = 0; bj < 2; ++bj) { const f32x4 v0 = acc[ai][bj][m][0] * cs[bj][0], v1 = acc[ai][bj][m][1] * cs[bj][1];
                    u32x2 w0, w1; w0.x = cvt_pk_bf16(v0[0], v0[1]); w0.y = cvt_pk_bf16(v0[2], v0[3]); w1.x = cvt_pk_bf16(v1[0], v1[1]); w1.y = cvt_pk_bf16(v1[2], v1[3]);
                    bf16_t* gp = rowp + bj * HALF - 8 * (fq & 1);
                    *(u32x2*)(gp + ((fq & 1) ? 4 : 0)) = w0; *(u32x2*)(gp + ((fq & 1) ? 12 : 8)) = w1; } }
    }
};
struct EpiResidual {
    static constexpr bool PERM = false, AFTER_DRAIN = false, HAS_INIT = true;
    const float* xold; float* out; bf16_t* xb; int ldc; float* ssq_out;
    __device__ __forceinline__ void init(f32x4 (&acc)[2][2][4][2], const Unit& u, int wr, int wc, int fr, int fq) const {
        const int row0 = u.pm * BM + wr * 64 + fr, col0 = u.pn * BM + wc * 32 + 4 * fq;
#pragma unroll
        for (int ai = 0; ai < 2; ++ai)
#pragma unroll
            for (int m = 0; m < 4; ++m) { const size_t ro = (size_t)(row0 + ai * HALF + m * 16) * ldc + col0;
#pragma unroll
                for (int bj = 0; bj < 2; ++bj)
#pragma unroll
                    for (int n = 0; n < 2; ++n) acc[ai][bj][m][n] = *(const f32x4*)(xold + ro + bj * HALF + 16 * n); }
    }
    __device__ __forceinline__ void operator()(const f32x4 (&acc)[2][2][4][2], const Unit& u, int wr, int wc, int fr, int fq) const {
        const int row0 = u.pm * BM + wr * 64 + fr, col0 = u.pn * BM + wc * 32 + 4 * fq;
#pragma unroll
        for (int ai = 0; ai < 2; ++ai)
#pragma unroll
            for (int m = 0; m < 4; ++m) {
                const int row = row0 + ai * HALF + m * 16; const size_t ro = (size_t)row * ldc + col0; float sq = 0.f;
#pragma unroll
                for (int bj = 0; bj < 2; ++bj)
#pragma unroll
                    for (int n = 0; n < 2; ++n) { const size_t o = ro + bj * HALF + 16 * n;
                        const f32x4 v = acc[ai][bj][m][n];
                        sq += (v[0] * v[0] + v[1] * v[1]) + (v[2] * v[2] + v[3] * v[3]);
                        *(f32x4*)(out + o) = v; u32x2 w; w.x = cvt_pk_bf16(v[0], v[1]); w.y = cvt_pk_bf16(v[2], v[3]); *(u32x2*)(xb + o) = w; }
                sq += __shfl_xor(sq, 16); sq += __shfl_xor(sq, 32); if (fq == 0) ssq_out[(size_t)row * 32 + u.pn * 4 + wc] = sq;
            }
    }
};

template <class Epi, class Sched, bool ALIGN_EPI = false>
__device__ __forceinline__ void gemm_phase(PG8_LAS unsigned char* lds, const Gemm g, const Sched& S, const Epi& E) {
    const int tid = threadIdx.x, wid = __builtin_amdgcn_readfirstlane(tid >> 6), lane = tid & 63, wr = wid >> 2, wc = wid & 3, fr = lane & 15, fq = lane >> 4;
    const int K = g.K, nt = K / BK;
    unsigned voffA[2], voffB[2];
#pragma unroll
    for (int i = 0; i < 2; ++i) { int R, C; stage_rc(tid * 16 + i * 8192, R, C); const int Rb = Epi::PERM ? ((R & ~31) + perm32(R & 31)) : R;
        voffA[i] = (unsigned)(R * g.lda + C) * 2u; voffB[i] = (unsigned)(Rb * g.ldb + C) * 2u; }
    const size_t kstep = (size_t)(BK * 2);
    const size_t hstepA = (size_t)HALF * g.lda * 2, hstepB = (size_t)HALF * g.ldb * 2;
    const size_t tstepA = 2 * hstepA, tstepB = 2 * hstepB;
    const unsigned ldsw = (unsigned)wid * 1024u;
    const int aoff = lds_byte(wr * 64 + fr, fq * 8), boff = lds_byte(wc * 32 + fr, fq * 8);
#define PG8_SA(b, h) (((b) * 2 + (h)) * HTB)
#define PG8_SB(b, h) ((4 + (b) * 2 + (h)) * HTB)
#define PG8_STAGE(bufoff, gbase, voff) do { _Pragma("unroll") for (int _i = 0; _i < 2; ++_i) \
        __builtin_amdgcn_global_load_lds((const unsigned*)((const char*)(gbase) + (voff)[_i]), (PG8_LAS unsigned*)(lds + (bufoff) + ldsw + _i * 8192), 16, 0, 0); } while (0)
#define PG8_LDA(dst, b, h) do { _Pragma("unroll") for (int m = 0; m < 4; ++m) _Pragma("unroll") for (int k = 0; k < 2; ++k) dst[m][k] = *(const PG8_LAS bf16x8*)(lds + PG8_SA(b, h) + aoff + m * 2048 + k * 1024); } while (0)
#define PG8_LDB(dst, b, h) do { _Pragma("unroll") for (int n = 0; n < 2; ++n) _Pragma("unroll") for (int k = 0; k < 2; ++k) dst[n][k] = *(const PG8_LAS bf16x8*)(lds + PG8_SB(b, h) + boff + n * 2048 + k * 1024); } while (0)
#define PG8_MMA(ai, bj, At, Bt) do { __builtin_amdgcn_s_setprio(1); _Pragma("unroll") for (int m = 0; m < 4; ++m) _Pragma("unroll") for (int n = 0; n < 2; ++n) _Pragma("unroll") for (int k = 0; k < 2; ++k) \
        acc[ai][bj][m][n] = __builtin_amdgcn_mfma_f32_16x16x32_bf16(Bt[n][k], At[m][k], acc[ai][bj][m][n], 0, 0, 0); __builtin_amdgcn_s_setprio(0); } while (0)
#define PG8_WAIT_V(n) asm volatile("s_waitcnt vmcnt(" #n ")" ::: "memory")
#define PG8_WAIT_L(n) asm volatile("s_waitcnt lgkmcnt(" #n ")" ::: "memory")
#define PG8_BAR __builtin_amdgcn_s_barrier()
#define PG8_SCHED __builtin_amdgcn_sched_barrier(0)
    Unit cur, nxt; int ui = 0;
    if (!S.next(0, cur)) return;
    f32x4 acc[2][2][4][2];
    if constexpr (Epi::HAS_INIT) E.init(acc, cur, wr, wc, fr, fq);
    else {
#pragma unroll
    for (int a = 0; a < 2; ++a)
#pragma unroll
        for (int b = 0; b < 2; ++b)
#pragma unroll
            for (int m = 0; m < 4; ++m)
#pragma unroll
                for (int n = 0; n < 2; ++n) acc[a][b][m][n] = (f32x4){0.f, 0.f, 0.f, 0.f};
    }
    bf16x8 At[4][2], B0[2][2], B1[2][2];
    const char* cA = (const char*)g.A + (size_t)cur.pm * tstepA; const char* cB = (const char*)g.Bt + (size_t)cur.pn * tstepB;
    S.a_ready(cur);
    PG8_STAGE(PG8_SB(0, 0), cB, voffB); PG8_STAGE(PG8_SB(0, 1), cB + hstepB, voffB); PG8_STAGE(PG8_SA(0, 0), cA, voffA); PG8_STAGE(PG8_SA(0, 1), cA + hstepA, voffA);
    if (wr == 1) PG8_BAR;
    PG8_WAIT_V(2); PG8_BAR;
    PG8_STAGE(PG8_SB(1, 0), cB + kstep, voffB); PG8_STAGE(PG8_SA(1, 0), cA + kstep, voffA); PG8_STAGE(PG8_SB(1, 1), cB + hstepB + kstep, voffB);
    PG8_WAIT_V(6); PG8_BAR;
    for (;;) {
        const bool has_next = S.next(ui + 1, nxt);
        const char* nA = has_next ? (const char*)g.A + (size_t)nxt.pm * tstepA : cA; const char* nB = has_next ? (const char*)g.Bt + (size_t)nxt.pn * tstepB : cB;
        for (int t = 0; t < nt; t += 2) {
            const bool last = (t == nt - 2);
            const char* a1 = cA + (size_t)(t + 1) * kstep;
            const char* a2 = last ? nA : cA + (size_t)(t + 2) * kstep; const char* b2 = last ? nB : cB + (size_t)(t + 2) * kstep;
            const char* a3 = a2 + kstep; const char* b3 = b2 + kstep;
            if (last && has_next) S.a_ready(nxt);
            PG8_LDB(B0, 0, 0); PG8_LDB(B1, 0, 1); PG8_SCHED; PG8_LDA(At, 0, 0); PG8_STAGE(PG8_SA(1, 1), a1 + hstepA, voffA);
            PG8_WAIT_V(8); PG8_WAIT_L(0); PG8_BAR; PG8_MMA(0, 0, At, B0); PG8_MMA(0, 1, At, B1); PG8_BAR; PG8_SCHED;
            PG8_LDA(At, 0, 1); PG8_STAGE(PG8_SB(0, 0), b2, voffB); PG8_STAGE(PG8_SB(0, 1), b2 + hstepB, voffB); PG8_STAGE(PG8_SA(0, 0), a2, voffA);
            PG8_WAIT_V(8); PG8_WAIT_L(0); PG8_BAR; PG8_MMA(1, 0, At, B0); PG8_MMA(1, 1, At, B1); PG8_BAR; PG8_SCHED;
            PG8_LDB(B0, 1, 0); PG8_LDB(B1, 1, 1); PG8_SCHED; PG8_LDA(At, 1, 0); PG8_STAGE(PG8_SA(0, 1), a2 + hstepA, voffA);
            PG8_WAIT_V(8); PG8_WAIT_L(0); PG8_BAR; PG8_MMA(0, 0, At, B0); PG8_MMA(0, 1, At, B1); PG8_BAR; PG8_SCHED;
            PG8_LDA(At, 1, 1); PG8_STAGE(PG8_SB(1, 0), b3, voffB); PG8_STAGE(PG8_SB(1, 1), b3 + hstepB, voffB); PG8_STAGE(PG8_SA(1, 0), a3, voffA);
            PG8_WAIT_V(8); PG8_WAIT_L(0); PG8_BAR; PG8_MMA(1, 0, At, B0); PG8_MMA(1, 1, At, B1); PG8_BAR; PG8_SCHED;
        }
        if constexpr (ALIGN_EPI) { if (wr == 0) PG8_BAR; }
        E(acc, cur, wr, wc, fr, fq); S.done(cur);
        if (!has_next) break;
        if constexpr (Epi::HAS_INIT) E.init(acc, nxt, wr, wc, fr, fq);
        else {
#pragma unroll
        for (int a = 0; a < 2; ++a)
#pragma unroll
            for (int b = 0; b < 2; ++b)
#pragma unroll
                for (int m = 0; m < 4; ++m)
#pragma unroll
                    for (int n = 0; n < 2; ++n) acc[a][b][m][n] = (f32x4){0.f, 0.f, 0.f, 0.f};
        }
        cur = nxt; cA = nA; cB = nB; ++ui;
        if constexpr (ALIGN_EPI) { if (wr == 1) PG8_BAR; }
    }
    PG8_WAIT_V(0);
    if constexpr (!ALIGN_EPI) { if (wr == 0) PG8_BAR; }
    PG8_BAR;
#undef PG8_SA
#undef PG8_SB
#undef PG8_STAGE
#undef PG8_LDA
#undef PG8_LDB
#undef PG8_MMA
#undef PG8_WAIT_V
#undef PG8_WAIT_L
#undef PG8_BAR
#undef PG8_SCHED
}
}
#define GAS __attribute__((address_space(1)))
#define LAS __attribute__((address_space(3)))
typedef unsigned short bf16;
typedef unsigned v4u __attribute__((ext_vector_type(4)));
typedef unsigned v2u __attribute__((ext_vector_type(2)));
typedef float f32x4 __attribute__((ext_vector_type(4)));
typedef float f32x16 __attribute__((ext_vector_type(16)));
typedef short bf16x8 __attribute__((ext_vector_type(8)));
typedef __bf16 bf16x2_t __attribute__((ext_vector_type(2)));
typedef GAS unsigned gu32;
#define RLX_AGENT __ATOMIC_RELAXED, __HIP_MEMORY_SCOPE_AGENT
__device__ __forceinline__ unsigned f2bf(float f) { unsigned u = __builtin_bit_cast(unsigned, f); return (u + 0x7fffu + ((u >> 16) & 1u)) >> 16; }
__device__ __forceinline__ unsigned pk2(float lo, float hi) { return pg8::cvt_pk_bf16(lo, hi); }
__device__ __forceinline__ float bf2f(unsigned short v) { return __uint_as_float((unsigned)v << 16); }
__device__ __forceinline__ float bflo(unsigned w) { return __uint_as_float(w << 16); }
__device__ __forceinline__ float bfhi(unsigned w) { return __uint_as_float(w & 0xffff0000u); }
__device__ __forceinline__ float dot2(unsigned a, unsigned b, float acc) { return __builtin_amdgcn_fdot2_f32_bf16(__builtin_bit_cast(bf16x2_t, a), __builtin_bit_cast(bf16x2_t, b), acc, false); }
__device__ __forceinline__ float wave_sum(float v) {
#pragma unroll
    for (int o = 1; o < 64; o <<= 1) v += __shfl_xor(v, o);
    return v;
}
__device__ __forceinline__ float pair_max(float x) { auto t = __builtin_amdgcn_permlane32_swap(__float_as_uint(x), __float_as_uint(x), false, false); return fmaxf(__uint_as_float(t[0]), __uint_as_float(t[1])); }
__device__ __forceinline__ float pair_sum(float x) { auto t = __builtin_amdgcn_permlane32_swap(__float_as_uint(x), __float_as_uint(x), false, false); return __uint_as_float(t[0]) + __uint_as_float(t[1]); }

#define XB_TMO      128
#define XB_XCNT(j)  (256  + 64 * (j))
#define XB_XSUB(j)  (1280 + 64 * (j))
#define XB_XGEN(j)  (2304 + 64 * (j))
#define XB_TOP      3328
#define XB_TOPGEN   3392
#define XCD_BAR_WORDS 3456
#define XB_SPIN_CAP (1u << 18)

__device__ __forceinline__ unsigned xb_ld(unsigned* p)              { return __hip_atomic_load(p, __ATOMIC_RELAXED, __HIP_MEMORY_SCOPE_AGENT); }
__device__ __forceinline__ unsigned xb_add(unsigned* p, unsigned v) { return __hip_atomic_fetch_add(p, v, __ATOMIC_RELAXED, __HIP_MEMORY_SCOPE_AGENT); }
__device__ __forceinline__ unsigned xb_xcc_id() { return (unsigned)__builtin_amdgcn_s_getreg((3 << 11) | 20) & 0xFu; }
#define XB_SPIN(cond, bar) do { unsigned _sp = 0; while (cond) { __builtin_amdgcn_s_sleep(1); \
    if ((++_sp & 255u) == 0u) { if (xb_ld(&(bar)[XB_TMO])) break; if (_sp > XB_SPIN_CAP) { atomicAdd(&(bar)[XB_TMO], 1u); break; } } } } while (0)

struct XcdBarrier {
    unsigned* bar; unsigned x;
    volatile LAS unsigned* st;
};
__device__ __forceinline__ XcdBarrier xcd_barrier_post(unsigned* bar, volatile LAS unsigned* st) {
    XcdBarrier b; b.bar = bar; b.x = xb_xcc_id(); b.st = st;
    if (threadIdx.x == 0) (void)xb_add(&bar[XB_XCNT(b.x)], 1u);
    return b;
}
__device__ __forceinline__ void xcd_barrier_complete(unsigned* bar, unsigned x, unsigned& nloc, unsigned& nx) {
    const unsigned G = gridDim.x * gridDim.y * gridDim.z;
    unsigned sum, cnt, mine, sp = 0u;
    for (;;) {
        sum = 0u; cnt = 0u; mine = 0u;
#pragma unroll
        for (unsigned j = 0; j < 16; ++j) { const unsigned c = xb_ld(&bar[XB_XCNT(j)]); sum += c; cnt += (c > 0u) ? 1u : 0u; mine = (j == x) ? c : mine; }
        if (sum == G) break;
        __builtin_amdgcn_s_sleep(1);
        if ((++sp & 255u) == 0u) { if (xb_ld(&bar[XB_TMO])) break; if (sp > XB_SPIN_CAP) { atomicAdd(&bar[XB_TMO], 1u); break; } }
    }
    nloc = mine > 0u ? mine : 1u; nx = cnt > 0u ? cnt : 1u;
}
__device__ __forceinline__ void xcd_barrier(const XcdBarrier& b) {
    asm volatile("s_waitcnt vmcnt(0)" ::: "memory");
    __syncthreads();
    if (threadIdx.x == 0) {
        unsigned* bar = b.bar;
        __builtin_amdgcn_s_waitcnt(0);
        unsigned nloc = b.st[0], nx = b.st[1];
        if (nloc == 0u) { xcd_barrier_complete(bar, b.x, nloc, nx); b.st[0] = nloc; b.st[1] = nx; }
        const unsigned old = xb_add(&bar[XB_XSUB(b.x)], 1u);
        const unsigned gen = old / nloc;
        if (old + 1u == (gen + 1u) * nloc) {
            __builtin_amdgcn_fence(__ATOMIC_RELEASE, "agent");
            asm volatile("s_waitcnt vmcnt(0)" ::: "memory");
            const unsigned og = xb_add(&bar[XB_TOP], 1u);
            const unsigned tg = og / nx;
            if (og + 1u == (tg + 1u) * nx) xb_add(&bar[XB_TOPGEN], 1u);
            else XB_SPIN(xb_ld(&bar[XB_TOPGEN]) == tg, bar);
            __builtin_amdgcn_fence(__ATOMIC_ACQUIRE, "agent");
            xb_add(&bar[XB_XGEN(b.x)], 1u);
            asm volatile("s_waitcnt vmcnt(0)" ::: "memory");
        } else {
            XB_SPIN(xb_ld(&bar[XB_XGEN(b.x)]) == gen, bar);
            __builtin_amdgcn_fence(__ATOMIC_ACQUIRE, "agent");
            asm volatile("s_waitcnt vmcnt(0)" ::: "memory");
        }
    }
    __syncthreads();
}
constexpr int NWAVES = 8;
constexpr int N_PHASES = 14;
constexpr int NB = 4, SEQ = 2048, T = NB * SEQ, D = 2048;
constexpr int MLA_H = 16, MLA_QK = 192, MLA_NOPE = 128, MLA_ROPE = 64, MLA_IN = 1088, MLA_INP = 1280, MLA_QN = 3072;
constexpr int FOX_H = 16, FOX_HD = 128, FOX_ZN = 6144;
constexpr int PE_H = 8, PE_NK = 128, PE_TOPK = 16, PE_NE = 16384, PE_SEL = 128;
constexpr float RMS_EPS = 1e-6f, LOG2E = 1.4426950408889634f;

constexpr size_t MiB = 1u << 20;
constexpr size_t WS_CTL = 0, CTL_ZERO_BYTES = 1 * MiB;
constexpr size_t WS_SSQ = 1 * MiB;
constexpr size_t WS_WF = WS_SSQ + 2 * MiB;
constexpr size_t WS_SKB = WS_WF + 128 * 1024;
constexpr size_t WS_LF = WS_SKB + 128 * 1024;
constexpr size_t WS_WT_MLA_IN = 5 * MiB;
constexpr size_t WS_WT_QB = WS_WT_MLA_IN + 5 * MiB;
constexpr size_t WS_WT_KVB = WS_WT_QB + 3 * MiB;
constexpr size_t WS_WT_MLA_O = WS_WT_KVB + 4 * MiB;
constexpr size_t WS_WT_FOX_IN = WS_WT_MLA_O + 8 * MiB;
constexpr size_t WS_WT_FOX_O = WS_WT_FOX_IN + 32 * MiB;
constexpr size_t WS_WT_PQ = WS_WT_FOX_O + 8 * MiB;
constexpr size_t WS_PU = WS_WT_PQ + 16 * MiB;
constexpr size_t WS_PV = WS_PU + 64 * MiB;
constexpr size_t WS_PSU = WS_PV + 64 * MiB, WS_PSV = WS_PSU + 128 * 1024;
constexpr size_t WS_XB = WS_PSU + 1 * MiB;
constexpr size_t WS_O = WS_XB + 32 * MiB;
constexpr size_t WS_QP = WS_O + 32 * MiB;
constexpr size_t WS_VT = WS_QP + 32 * MiB;
constexpr size_t WS_ACT = WS_VT + 32 * MiB;
constexpr size_t WS_Z0 = WS_ACT;
constexpr size_t WS_Q = WS_Z0 + 20 * MiB;
constexpr size_t WS_KN = WS_Q + 48 * MiB;
constexpr size_t WS_KM = WS_KN + 32 * MiB;
constexpr size_t WS_KRG = WS_KM;
constexpr size_t WS_RCKV = WS_KM + 2 * MiB, WS_KRSS = WS_RCKV + 256 * 1024;
constexpr size_t WS_ROPE = WS_KM + 4 * MiB;
constexpr size_t WS_KSQM = WS_KM + 8 * MiB;
constexpr size_t WS_Z = WS_ACT;
constexpr size_t WS_KSQ = WS_ACT + 100 * MiB;
constexpr size_t WS_END = WS_KM + 48 * MiB;
static_assert(WS_Z + 96 * MiB <= WS_END, "ws map");
constexpr int SSQ_X0 = 0, SSQ_X2 = T, SSQ_CQ = 2 * T, SSQ_CKV = 10 * T, SSQ_XS = 18 * T;
constexpr int CW_BAR = 4096;

constexpr int RING_OFF = 0, RING_BYTES = 131072;
constexpr int LDS_BYTES = 163840;
constexpr int LDSCTL_OFF = LDS_BYTES - 1024, MISC_OFF = LDSCTL_OFF + 320;

struct Frame {
    LAS unsigned char* lds;
    int tid, lane, wave, vcu, G;
    unsigned char* ws;
    float* out;
};

__device__ __forceinline__ void transpose_item(const float* W, int ldw, int k0, int n0src, const float* gain, bf16* WT, int K, int dstrow0, LAS float* scr, int lane) {
    const int r4 = lane >> 4, c4 = (lane & 15) * 4; f32x4 v[16];
    const float* src = W + (size_t)(k0 + r4) * ldw + n0src + c4;
#pragma unroll
    for (int i = 0; i < 16; ++i) v[i] = *(const f32x4*)(src + (size_t)(4 * i) * ldw);
#pragma unroll
    for (int i = 0; i < 16; ++i) { const int kk = 4 * i + r4; const float gk = gain ? gain[k0 + kk] : 1.f; LAS float* d = scr + kk * 65 + c4; d[0] = v[i].x * gk; d[1] = v[i].y * gk; d[2] = v[i].z * gk; d[3] = v[i].w * gk; }
    asm volatile("s_waitcnt lgkmcnt(0)" ::: "memory");
    const int c = lane & 7;
#pragma unroll
    for (int j = 0; j < 8; ++j) { const int n = (lane >> 3) + 8 * j; const LAS float* s = scr + (8 * c) * 65 + n;
        v4u o; o.x = pk2(s[0 * 65], s[1 * 65]); o.y = pk2(s[2 * 65], s[3 * 65]); o.z = pk2(s[4 * 65], s[5 * 65]); o.w = pk2(s[6 * 65], s[7 * 65]);
        *(v4u*)(WT + (size_t)(dstrow0 + n) * K + k0 + 8 * c) = o; }
    asm volatile("s_waitcnt lgkmcnt(0)" ::: "memory");
}
struct In {
    const float* x; const int* pos; const float *g_mix, *g_ffn, *mla_w_in, *mla_g_qa, *mla_w_qb, *mla_g_kva, *mla_w_kvb, *mla_g_q, *mla_g_k, *mla_w_o,
        *fox_w_in, *fox_b_f, *fox_g_q, *fox_g_k, *fox_w_o, *pe_wq, *pe_sk, *pe_u, *pe_v;
};
__device__ __forceinline__ void prologue_transpose_item(const In& I, unsigned char* ws, LAS float* scr, int lane, int it) {
    constexpr int I1 = 17 * 32, I2 = 48 * 8, I3 = 64 * 8, I4 = 32 * 32, I5 = 128 * 32, I6 = 32 * 32, I7 = 32 * 32;
        int r = it;
        if (r < I1) { const int kb = r / 17, nb = r % 17; transpose_item(I.mla_w_in, MLA_IN, 64 * kb, 64 * nb, I.g_mix, (bf16*)(ws + WS_WT_MLA_IN), 2048, 64 * nb, scr, lane); return; } r -= I1;
        if (r < I2) { const int kb = r / 48, nb = r % 48; transpose_item(I.mla_w_qb, 3072, 64 * kb, 64 * nb, I.mla_g_qa, (bf16*)(ws + WS_WT_QB), 512, 64 * nb, scr, lane); return; } r -= I2;
        if (r < I3) { const int kb = r / 64, nb = r % 64, n0 = 64 * nb, h = n0 >> 8, part = (n0 >> 7) & 1, d0 = n0 & 127;
            transpose_item(I.mla_w_kvb, 4096, 64 * kb, n0, I.mla_g_kva, (bf16*)(ws + WS_WT_KVB), 512, part * 2048 + h * 128 + d0, scr, lane); return; } r -= I3;
        if (r < I4) { const int kb = r / 32, nb = r % 32; transpose_item(I.mla_w_o, 2048, 64 * kb, 64 * nb, nullptr, (bf16*)(ws + WS_WT_MLA_O), 2048, 64 * nb, scr, lane); return; } r -= I4;
        if (r < I5) { const int kb = r / 128, nb = r % 128, n0 = 64 * nb, sec = n0 >> 11, dsec = (sec == 0) ? 0 : (sec == 1) ? 1 : (sec == 2) ? 3 : 2;
            transpose_item(I.fox_w_in, 8208, 64 * kb, n0, I.g_mix + 2048, (bf16*)(ws + WS_WT_FOX_IN), 2048, dsec * 2048 + (n0 & 2047), scr, lane); return; } r -= I5;
        if (r < I6) { const int kb = r / 32, nb = r % 32; transpose_item(I.fox_w_o, 2048, 64 * kb, 64 * nb, nullptr, (bf16*)(ws + WS_WT_FOX_O), 2048, 64 * nb, scr, lane); return; } r -= I6;
        if (r < I7) { const int kb = r / 32, nb = r % 32; transpose_item(I.pe_wq, 2048, 64 * kb, 64 * nb, I.g_ffn, (bf16*)(ws + WS_WT_PQ), 2048, 64 * nb, scr, lane); return; } r -= I7;
        { const int kb = r / 32, nb = r % 32; transpose_item(I.pe_wq + (size_t)2048 * 2048, 2048, 64 * kb, 64 * nb, I.g_ffn + 2048, (bf16*)(ws + WS_WT_PQ + 8 * MiB), 2048, 64 * nb, scr, lane); }
}
__device__ __forceinline__ void quant_pair(const In& I, unsigned char* ws, int lane, int row0) {
        f32x4 v[2][8]; float mx[2] = {0.f, 0.f};
#pragma unroll
        for (int u = 0; u < 2; ++u) { const int row = row0 + u, tbl = row >> 15, rr = row & 32767; const f32x4* src = (const f32x4*)((tbl ? I.pe_v : I.pe_u) + (size_t)rr * D) + lane;
#pragma unroll
            for (int q = 0; q < 8; ++q) v[u][q] = __builtin_nontemporal_load(src + 64 * q); }
#pragma unroll
        for (int u = 0; u < 2; ++u) {
#pragma unroll
            for (int i = 0; i < 8; ++i) { const f32x4 t = v[u][i]; mx[u] = fmaxf(mx[u], fmaxf(fmaxf(fabsf(t.x), fabsf(t.y)), fmaxf(fabsf(t.z), fabsf(t.w)))); }
#pragma unroll
            for (int o = 1; o < 64; o <<= 1) mx[u] = fmaxf(mx[u], __shfl_xor(mx[u], o));
        }
#pragma unroll
        for (int u = 0; u < 2; ++u) { const int row = row0 + u, tbl = row >> 15, rr = row & 32767;
            const float top = tbl ? 440.f : 127.f;
            const float inv = mx[u] > 0.f ? top / mx[u] : 1.f, sc = mx[u] > 0.f ? mx[u] / top : 1.f;
            v4u* dst = (v4u*)(ws + (tbl ? WS_PV : WS_PU) + (size_t)rr * D) + lane; unsigned dq[8];
#pragma unroll
            for (int q = 0; q < 8; ++q) { const f32x4 t = v[u][q] * inv; int w = 0;
                if (tbl) { w = __builtin_amdgcn_cvt_pk_fp8_f32(t.x, t.y, w, false); w = __builtin_amdgcn_cvt_pk_fp8_f32(t.z, t.w, w, true); }
                else w = (__float2int_rn(t.x) & 255) | ((__float2int_rn(t.y) & 255) << 8) | ((__float2int_rn(t.z) & 255) << 16) | (__float2int_rn(t.w) << 24);
                dq[q] = (unsigned)w; }
            if (tbl) {
#pragma unroll
                for (int q = 0; q < 8; ++q) ((unsigned*)dst)[64 * q - 3 * lane] = dq[q];
            } else { dst[0] = (v4u){dq[0], dq[1], dq[2], dq[3]}; dst[64] = (v4u){dq[4], dq[5], dq[6], dq[7]}; }
            if (lane == 0) ((float*)(ws + (tbl ? WS_PSV : WS_PSU)))[rr] = sc; }
}
constexpr int PE_FILL2 = 6144;
__device__ __forceinline__ void p_table_fill(const Frame& F, const In& I, int row_lo, int nrows, int w, int NW) {
    for (int r = 2 * w; r < nrows; r += 2 * NW) quant_pair(I, F.ws, F.lane, row_lo + r);
}
__device__ __forceinline__ void p_prologue(const Frame& F, const In& I) {
    LAS float* scr = (LAS float*)(F.lds + RING_OFF + F.wave * 16640);
    const int gw = F.vcu * NWAVES + F.wave, NGW = F.G * NWAVES, lane = F.lane;
    unsigned char* ws = F.ws;
    constexpr int I1 = 17 * 32, I2 = 48 * 8, I3 = 64 * 8, I4 = 32 * 32, I5 = 128 * 32, I6 = 32 * 32, I7 = 32 * 32, I8 = 32 * 32;
    constexpr int NITEMS = I1 + I2 + I3 + I4 + I5 + I6 + I7 + I8;
    const int gt = F.vcu * 512 + F.tid, NGT = F.G * 512;
    for (int i = gt; i < 49152; i += NGT) ((v4u*)(ws + WS_WT_MLA_IN + (size_t)MLA_IN * 2048 * 2))[i] = (v4u){0u, 0u, 0u, 0u};
    for (int i = gt; i < 16 * 2048; i += NGT) { const int j = i >> 11, k = i & 2047; ((float*)(ws + WS_WF))[i] = I.fox_w_in[(size_t)k * 8208 + 8192 + j] * I.g_mix[2048 + k]; }
    for (int i = gt; i < 2 * 2 * 128 * 128; i += NGT) ((bf16*)(ws + WS_SKB))[i] = (bf16)f2bf(I.pe_sk[i]);
    for (int m = gw; m < T; m += NGW) {
        const f32x4* xr = (const f32x4*)(I.x + (size_t)m * D) + lane; f32x4 v[8]; float s = 0.f;
#pragma unroll
        for (int j = 0; j < 8; ++j) { v[j] = xr[64 * j]; s += (v[j].x * v[j].x + v[j].y * v[j].y) + (v[j].z * v[j].z + v[j].w * v[j].w); }
        s = wave_sum(s); if (lane == 0) ((float*)(ws + WS_SSQ))[SSQ_X0 + m] = s;
        v2u* o = (v2u*)(ws + WS_XB + (size_t)m * D * 2) + lane;
#pragma unroll
        for (int j = 0; j < 8; ++j) { v2u w; w.x = pk2(v[j].x, v[j].y); w.y = pk2(v[j].z, v[j].w); o[64 * j] = w; }
    }
    int tit = gw, tk3 = 0;
    constexpr int NPRO = 65536 - 16384 - PE_FILL2;
    for (int vr = 2 * gw; vr < NPRO || tit < NITEMS; vr += 2 * NGW, ++tk3) {
        if ((tk3 % 3 == 0 || vr >= NPRO) && tit < NITEMS) { prologue_transpose_item(I, ws, scr, lane, tit); tit += NGW; }
        if (vr >= NPRO) continue;
        const int row0 = vr < 16384 ? vr : vr < 32768 ? 32768 + (vr - 16384) : 49152 + PE_FILL2 + (vr - 32768);
        quant_pair(I, ws, lane, row0);
    }
}

__device__ __forceinline__ void p_mla_tok(const Frame& F, const In& I) {
    const int gw = F.vcu * NWAVES + F.wave, NGW = F.G * NWAVES, lane = F.lane;
    const bf16* z0 = (const bf16*)(F.ws + WS_Z0); const float* sq = (const float*)(F.ws + WS_SSQ);
    const float gk2 = I.mla_g_k[128 + lane];
    const float inv_freq = __builtin_amdgcn_exp2f(-13.287712379549449f * (float)(2 * (lane & 31)) * (1.f / 64.f));
    for (int tok = gw; tok < T; tok += NGW) {
        const float ang = (float)I.pos[tok] * inv_freq; const float cs = __cosf(ang), sn = __sinf(ang);
        const float kr = bf2f(z0[(size_t)tok * MLA_INP + 1024 + lane]); const float kr_ss = wave_sum(kr * kr);
        const float krg = kr * gk2, pb = __shfl_xor(krg, 32);
        const float rot = (lane < 32) ? (krg * cs - pb * sn) : (krg * cs + pb * sn);
        ((bf16*)(F.ws + WS_KRG))[(size_t)tok * 64 + lane] = (bf16)f2bf(rot);
        ((float*)(F.ws + WS_ROPE))[(size_t)tok * 64 + lane] = (lane < 32) ? cs : sn;
        if (lane == 0) { ((float*)(F.ws + WS_RCKV))[tok] = __builtin_amdgcn_rsqf(pg8::slot_sum(sq + SSQ_CKV + (size_t)tok * 8, 8) * (1.f / 512.f) + RMS_EPS); ((float*)(F.ws + WS_KRSS))[tok] = kr_ss; }
    }
}

__device__ __forceinline__ void p_fox_prep(const Frame& F, const In& I) {
    const int gw = F.vcu * NWAVES + F.wave, NGW = F.G * NWAVES, lane = F.lane;
    bf16* z = (bf16*)(F.ws + WS_Z);
    const float QS = 0.08838834764831845f * LOG2E;
    const float gq0 = I.fox_g_q[lane], gq1 = I.fox_g_q[64 + lane], gk0 = I.fox_g_k[lane], gk1 = I.fox_g_k[64 + lane];
    for (int tok = gw; tok < T; tok += NGW) {
        bf16* zr = z + (size_t)tok * FOX_ZN;
        for (int h = 0; h < FOX_H; ++h) {
            bf16* qp = zr + h * 128; bf16* kp = zr + 2048 + h * 128;
            float a0 = bf2f(qp[lane]), a1 = bf2f(qp[64 + lane]), b0 = bf2f(kp[lane]), b1 = bf2f(kp[64 + lane]);
            const float rq = __builtin_amdgcn_rsqf(wave_sum(a0 * a0 + a1 * a1) * (1.f / 128.f) + RMS_EPS) * QS;
            const float rk = __builtin_amdgcn_rsqf(wave_sum(b0 * b0 + b1 * b1) * (1.f / 128.f) + RMS_EPS);
            qp[lane] = (bf16)f2bf(a0 * rq * gq0); qp[64 + lane] = (bf16)f2bf(a1 * rq * gq1);
            kp[lane] = (bf16)f2bf(b0 * rk * gk0); kp[64 + lane] = (bf16)f2bf(b1 * rk * gk1);
        }
    }
}

struct AttnAux { const float *gq, *gk, *ksq, *cqs, *rope, *rckv, *krss; const bf16* krg; };
template <int DK> struct AttnCfg { static constexpr int KP = DK + 8, KB_BYTES = 64 * KP * 2, VP = 72, VB_BYTES = 128 * VP * 2, NKS = DK / 16, KPT = (64 * DK / 8) / 512,
    OFF_K = 0, OFF_V = 2 * KB_BYTES, OFF_CL = OFF_V + 2 * VB_BYTES, OFF_WS = OFF_CL + 8192, OFF_RK = OFF_WS + 64, END = OFF_RK + 8192; };
template <int DK, bool FOX>
__device__ __forceinline__ void attn_unit(LAS unsigned char* lds, const bf16* __restrict__ Q, int qpitch, const bf16* __restrict__ K, int kpitch, const bf16* __restrict__ Vt, bf16* __restrict__ O,
                                          const bf16* __restrict__ gate, int gpitch, const float* __restrict__ lf, const AttnAux& ax,
                                          int b, int h, int qb, int tid, int wid, int lane) {
    const float* __restrict__ gq = ax.gq; const float* __restrict__ gk = ax.gk; const float* __restrict__ ksq = ax.ksq;
    typedef AttnCfg<DK> C;
    static_assert(C::END <= RING_BYTES, "attention LDS");
    asm volatile("" : "+v"(tid), "+v"(lane));
    const int r = lane & 31, hh = lane >> 5;
    const int tok0 = b * SEQ, q0 = qb * 256 + wid * 32, jw = q0 >> 6, jmax = qb * 4 + 3;
    constexpr int KPPR = DK / 8 + 1, KNI = 64 * KPPR / 64, VPPR = 9, VNI = 128 * VPPR / 64;
    static_assert(KPPR * 16 == C::KP * 2 && VPPR * 16 == C::VP * 2, "LDS pitches");
    const char* kbase_u = (const char*)(K + (size_t)tok0 * kpitch + h * (FOX ? DK : 128)); const char* vbase_u = (const char*)(Vt + (size_t)h * 128 * T + tok0);
    const char* krbase_u = FOX ? kbase_u : (const char*)(ax.krg + (size_t)tok0 * 64);
    unsigned kg[4], vg[3]; bool kr_[4];
#pragma unroll
    for (int i = 0; i < 4; ++i) { const int p = 64 * (wid + 8 * i) + lane, key = p / KPPR, c = p % KPPR;
        if (FOX) { kr_[i] = false; kg[i] = (unsigned)(key * kpitch + (c < DK / 8 ? c * 8 : 0)) * 2u; }
        else { kr_[i] = (c >= 16 && c < 24); kg[i] = kr_[i] ? (unsigned)(key * 64 + 8 * (c - 16)) * 2u : (unsigned)(key * kpitch + (c < 16 ? c * 8 : 0)) * 2u; } }
#pragma unroll
    for (int i = 0; i < 3; ++i) { const int p = 64 * (wid + 8 * i) + lane, dv = p / VPPR, c = p % VPPR; vg[i] = (unsigned)(dv * T + (c < 8 ? c * 8 : 0)) * 2u; }
#define ATT_STAGE(j, buf) do { const char* _kb = kbase_u + (size_t)(j) * 64 * kpitch * 2; const char* _rb = krbase_u + (size_t)(j) * 64 * 64 * 2; const char* _vb = vbase_u + (size_t)(j) * 128; \
        _Pragma("unroll") for (int i = 0; i < 4; ++i) if (wid + 8 * i < KNI) __builtin_amdgcn_global_load_lds((const unsigned*)(((!FOX && kr_[i]) ? _rb : _kb) + kg[i]), (LAS unsigned*)(lds + C::OFF_K + (buf) * C::KB_BYTES + 1024 * (wid + 8 * i)), 16, 0, 0); \
        _Pragma("unroll") for (int i = 0; i < 3; ++i) if (wid + 8 * i < VNI) __builtin_amdgcn_global_load_lds((const unsigned*)(_vb + vg[i]), (LAS unsigned*)(lds + C::OFF_V + (buf) * C::VB_BYTES + 1024 * (wid + 8 * i)), 16, 0, 0); } while (0)
#define ATT_SYNC() do { asm volatile("s_waitcnt vmcnt(0)" ::: "memory"); __syncthreads(); } while (0)
    ATT_STAGE(0, 0);
    bf16x8 qf[C::NKS];
    {
        LAS unsigned char* qst = lds + C::END + wid * 4608;
        const int rr_ = lane >> 3, cc_ = lane & 7;
        v4u qg[C::NKS / 4][4];
#pragma unroll
        for (int rd = 0; rd < C::NKS / 4; ++rd)
#pragma unroll
            for (int i = 0; i < 4; ++i) qg[rd][i] = *(const v4u*)(Q + (size_t)(tok0 + q0 + 8 * i + rr_) * qpitch + h * DK + 64 * rd + 8 * cc_);
#pragma unroll
        for (int rd = 0; rd < C::NKS / 4; ++rd) {
#pragma unroll
            for (int i = 0; i < 4; ++i) *(LAS v4u*)(qst + (8 * i + rr_) * 144 + cc_ * 16) = qg[rd][i];
            asm volatile("s_waitcnt lgkmcnt(0)" ::: "memory");
#pragma unroll
            for (int k4 = 0; k4 < 4; ++k4) qf[4 * rd + k4] = *(const LAS bf16x8*)(qst + r * 144 + k4 * 32 + hh * 16);
            asm volatile("s_waitcnt lgkmcnt(0)" ::: "memory");
        }
    }
    LAS float* cl = (LAS float*)(lds + C::OFF_CL);
    LAS float* rkl = (LAS float*)(lds + C::OFF_RK);
    if constexpr (FOX) {
        LAS float* wsum = (LAS float*)(lds + C::OFF_WS);
        const int n = (qb + 1) * 256; float v[4]; f32x4 kqv[4];
        { const f32x4 t4 = *(const f32x4*)(lf + (size_t)h * T + tok0 + 4 * tid);
#pragma unroll
          for (int e = 0; e < 4; ++e) v[e] = (4 * tid + e < n) ? t4[e] : 0.f; }
#pragma unroll
        for (int e = 0; e < 4; ++e) kqv[e] = *(const f32x4*)(ksq + ((size_t)h * T + tok0 + tid + 512 * e) * 4);
        {
            float ss = 0.f;
#pragma unroll
            for (int ks = 0; ks < C::NKS; ++ks)
#pragma unroll
                for (int j = 0; j < 8; ++j) { const float v_ = bf2f((unsigned short)qf[ks][j]); ss += v_ * v_; }
            ss = pair_sum(ss);
            const float rq = __builtin_amdgcn_rsqf(ss * (1.f / 128.f) + RMS_EPS) * (0.08838834764831845f * LOG2E);
#pragma unroll
            for (int ks = 0; ks < C::NKS; ++ks) { const int d0 = 16 * ks + 8 * hh; const f32x4 ga = *(const f32x4*)(gq + d0), gb = *(const f32x4*)(gq + d0 + 4), ka = *(const f32x4*)(gk + d0), kb2 = *(const f32x4*)(gk + d0 + 4);
                v4u w; w.x = pk2(bf2f((unsigned short)qf[ks][0]) * rq * ga.x * ka.x, bf2f((unsigned short)qf[ks][1]) * rq * ga.y * ka.y); w.y = pk2(bf2f((unsigned short)qf[ks][2]) * rq * ga.z * ka.z, bf2f((unsigned short)qf[ks][3]) * rq * ga.w * ka.w);
                w.z = pk2(bf2f((unsigned short)qf[ks][4]) * rq * gb.x * kb2.x, bf2f((unsigned short)qf[ks][5]) * rq * gb.y * kb2.y); w.w = pk2(bf2f((unsigned short)qf[ks][6]) * rq * gb.z * kb2.z, bf2f((unsigned short)qf[ks][7]) * rq * gb.w * kb2.w);
                qf[ks] = __builtin_bit_cast(bf16x8, w); }
        }
        v[1] += v[0]; v[2] += v[1]; v[3] += v[2];
        const float tot = v[3]; float sc = tot;
#pragma unroll
        for (int o = 1; o < 64; o <<= 1) { const float t = __shfl_up(sc, o); if (lane >= o) sc += t; }
        if (lane == 63) wsum[wid] = sc;
#pragma unroll
        for (int e = 0; e < 4; ++e) rkl[tid + 512 * e] = __builtin_amdgcn_rsqf(((kqv[e].x + kqv[e].y) + (kqv[e].z + kqv[e].w)) * (1.f / 128.f) + RMS_EPS);
        __syncthreads();
        float base = 0.f;
#pragma unroll
        for (int w = 0; w < 8; ++w) base += (w < wid) ? wsum[w] : 0.f;
        const float excl = base + sc - tot;
#pragma unroll
        for (int e = 0; e < 4; ++e) cl[4 * tid + e] = (excl + v[e]) * LOG2E;
    }
    if constexpr (!FOX) {
        f32x4 kqm[4]; float rcm[4], krm[4];
        { const int n = (qb + 1) * 256;
#pragma unroll
          for (int e = 0; e < 4; ++e) { const int sx = tid + 512 * e; kqm[e] = *(const f32x4*)(ksq + ((size_t)h * T + tok0 + sx) * 4); rcm[e] = ax.rckv[tok0 + sx]; krm[e] = ax.krss[tok0 + sx]; } (void)n; }
        {
            const int tokq = tok0 + q0 + r;
            const float rcq = __builtin_amdgcn_rsqf(pg8::slot_sum(ax.cqs + (size_t)tokq * 8, 8) * (1.f / 512.f) + RMS_EPS);
            float ss = 0.f;
#pragma unroll
            for (int ks = 0; ks < C::NKS; ++ks)
#pragma unroll
                for (int j = 0; j < 8; ++j) { const float v = bf2f((unsigned short)qf[ks][j]); ss += v * v; }
            ss = pair_sum(ss) * rcq * rcq;
            const float sc = rcq * __builtin_amdgcn_rsqf(ss * (1.f / 192.f) + RMS_EPS) * (0.07216878364870322f * LOG2E);
#pragma unroll
            for (int ks = 0; ks < 8; ++ks) { const int d0 = 16 * ks + 8 * hh; const f32x4 ga = *(const f32x4*)(gq + d0), gb = *(const f32x4*)(gq + d0 + 4), ka = *(const f32x4*)(gk + d0), kb2 = *(const f32x4*)(gk + d0 + 4);
                v4u w; w.x = pk2(bf2f((unsigned short)qf[ks][0]) * sc * ga.x * ka.x, bf2f((unsigned short)qf[ks][1]) * sc * ga.y * ka.y); w.y = pk2(bf2f((unsigned short)qf[ks][2]) * sc * ga.z * ka.z, bf2f((unsigned short)qf[ks][3]) * sc * ga.w * ka.w);
                w.z = pk2(bf2f((unsigned short)qf[ks][4]) * sc * gb.x * kb2.x, bf2f((unsigned short)qf[ks][5]) * sc * gb.y * kb2.y); w.w = pk2(bf2f((unsigned short)qf[ks][6]) * sc * gb.z * kb2.z, bf2f((unsigned short)qf[ks][7]) * sc * gb.w * kb2.w);
                qf[ks] = __builtin_bit_cast(bf16x8, w); }
#pragma unroll
            for (int kk = 0; kk < 2; ++kk) { const int i0 = 16 * kk + 8 * hh; const float* rp = ax.rope + (size_t)tokq * 64 + i0;
                const f32x4 c0 = *(const f32x4*)rp, c1 = *(const f32x4*)(rp + 4), s0_ = *(const f32x4*)(rp + 32), s1_ = *(const f32x4*)(rp + 36);
                const f32x4 g10 = *(const f32x4*)(gq + 128 + i0), g11 = *(const f32x4*)(gq + 132 + i0), g20 = *(const f32x4*)(gq + 160 + i0), g21 = *(const f32x4*)(gq + 164 + i0);
                float o1[8], o2[8];
#pragma unroll
                for (int j = 0; j < 8; ++j) { const float cj = j < 4 ? c0[j & 3] : c1[j & 3], sj = j < 4 ? s0_[j & 3] : s1_[j & 3], g1 = j < 4 ? g10[j & 3] : g11[j & 3], g2 = j < 4 ? g20[j & 3] : g21[j & 3];
                    const float x1 = bf2f((unsigned short)qf[8 + kk][j]) * sc * g1, x2 = bf2f((unsigned short)qf[10 + kk][j]) * sc * g2; o1[j] = x1 * cj - x2 * sj; o2[j] = x2 * cj + x1 * sj; }
                v4u w1, w2; w1.x = pk2(o1[0], o1[1]); w1.y = pk2(o1[2], o1[3]); w1.z = pk2(o1[4], o1[5]); w1.w = pk2(o1[6], o1[7]); w2.x = pk2(o2[0], o2[1]); w2.y = pk2(o2[2], o2[3]); w2.z = pk2(o2[4], o2[5]); w2.w = pk2(o2[6], o2[7]);
                qf[8 + kk] = __builtin_bit_cast(bf16x8, w1); qf[10 + kk] = __builtin_bit_cast(bf16x8, w2); }
        }
        {
#pragma unroll
            for (int e = 0; e < 4; ++e) { const int sx = tid + 512 * e; const f32x4 kq = kqm[e]; const float rc = rcm[e];
                const float rk = __builtin_amdgcn_rsqf((rc * rc * ((kq.x + kq.y) + (kq.z + kq.w)) + krm[e]) * (1.f / 192.f) + RMS_EPS); rkl[sx] = rk; cl[sx] = rk * rc; }
        }
    }
    f32x16 o[4];
#pragma unroll
    for (int i = 0; i < 4; ++i)
#pragma unroll
        for (int e = 0; e < 16; ++e) o[i][e] = 0.f;
    float m = -1e30f, l = 0.f;
    ATT_SYNC();
#pragma unroll 1
    for (int j = 0; j <= jmax; ++j) {
        if (j < jmax) ATT_STAGE(j + 1, (j + 1) & 1);
        if (j <= jw) {
#pragma unroll
            for (int kbk = 0; kbk < 2; ++kbk) {
                f32x16 s0;
#pragma unroll
                for (int e = 0; e < 16; ++e) s0[e] = 0.f;
                const LAS unsigned char* kb = lds + C::OFF_K + (j & 1) * C::KB_BYTES + ((32 * kbk + r) * C::KP + 8 * hh) * 2;
                if constexpr (FOX) {
#pragma unroll
                    for (int ks = 0; ks < C::NKS; ++ks) {
                        const bf16x8 a0 = *(const LAS bf16x8*)(kb + ks * 32);
                        s0 = __builtin_amdgcn_mfma_f32_32x32x16_bf16(a0, qf[ks], s0, 0, 0, 0);
                    }
                } else {
                    f32x16 sr;
#pragma unroll
                    for (int e = 0; e < 16; ++e) sr[e] = 0.f;
#pragma unroll
                    for (int ks = 0; ks < 8; ++ks) { const bf16x8 a0 = *(const LAS bf16x8*)(kb + ks * 32); s0 = __builtin_amdgcn_mfma_f32_32x32x16_bf16(a0, qf[ks], s0, 0, 0, 0); }
#pragma unroll
                    for (int ks = 8; ks < 12; ++ks) { const bf16x8 a0 = *(const LAS bf16x8*)(kb + ks * 32); sr = __builtin_amdgcn_mfma_f32_32x32x16_bf16(a0, qf[ks], sr, 0, 0, 0); }
                    const LAS f32x4* v4 = (const LAS f32x4*)(cl + 64 * j + 32 * kbk + 4 * hh); const LAS f32x4* r4 = (const LAS f32x4*)(rkl + 64 * j + 32 * kbk + 4 * hh);
#pragma unroll
                    for (int g = 0; g < 4; ++g) { const f32x4 kv = v4[2 * g], rr = r4[2 * g];
#pragma unroll
                        for (int e = 0; e < 4; ++e) s0[4 * g + e] = s0[4 * g + e] * kv[e] + sr[4 * g + e] * rr[e]; }
                }
                if constexpr (FOX) {
                    const LAS f32x4* c4 = (const LAS f32x4*)(cl + 64 * j + 32 * kbk + 4 * hh); const LAS f32x4* r4 = (const LAS f32x4*)(rkl + 64 * j + 32 * kbk + 4 * hh);
#pragma unroll
                    for (int g = 0; g < 4; ++g) { const f32x4 c0 = c4[2 * g], rr = r4[2 * g];
#pragma unroll
                        for (int e = 0; e < 4; ++e) s0[4 * g + e] = s0[4 * g + e] * rr[e] - c0[e]; }
                    if (j == jw) {
                        const int qrow = q0 + r, kbase = 64 * j + 32 * kbk + 4 * hh;
#pragma unroll
                        for (int e = 0; e < 16; ++e) { const int key = kbase + (e & 3) + 8 * (e >> 2); if (key > qrow) s0[e] = -1e30f; }
                    }
                }
                float mx = s0[0];
#pragma unroll
                for (int e = 1; e < 16; ++e) mx = fmaxf(mx, s0[e]);
                mx = pair_max(mx);
                const float mn = fmaxf(m, mx);
                if (__any(mn > m)) {
                    const float alpha = __builtin_amdgcn_exp2f(m - mn);
                    l *= alpha;
#pragma unroll
                    for (int i = 0; i < 4; ++i)
#pragma unroll
                        for (int e = 0; e < 16; ++e) o[i][e] *= alpha;
                    m = mn;
                }
                float ps = 0.f;
#pragma unroll
                for (int e = 0; e < 16; ++e) { s0[e] = __builtin_amdgcn_exp2f(s0[e] - m); ps += s0[e]; }
                l += ps;
                bf16x8 p[2];
#pragma unroll
                for (int s = 0; s < 2; ++s) {
                    v4u w0;
                    w0.x = pk2(s0[8 * s + 0], s0[8 * s + 1]); w0.y = pk2(s0[8 * s + 2], s0[8 * s + 3]); w0.z = pk2(s0[8 * s + 4], s0[8 * s + 5]); w0.w = pk2(s0[8 * s + 6], s0[8 * s + 7]);
                    p[s] = __builtin_bit_cast(bf16x8, w0);
                }
                const LAS unsigned char* vb = lds + C::OFF_V + (j & 1) * C::VB_BYTES + (r * C::VP + 32 * kbk + 8 * hh) * 2;
#pragma unroll
                for (int dvb = 0; dvb < 4; ++dvb)
#pragma unroll
                    for (int s = 0; s < 2; ++s) {
                        const bf16x8 a = *(const LAS bf16x8*)(vb + (dvb * 32 * C::VP + 16 * s) * 2);
                        o[dvb] = __builtin_amdgcn_mfma_f32_32x32x16_bf16(a, p[s], o[dvb], 0, 0, 0);
                    }
            }
        }
        ATT_SYNC();
    }
#undef ATT_STAGE
#undef ATT_SYNC
    l = pair_sum(l);
    const float inv = 1.f / l;
    int re = r, he = hh; asm volatile("" : "+v"(re), "+v"(he));
    static_assert(C::END + 8 * 4608 <= LDSCTL_OFF, "attention O staging");
    LAS unsigned char* ost = lds + C::END + wid * 4608;
    const int rr = lane >> 3, cc = lane & 7;
    const size_t orow0 = (size_t)(tok0 + q0);
#pragma unroll
    for (int half = 0; half < 2; ++half) {
#pragma unroll
        for (int d2 = 0; d2 < 2; ++d2)
#pragma unroll
            for (int g = 0; g < 4; ++g) { const int dvb = 2 * half + d2;
                v2u w; w.x = pk2(o[dvb][4 * g + 0] * inv, o[dvb][4 * g + 1] * inv); w.y = pk2(o[dvb][4 * g + 2] * inv, o[dvb][4 * g + 3] * inv);
                *(LAS v2u*)(ost + re * 144 + (d2 * 32 + 8 * g + 4 * he) * 2) = w; }
        asm volatile("s_waitcnt lgkmcnt(0)" ::: "memory");
#pragma unroll
        for (int i = 0; i < 4; ++i) { const int row = 8 * i + rr;
            v4u w = *(const LAS v4u*)(ost + row * 144 + cc * 16);
            if constexpr (FOX) {
                const v4u gw = *(const v4u*)(gate + (orow0 + row) * gpitch + h * 128 + half * 64 + cc * 8);
#pragma unroll
                for (int c = 0; c < 4; ++c) { const float lo = bflo(w[c]) * __builtin_amdgcn_rcpf(1.f + __builtin_amdgcn_exp2f(-LOG2E * bflo(gw[c]))), hi = bfhi(w[c]) * __builtin_amdgcn_rcpf(1.f + __builtin_amdgcn_exp2f(-LOG2E * bfhi(gw[c]))); w[c] = pk2(lo, hi); }
            }
            *(v4u*)(O + (orow0 + row) * 2048 + h * 128 + half * 64 + cc * 8) = w; }
        asm volatile("s_waitcnt lgkmcnt(0)" ::: "memory");
    }
}
template <int DK, bool FOX>
__device__ __forceinline__ void p_attention(const Frame& F, const bf16* Q, int qpitch, const bf16* K, int kpitch, const bf16* Vt, bf16* O, const bf16* gate, int gpitch, const float* lf, const AttnAux& ax) {
    for (int u = F.vcu; u < 256; u += F.G) {
        const int bh = u >> 2, p = u & 3, b = bh >> 4, h = bh & 15;
#pragma unroll 1
        for (int half = 0; half < 2; ++half)
            attn_unit<DK, FOX>(F.lds + RING_OFF, Q, qpitch, K, kpitch, Vt, O, gate, gpitch, lf, ax, b, h, half ? p : 7 - p, F.tid, F.wave, F.lane);
    }
}

__device__ __forceinline__ unsigned sortkey(float s) { const unsigned b = __float_as_uint(s); return b ^ ((unsigned)((int)b >> 31) | 0x80000000u); }
__device__ __forceinline__ float unsortkey(unsigned k) { return __uint_as_float((k & 0x80000000u) ? (k ^ 0x80000000u) : ~k); }
#define TOP_INSERT(top, x) do { unsigned _x = (x); _Pragma("unroll") for (int _i = 0; _i < 16; ++_i) { const unsigned _h = max((top)[_i], _x); _x = min((top)[_i], _x); (top)[_i] = _h; } } while (0)
__device__ __forceinline__ int sel16(const int (&a)[16], int i) { int r = a[0];
#pragma unroll
    for (int q = 1; q < 16; ++q) r = (i == q) ? a[q] : r;
    return r; }
#define CE_DESC(a, b) do { const unsigned _hi = max((a), (b)), _lo = min((a), (b)); (a) = _hi; (b) = _lo; } while (0)
__device__ __forceinline__ void bitonic_merge16_desc(unsigned (&v)[16]) {
#pragma unroll
    for (int j = 8; j > 0; j >>= 1)
#pragma unroll
        for (int i = 0; i < 16; ++i) if ((i & j) == 0) CE_DESC(v[i], v[i | j]);
}
__device__ __forceinline__ void sort16_desc(unsigned (&v)[16]) {
#pragma unroll
    for (int k = 2; k <= 16; k <<= 1)
#pragma unroll
        for (int j = k >> 1; j > 0; j >>= 1)
#pragma unroll
            for (int i = 0; i < 16; ++i) { const int l = i ^ j; if (l > i) { if ((i & k) == 0 || k == 16) CE_DESC(v[i], v[l]); else CE_DESC(v[l], v[i]); } }
}
__device__ __forceinline__ void merge_top16(unsigned (&top)[16], const unsigned (&b)[16]) {
#pragma unroll
    for (int i = 0; i < 16; ++i) top[i] = max(top[i], b[15 - i]);
    bitonic_merge16_desc(top);
}
__device__ __forceinline__ void peer_half_top16(const bf16* __restrict__ qrow  , const bf16* __restrict__ sk  , int hh, unsigned (&top)[16]) {
#pragma unroll
    for (int i = 0; i < 16; ++i) top[i] = 0u;
#pragma unroll 1
    for (int kb = 0; kb < 4; ++kb) {
        f32x16 acc;
#pragma unroll
        for (int e = 0; e < 16; ++e) acc[e] = 0.f;
        const bf16* skb = sk + (size_t)kb * 32 * 128;
#pragma unroll
        for (int ks = 0; ks < 8; ++ks) { const bf16x8 qf = *(const bf16x8*)(qrow + 16 * ks), a = *(const bf16x8*)(skb + 16 * ks); acc = __builtin_amdgcn_mfma_f32_32x32x16_bf16(a, qf, acc, 0, 0, 0); }
        const int kbase = 127 - (32 * kb + 4 * hh);
        unsigned nv[16];
#pragma unroll
        for (int e = 0; e < 16; ++e) nv[e] = (sortkey(acc[e]) & ~127u) | (unsigned)(kbase - ((e & 3) + 8 * (e >> 2)));
        sort16_desc(nv); merge_top16(top, nv);
    }
    unsigned pt[16];
#pragma unroll
    for (int i = 0; i < 16; ++i) pt[i] = (unsigned)__shfl_xor((int)top[i], 32);
    merge_top16(top, pt);
}
constexpr int PE_OFF_IDX = 0, PE_OFF_G = 16384, PE_OFF_TB = 32768;
__device__ __forceinline__ void peer_topk(const Frame& F, int layer, int t0) {
    const int lane = F.lane, r = lane & 31, hh = lane >> 5, head = F.wave;
    const bf16* qp = (const bf16*)(F.ws + WS_QP) + (size_t)(t0 + r) * 2048 + head * 256 + 8 * hh;
    const bf16* sk = (const bf16*)(F.ws + WS_SKB) + (size_t)layer * 2 * 128 * 128 + r * 128 + 8 * hh;
    unsigned t1[16], t2[16];
    peer_half_top16(qp, sk, hh, t1);
    peer_half_top16(qp + 128, sk + 128 * 128, hh, t2);
    int rr = r; asm volatile("" : "+v"(rr));
    const float rs = __builtin_amdgcn_rsqf(pg8::slot_sum((const float*)(F.ws + WS_SSQ) + SSQ_XS + (size_t)(t0 + rr) * 32, 32) * (1.f / 2048.f) + RMS_EPS);
    float v1[16], v2[16]; int e1[16], e2[16];
#pragma unroll
    for (int i = 0; i < 16; ++i) { v1[i] = unsortkey(t1[i] & ~127u) * rs; e1[i] = 127 - (int)(t1[i] & 127u); v2[i] = unsortkey(t2[i] & ~127u) * rs; e2[i] = 127 - (int)(t2[i] & 127u); }
    unsigned best[16], g1[16], g2[16], g3[16];
#pragma unroll
    for (int i = 0; i < 16; ++i) { best[i] = 0u; g1[i] = 0u; g2[i] = 0u; g3[i] = 0u; }
    { int n = 0;
#pragma unroll
      for (int i = 0; i < 16; ++i)
#pragma unroll
        for (int j = 0; j < 16; ++j)
            if ((i + 1) * (j + 1) <= 16) { const unsigned kx = (sortkey(v1[i] + v2[j]) & ~255u) | (unsigned)(255 - (i * 16 + j));
                if (n < 16) best[n & 15] = kx; else if (n < 32) g1[n & 15] = kx; else if (n < 48) g2[n & 15] = kx; else g3[n & 15] = kx; ++n; } }
    sort16_desc(best); sort16_desc(g1); sort16_desc(g2); sort16_desc(g3);
    merge_top16(best, g1); merge_top16(best, g2); merge_top16(best, g3);
    float sc[16]; int ex[16];
    LAS int* tb = (LAS int*)(F.lds + RING_OFF + PE_OFF_TB) + F.wave * 2048 + lane;
#pragma unroll
    for (int i = 0; i < 16; ++i) { tb[i * 64] = e1[i]; tb[(16 + i) * 64] = e2[i]; }
#pragma unroll
    for (int k = 0; k < 16; ++k) { const int pos = 255 - (int)(best[k] & 255u); ex[k] = tb[(pos >> 4) * 64] * PE_NK + tb[(16 + (pos & 15)) * 64]; sc[k] = unsortkey(best[k] & ~255u); }
    float sum = 0.f; const float smax = sc[0];
#pragma unroll
    for (int k = 0; k < 16; ++k) { sc[k] = __expf(sc[k] - smax); sum += sc[k]; }
    const float inv = 1.f / sum;
    LAS int* li = (LAS int*)(F.lds + RING_OFF + PE_OFF_IDX) + r * PE_SEL + head * 16;
    LAS float* lg = (LAS float*)(F.lds + RING_OFF + PE_OFF_G) + r * PE_SEL + head * 16;
    if (hh == 0) {
#pragma unroll
        for (int k = 0; k < 16; ++k) li[k] = ex[k];
    } else {
#pragma unroll
        for (int k = 0; k < 16; ++k) lg[k] = sc[k] * inv;
    }
}
__device__ __forceinline__ float group_sum64(float v) {
    const int i0 = __builtin_bit_cast(int, v);
    v += __builtin_bit_cast(float, __builtin_amdgcn_update_dpp(0, i0, 0x111, 0xf, 0xf, true));
    v += __builtin_bit_cast(float, __builtin_amdgcn_update_dpp(0, __builtin_bit_cast(int, v), 0x112, 0xf, 0xf, true));
    v += __builtin_bit_cast(float, __builtin_amdgcn_update_dpp(0, __builtin_bit_cast(int, v), 0x114, 0xf, 0xf, true));
    v += __builtin_bit_cast(float, __builtin_amdgcn_update_dpp(0, __builtin_bit_cast(int, v), 0x118, 0xf, 0xf, true));
    v += __builtin_bit_cast(float, __builtin_amdgcn_update_dpp(0, __builtin_bit_cast(int, v), 0x142, 0xa, 0xf, false));
    v += __builtin_bit_cast(float, __builtin_amdgcn_update_dpp(0, __builtin_bit_cast(int, v), 0x143, 0xc, 0xf, false));
    return v;
}
__device__ __forceinline__ float gelu_erf(float x) { return 0.5f * x * (1.f + erff(x * 0.7071067811865476f)); }
typedef float f32x2 __attribute__((ext_vector_type(2)));
__device__ __forceinline__ void sort128(unsigned& kA, unsigned& kB, int lane) {
#pragma unroll
    for (int k = 2; k <= 128; k <<= 1)
#pragma unroll
        for (int j = k >> 1; j > 0; j >>= 1) {
            if (j == 64) { const unsigned lo = min(kA, kB), hi = max(kA, kB); kA = lo; kB = hi; }
            else {
                const unsigned pA = (unsigned)__shfl_xor((int)kA, j), pB = (unsigned)__shfl_xor((int)kB, j);
                const bool lower = (lane & j) == 0, upA = (lane & k) == 0, upB = ((lane + 64) & k) == 0;
                kA = (lower == upA) ? min(kA, pA) : max(kA, pA);
                kB = (lower == upB) ? min(kB, pB) : max(kB, pB);
            }
        }
}
constexpr int PE_NS = 32, PE_SLICE = PE_NE / PE_NS;
constexpr int PE_PACE = 64;
typedef int v4i __attribute__((ext_vector_type(4)));
constexpr int PE_D = 6;
constexpr int PE2_KEYS = 0, PE2_G = 16384, PE2_A = 32768, PE2_ORD = 49152, PE2_CT = 65536, PE2_RING = 73728, PE2_END = PE2_RING + 8 * 5 * 2048;
static_assert(PE2_G == PE_OFF_G && PE2_KEYS == PE_OFF_IDX && PE2_END <= 160 * 1024 - 1024, "peer LDS map");
#define PE_WAITV(n) asm volatile("s_waitcnt vmcnt(" #n ")" ::: "memory")
template <int LAYER>
__device__ __forceinline__ void peer_gather4(const Frame& F, const In& I, int t0w, int tl0, int dry) {
    const int lane = F.lane, wv = F.wave;
    const float* gain = I.g_ffn + LAYER * 2048;
    const unsigned char* ut = F.ws + WS_PU + (size_t)LAYER * PE_NE * D + lane * 16;
    const unsigned char* vt = F.ws + WS_PV + (size_t)LAYER * PE_NE * D + lane * 16;
    const float* su = (const float*)(F.ws + WS_PSU) + LAYER * PE_NE; const float* sv = (const float*)(F.ws + WS_PSV) + LAYER * PE_NE;
    LAS unsigned* keys = (LAS unsigned*)(F.lds + RING_OFF + PE2_KEYS) + tl0 * PE_SEL;
    LAS float* lg = (LAS float*)(F.lds + RING_OFF + PE2_G) + tl0 * PE_SEL;
    LAS float* la = (LAS float*)(F.lds + RING_OFF + PE2_A) + tl0 * PE_SEL;
    LAS unsigned* ord = (LAS unsigned*)(F.lds + RING_OFF + PE2_ORD) + wv * 512;
    LAS int* ct = (LAS int*)(F.lds + RING_OFF + PE2_CT) + wv * 256;
    LAS unsigned char* ring = F.lds + RING_OFF + PE2_RING + wv * (5 * 2048);
    LAS unsigned char* ring5 = F.lds + RING_OFF + PE2_KEYS + wv * 2048;
#define PE_SLOT(sl) (((sl) < 5) ? ring + (sl) * 2048 : ring5)
    unsigned sA[4], sB[4];
#pragma unroll
    for (int tk = 0; tk < 4; ++tk) {
        sA[tk] = (keys[tk * PE_SEL + lane] << 7) | (unsigned)lane; sB[tk] = (keys[tk * PE_SEL + 64 + lane] << 7) | (unsigned)(64 + lane);
        sort128(sA[tk], sB[tk], lane);
    }
    if (lane < 4) ct[lane * 36] = 0;
#pragma unroll 1
    for (int s = 0; s < PE_NS; ++s) { const unsigned limit = (unsigned)((s + 1) * PE_SLICE) << 7;
#pragma unroll
        for (int tk = 0; tk < 4; ++tk) { const int c = __builtin_popcountll(__ballot(sA[tk] < limit)) + __builtin_popcountll(__ballot(sB[tk] < limit)); if (lane == 0) ct[tk * 36 + s + 1] = c; } }
#pragma unroll
    for (int tk = 0; tk < 4; ++tk) {
#pragma unroll
        for (int hb = 0; hb < 2; ++hb) { const unsigned key = hb ? sB[tk] : sA[tk]; const int pos = lane + 64 * hb, e = (int)(key >> 7), sl = e / PE_SLICE; int rank = pos;
#pragma unroll
            for (int t2 = 0; t2 < 4; ++t2) if (t2 != tk) rank += ct[t2 * 36 + sl + (t2 < tk ? 1 : 0)];
            ord[rank] = ((unsigned)e << 9) | (unsigned)(tk << 7) | (unsigned)pos; }
    }
    float glA[4], glB[4];
#pragma unroll
    for (int tk = 0; tk < 4; ++tk) { glA[tk] = lg[tk * PE_SEL + (sA[tk] & 127u)]; glB[tk] = lg[tk * PE_SEL + (sB[tk] & 127u)]; }
    const int bj = lane & 3, bb = lane >> 2;
    int hq[8][4]; float shl = 1.f;
    {
        LAS unsigned char* himg = ring;
#pragma unroll
        for (int tk = 0; tk < 4; ++tk) {
            const float* xrow = F.out + (size_t)(t0w + tk) * D + 4 * lane; const float* grow = gain + 4 * lane;
            const float rs = __builtin_amdgcn_rsqf(pg8::slot_sum((const float*)(F.ws + WS_SSQ) + SSQ_XS + (size_t)(t0w + tk) * 32, 32) * (1.f / 2048.f) + RMS_EPS);
            f32x4 hv[8]; float mx = 0.f;
#pragma unroll
            for (int q = 0; q < 8; ++q) { const f32x4 xv = *(const f32x4*)(xrow + 256 * q), gv = *(const f32x4*)(grow + 256 * q);
                const f32x4 t = (f32x4){xv.x * rs * gv.x, xv.y * rs * gv.y, xv.z * rs * gv.z, xv.w * rs * gv.w}; hv[q] = t;
                mx = fmaxf(mx, fmaxf(fmaxf(fabsf(t.x), fabsf(t.y)), fmaxf(fabsf(t.z), fabsf(t.w)))); }
#pragma unroll
            for (int o = 1; o < 64; o <<= 1) mx = fmaxf(mx, __shfl_xor(mx, o));
            const float inv = mx > 0.f ? 127.f / mx : 1.f; if (bj == tk) shl = mx > 0.f ? mx * (1.f / 127.f) : 1.f;
            unsigned dq[8];
#pragma unroll
            for (int q = 0; q < 8; ++q) { const f32x4 t = hv[q] * inv; dq[q] = (unsigned)((__float2int_rn(t.x) & 255) | ((__float2int_rn(t.y) & 255) << 8) | ((__float2int_rn(t.z) & 255) << 16) | (__float2int_rn(t.w) << 24)); }
            *(LAS v4u*)(himg + tk * 2048 + 16 * lane) = (v4u){dq[0], dq[1], dq[2], dq[3]}; *(LAS v4u*)(himg + tk * 2048 + 1024 + 16 * lane) = (v4u){dq[4], dq[5], dq[6], dq[7]};
            asm volatile("" ::: "memory");
        }
        asm volatile("s_waitcnt lgkmcnt(0)" ::: "memory");
#pragma unroll
        for (int s8 = 0; s8 < 8; ++s8) { const v4u t = *(const LAS v4u*)(himg + bj * 2048 + 256 * s8 + 16 * bb); hq[s8][0] = (int)t.x; hq[s8][1] = (int)t.y; hq[s8][2] = (int)t.z; hq[s8][3] = (int)t.w; }
    }
    asm volatile("s_waitcnt vmcnt(0) lgkmcnt(0)" ::: "memory");
    static_assert(PE_D == 6, "the counted wait below is vmcnt(2 * (PE_D - 1))");
#define PE_EMASK
#define PE_ISSUE(tab, code, slot) do { const unsigned char* _g = (tab) + ((size_t)((code) >> 9) << 11); \
        LAS unsigned char* _d = PE_SLOT(slot); \
        __builtin_amdgcn_global_load_lds((const unsigned*)_g, (LAS unsigned*)_d, 16, 0, 0); \
        __builtin_amdgcn_global_load_lds((const unsigned*)(_g + 1024), (LAS unsigned*)(_d + 1024), 16, 0, 0); } while (0)
#define PE_ROW_HEAD(tab) \
                    const int i6 = r & 63, ia = i6 + PE_D; const unsigned codea = (unsigned)__builtin_amdgcn_readlane((int)((ia < 64) ? oc : on), ia & 63); \
                    PE_WAITV(10); \
                    v4u w[2]; { const LAS unsigned char* _s = PE_SLOT(slot); w[0] = *(const LAS v4u*)(_s + lane * 16); w[1] = *(const LAS v4u*)(_s + 1024 + lane * 16); } \
                    asm volatile("s_waitcnt lgkmcnt(0)" ::: "memory"); \
                    PE_ISSUE(tab, codea, slot);
#define PE_ROW_TAIL() \
                    slot = (slot + 1 == PE_D) ? 0 : slot + 1; ++r; \
                    if ((r & 63) == 0) { const int nb = (r >> 6) + 1; oc = on; on = ord[((nb < 8) ? nb : 7) * 64 + lane]; asm volatile("s_waitcnt lgkmcnt(0)" ::: "memory"); }
    LAS _Float16* lah = (LAS _Float16*)(F.lds + RING_OFF + PE2_A + wv * 2048);
    LAS float* lav = lg;
    {
        LAS unsigned char* const sl5 = F.lds + RING_OFF + PE2_KEYS + wv * 2048;
        LAS unsigned char* const sl6 = F.lds + RING_OFF + PE2_G + wv * 2048;
        LAS unsigned char* const sl7lo = F.lds + RING_OFF + PE2_A + wv * 2048 + 1024;
        LAS unsigned char* const sl7hi = F.lds + RING_OFF + PE2_CT + wv * 1024;
#define U_LO(k) ((k) < 5 ? ring + (k) * 2048 : (k) == 5 ? sl5 : (k) == 6 ? sl6 : sl7lo)
#define U_HI(k) ((k) < 7 ? U_LO(k) + 1024 : sl7hi)
        const LAS unsigned char* ad[2][8];
#pragma unroll
        for (int p = 0; p < 2; ++p) {
            const LAS unsigned char* lo = bj == 0 ? U_LO(4 * p) : bj == 1 ? U_LO(4 * p + 1) : bj == 2 ? U_LO(4 * p + 2) : U_LO(4 * p + 3);
            const LAS unsigned char* hi = bj == 0 ? U_HI(4 * p) : bj == 1 ? U_HI(4 * p + 1) : bj == 2 ? U_HI(4 * p + 2) : U_HI(4 * p + 3);
#pragma unroll
            for (int s8 = 0; s8 < 8; ++s8) ad[p][s8] = (s8 < 4 ? lo : hi) + 16 * ((16 * (s8 & 3) + bb - 4 * bj) & 63);
        }
        const unsigned char* utr[4];
#pragma unroll
        for (int i = 0; i < 4; ++i) utr[i] = F.ws + WS_PU + (size_t)LAYER * PE_NE * D + 16 * ((lane + 4 * i) & 63);
#define U_ISSUE(i, k, code) do { const unsigned char* _g = utr[i] + ((size_t)(((code) >> 9) PE_EMASK) << 11); \
        __builtin_amdgcn_global_load_lds((const unsigned*)_g, (LAS unsigned*)U_LO(k), 16, 0, 0); \
        __builtin_amdgcn_global_load_lds((const unsigned*)(_g + 1024), (LAS unsigned*)U_HI(k), 16, 0, 0); } while (0)
        { const v4u c0 = *(const LAS v4u*)(ord), c1 = *(const LAS v4u*)(ord + 4);
          asm volatile("s_waitcnt lgkmcnt(0)" ::: "memory");
#pragma unroll
          for (int i = 0; i < 4; ++i) U_ISSUE(i, i, (unsigned)__builtin_amdgcn_readfirstlane((int)c0[i]));
#pragma unroll
          for (int i = 0; i < 4; ++i) U_ISSUE(i, 4 + i, (unsigned)__builtin_amdgcn_readfirstlane((int)c1[i])); }
#pragma unroll 1
        for (int g2 = 0; g2 < 64; ++g2) {
#pragma unroll
            for (int p = 0; p < 2; ++p) {
                const int r = 8 * g2 + 4 * p, nx = (r + 8 < 508) ? r + 8 : 508;
                const v4u cn = *(const LAS v4u*)(ord + nx); const unsigned cm = ord[r + (lane >> 4)];
                PE_WAITV(8);
                v4u a[8];
#pragma unroll
                for (int s8 = 0; s8 < 8; ++s8) a[s8] = *(const LAS v4u*)ad[p][s8];
                asm volatile("s_waitcnt lgkmcnt(0)" ::: "memory");
#pragma unroll
                for (int i = 0; i < 4; ++i) U_ISSUE(i, 4 * p + i, (unsigned)__builtin_amdgcn_readfirstlane((int)cn[i]));
                v4i d0 = (v4i){0, 0, 0, 0}, d1 = (v4i){0, 0, 0, 0};
#pragma unroll
                for (int s8 = 0; s8 < 8; ++s8)
#pragma unroll
                    for (int c = 0; c < 4; ++c) { if (c & 1) d1 = __builtin_amdgcn_mfma_i32_4x4x4i8((int)a[s8][c], hq[s8][c], d1, 0, 0, 0); else d0 = __builtin_amdgcn_mfma_i32_4x4x4i8((int)a[s8][c], hq[s8][c], d0, 0, 0, 0); }
                unsigned e0 = (unsigned)(d0[0] + d1[0]), e1 = (unsigned)(d0[1] + d1[1]), e2 = (unsigned)(d0[2] + d1[2]), e3 = (unsigned)(d0[3] + d1[3]);
                { const auto t = __builtin_amdgcn_permlane32_swap(e0, e2, false, false); e0 = t[0] + t[1]; }
                { const auto t = __builtin_amdgcn_permlane32_swap(e1, e3, false, false); e1 = t[0] + t[1]; }
                { const auto t = __builtin_amdgcn_permlane16_swap(e0, e1, false, false); e0 = t[0] + t[1]; }
                e0 += (unsigned)__builtin_amdgcn_update_dpp(0, (int)e0, 0x124, 0xf, 0xf, true);
                e0 += (unsigned)__builtin_amdgcn_update_dpp(0, (int)e0, 0x128, 0xf, 0xf, true);
                const float val = (float)(int)e0 * shl * (1.f / 256.f);
                if ((lane & 12) == 0 && ((cm >> 7) & 3u) == (unsigned)bj) lah[cm & 511u] = (_Float16)val;
            }
        }
        asm volatile("s_waitcnt vmcnt(0) lgkmcnt(0)" ::: "memory");
#undef U_ISSUE
#undef U_LO
#undef U_HI
    }
#pragma unroll
    for (int tk = 0; tk < 4; ++tk) {
#pragma unroll
        for (int hb = 0; hb < 2; ++hb) { const unsigned key = hb ? sB[tk] : sA[tk]; const int pos = lane + 64 * hb, e = (int)(key >> 7);
            const float av = (float)lah[tk * PE_SEL + pos] * 256.f * su[e]; lav[tk * PE_SEL + pos] = gelu_erf(av) * (hb ? glB[tk] : glA[tk]) * sv[e]; }
    }
    asm volatile("s_waitcnt vmcnt(0) lgkmcnt(0)" ::: "memory");
    f32x2 acc[4][16];
#pragma unroll
    for (int tk = 0; tk < 4; ++tk)
#pragma unroll
        for (int i = 0; i < 16; ++i) acc[tk][i] = (f32x2){0.f, 0.f};
    {
        unsigned oc = ord[lane], on = ord[64 + lane];
        asm volatile("s_waitcnt lgkmcnt(0)" ::: "memory");
#pragma unroll
        for (int i = 0; i < PE_D; ++i) PE_ISSUE(vt, (unsigned)__builtin_amdgcn_readlane((int)oc, i), i);
        int slot = 0, r = 0; int ptr[4] = {0, 0, 0, 0};
#pragma unroll 1
        for (int s = 0; s < PE_NS; ++s) {
            const unsigned limit = (unsigned)((s + 1) * PE_SLICE) << 7;
#pragma unroll
            for (int tk = 0; tk < 4; ++tk) {
                const int end = __builtin_popcountll(__ballot(sA[tk] < limit)) + __builtin_popcountll(__ballot(sB[tk] < limit));
#pragma unroll 1
                for (int pos = ptr[tk]; pos < end; ++pos) {
                    const float a = lav[tk * PE_SEL + pos];
                    PE_ROW_HEAD(vt)
#pragma unroll
                    for (int j = 0; j < 2; ++j)
#pragma unroll
                        for (int c = 0; c < 4; ++c) { const unsigned wd = w[j][c];
                            acc[tk][8 * j + 2 * c] += __builtin_amdgcn_cvt_pk_f32_fp8((int)wd, false) * a; acc[tk][8 * j + 2 * c + 1] += __builtin_amdgcn_cvt_pk_f32_fp8((int)wd, true) * a; }
                    PE_ROW_TAIL()
                }
                ptr[tk] = end;
            }
            if ((s & (PE_PACE - 1)) == PE_PACE - 1) __builtin_amdgcn_s_barrier();
        }
        asm volatile("s_waitcnt vmcnt(0) lgkmcnt(0)" ::: "memory");
    }
#undef PE_ROW_HEAD
#undef PE_ROW_TAIL
#undef PE_SLOT
#undef PE_ISSUE
    asm volatile("" ::: "memory");
    float sqv[4] = {0.f, 0.f, 0.f, 0.f};
#pragma unroll
    for (int tk = 0; tk < 4; ++tk) {
        const int tok = t0w + tk;
        float* xrow = F.out + (size_t)tok * D;
        float* xdst = dry ? (float*)(F.ws + WS_Z) + (size_t)tok * D : xrow;
        float sq = 0.f;
#pragma unroll
        for (int j = 0; j < 2; ++j) {
            unsigned pk[8];
#pragma unroll
            for (int q = 0; q < 4; ++q) { const int d = j * 1024 + lane * 16 + 4 * q; f32x4 xv = *(const f32x4*)(xrow + d);
                xv.x += acc[tk][8 * j + 2 * q].x; xv.y += acc[tk][8 * j + 2 * q].y; xv.z += acc[tk][8 * j + 2 * q + 1].x; xv.w += acc[tk][8 * j + 2 * q + 1].y;
                *(f32x4*)(xdst + d) = xv;
                if constexpr (LAYER == 0) { sq += (xv.x * xv.x + xv.y * xv.y) + (xv.z * xv.z + xv.w * xv.w); pk[2 * q] = pk2(xv.x, xv.y); pk[2 * q + 1] = pk2(xv.z, xv.w);
                    acc[tk][8 * j + 2 * q] = (f32x2){xv.x, xv.y}; acc[tk][8 * j + 2 * q + 1] = (f32x2){xv.z, xv.w}; } }
            if constexpr (LAYER == 0) { unsigned char* xb = F.ws + WS_XB + ((size_t)tok * D + j * 1024 + lane * 16) * 2;
                *(v4u*)xb = (v4u){pk[0], pk[1], pk[2], pk[3]}; *(v4u*)(xb + 16) = (v4u){pk[4], pk[5], pk[6], pk[7]}; }
            asm volatile("" ::: "memory");
        }
        if constexpr (LAYER == 0) { sq = wave_sum(sq); sqv[tk] = sq; if (lane == 0) ((float*)(F.ws + WS_SSQ))[SSQ_X2 + tok] = sq; }
    }
    if constexpr (LAYER == 0) {
        const float* wf = (const float*)(F.ws + WS_WF) + lane * 16;
        float mine = 0.f;
#pragma unroll 1
        for (int jf = 0; jf < 16; ++jf) {
            f32x2 sacc[4] = {{0.f, 0.f}, {0.f, 0.f}, {0.f, 0.f}, {0.f, 0.f}};
#pragma unroll
            for (int j = 0; j < 2; ++j)
#pragma unroll
                for (int q = 0; q < 4; ++q) { const f32x4 wv = *(const f32x4*)(wf + jf * 2048 + j * 1024 + 4 * q);
#pragma unroll
                    for (int tk = 0; tk < 4; ++tk) { sacc[tk] += acc[tk][8 * j + 2 * q] * (f32x2){wv.x, wv.y}; sacc[tk] += acc[tk][8 * j + 2 * q + 1] * (f32x2){wv.z, wv.w}; } }
            float s0 = sacc[0].x + sacc[0].y, s1 = sacc[1].x + sacc[1].y, s2 = sacc[2].x + sacc[2].y, s3 = sacc[3].x + sacc[3].y;
            { const auto t = __builtin_amdgcn_permlane32_swap(__float_as_uint(s0), __float_as_uint(s2), false, false); s0 = __uint_as_float(t[0]) + __uint_as_float(t[1]); }
            { const auto t = __builtin_amdgcn_permlane32_swap(__float_as_uint(s1), __float_as_uint(s3), false, false); s1 = __uint_as_float(t[0]) + __uint_as_float(t[1]); }
            { const auto t = __builtin_amdgcn_permlane16_swap(__float_as_uint(s0), __float_as_uint(s1), false, false); s0 = __uint_as_float(t[0]) + __uint_as_float(t[1]); }
            s0 += __int_as_float(__builtin_amdgcn_update_dpp(0, __float_as_int(s0), 0x128, 0xf, 0xf, true));
            s0 += __int_as_float(__builtin_amdgcn_update_dpp(0, __float_as_int(s0), 0x124, 0xf, 0xf, true));
            s0 += __int_as_float(__builtin_amdgcn_update_dpp(0, __float_as_int(s0), 0x122, 0xf, 0xf, true));
            s0 += __int_as_float(__builtin_amdgcn_update_dpp(0, __float_as_int(s0), 0x121, 0xf, 0xf, true));
            if ((lane & 15) == jf) mine = s0;
        }
        { const int q = lane >> 4; const float sqq = q == 0 ? sqv[0] : q == 1 ? sqv[1] : q == 2 ? sqv[2] : sqv[3];
          const float rs2 = __builtin_amdgcn_rsqf(sqq * (1.f / 2048.f) + RMS_EPS);
          const float zf = mine * rs2 + I.fox_b_f[lane & 15]; const float ls = fminf(zf, 0.f) - log1pf(__expf(-fabsf(zf)));
          ((float*)(F.ws + WS_LF))[(size_t)(lane & 15) * T + (t0w + q)] = ls; }
    }
}
template <int LAYER>
__device__ __forceinline__ void p_peer(const Frame& F, const In& I, int dry) {
    for (int tb = F.vcu; tb < T / 32; tb += F.G) {
        const int t0 = tb * 32;
        Frame Fo = F; asm volatile("" : "+v"(Fo.lane), "+v"(Fo.tid));
        peer_topk(Fo, LAYER, t0);
        __syncthreads();
#ifdef TOPK_PROBE
        peer_topk(Fo, LAYER, t0);
        __syncthreads();
#endif
        asm volatile("" : "+v"(Fo.lane));
        peer_gather4<LAYER>(Fo, I, t0 + F.wave * 4, F.wave * 4, dry);
        __syncthreads();
    }
}
#ifdef SELFCHECK
constexpr int DG_CHUNK = 8192, DG_MAXCH = 8192, DG_NBUF = 3, DG_NPASS = 4;
constexpr size_t WS_DG = WS_END;
constexpr size_t DG_BYTES = (size_t)DG_NPASS * N_PHASES * DG_NBUF * DG_MAXCH * 8;
__global__ void __launch_bounds__(256) dg_kernel(const void* buf, int is_f32, size_t nelem, float2* dig) {
    const int c = blockIdx.x; const size_t e0 = (size_t)c * DG_CHUNK; float s = 0.f, a = 0.f;
    for (int i = threadIdx.x; i < DG_CHUNK; i += 256) { const size_t e = e0 + i; if (e < nelem) { const float v = is_f32 ? ((const float*)buf)[e] : __uint_as_float((unsigned)((const unsigned short*)buf)[e] << 16);
        const float w = ((i * 2654435761u) >> 13) & 1 ? 1.f : -1.f; s += w * v; a += fabsf(v); } }
    __shared__ float ss[256], sa[256]; ss[threadIdx.x] = s; sa[threadIdx.x] = a; __syncthreads();
    for (int o = 128; o > 0; o >>= 1) { if ((int)threadIdx.x < o) { ss[threadIdx.x] += ss[threadIdx.x + o]; sa[threadIdx.x] += sa[threadIdx.x + o]; } __syncthreads(); }
    if (threadIdx.x == 0) dig[c] = make_float2(ss[0], sa[0]);
}
__global__ void dg_compare(const float2* dig, unsigned* flag  ) {
    const int p = blockIdx.x;
    for (int q = 1; q < DG_NPASS; ++q)
        for (int i = threadIdx.x; i < DG_NBUF * DG_MAXCH; i += blockDim.x) {
            const float2 a = dig[((size_t)0 * N_PHASES + p) * DG_NBUF * DG_MAXCH + i], b = dig[((size_t)q * N_PHASES + p) * DG_NBUF * DG_MAXCH + i];
            if (!(fabsf(a.x - b.x) <= 1e-5f * a.y + 0.02f)) atomicAdd(flag + p, 1u);
        }
}
__global__ void dg_poison(const unsigned* flag, float* out) {
    if (threadIdx.x == 0 && blockIdx.x == 0) { for (int p = 0; p < N_PHASES; ++p) if (flag[p]) { out[0] += 1000.f * (float)(1 << p); break; } }
}
struct DgBuf { size_t off; int is_f32; size_t nelem; };
#endif
#ifdef STAGECHECK
constexpr size_t WS_CK = WS_END;
constexpr int CK_NS = 32;
constexpr size_t WS_CK_ROWS = WS_CK + 4096, WS_CK_TMP = WS_CK_ROWS + (size_t)CK_NS * 2048 * 4;
__device__ __forceinline__ unsigned ck_hash(unsigned a) { a ^= a >> 16; a *= 0x7feb352du; a ^= a >> 15; a *= 0x846ca68bu; a ^= a >> 16; return a; }
__device__ __forceinline__ bool ck_bad(float ref, float got) { return !(fabsf(ref - got) <= 0.03f * fabsf(ref) + 0.03f); }
__device__ __forceinline__ int ck_slot(int t) { const int c = t & 15; return (t & ~15) + (c < 4 ? c : c < 8 ? c + 4 : c < 12 ? c - 4 : c); }
__device__ __forceinline__ void ck_flag(unsigned* flags, int code, bool bad) { if (__any(bad)) { if ((threadIdx.x & 63) == 0) atomicAdd(flags + code, 1u); } }

__global__ void __launch_bounds__(64) ck_save_rows(const float* out, float* rows) {
    const int s = blockIdx.x, t = ck_hash(1000 + s) % T; for (int i = threadIdx.x; i < 2048; i += 64) rows[s * 2048 + i] = out[(size_t)t * 2048 + i];
}
__global__ void __launch_bounds__(64) ck_kernel(int stage, In I, unsigned char* ws, const float* out, unsigned* flags) {
    const int s = blockIdx.x, lane = threadIdx.x;
    __shared__ float sh[4096];
    const bf16* z0 = (const bf16*)(ws + WS_Z0); const float* ssq = (const float*)(ws + WS_SSQ);
    if (stage == 1) {
        const int t = ck_hash(s) % T, n = ck_hash(77 + s) % MLA_IN; float a = 0.f, d = 0.f;
        for (int k = lane; k < 2048; k += 64) { const float x = I.x[(size_t)t * 2048 + k]; a += x * x; d += x * I.g_mix[k] * I.mla_w_in[(size_t)k * MLA_IN + n]; }
        a = wave_sum(a); d = wave_sum(d); const float ref = d * rsqrtf(a / 2048.f + 1e-6f);
        ck_flag(flags, 1, ck_bad(ref, bf2f(z0[(size_t)t * MLA_INP + n])));
    } else if (stage == 2) {
        const int t = ck_hash(s) % T, n = ck_hash(78 + s) % 3072, h = ck_hash(79 + s) % 16, dd = ck_hash(80 + s) % 128; float a = 0.f, b = 0.f, c = 0.f, q = 0.f;
        for (int k = lane; k < 512; k += 64) { const float zq = bf2f(z0[(size_t)t * MLA_INP + k]), zk = bf2f(z0[(size_t)t * MLA_INP + 512 + k]);
            a += zq * I.mla_g_qa[k] * I.mla_w_qb[(size_t)k * 3072 + n]; b += zk * I.mla_g_kva[k] * I.mla_w_kvb[(size_t)k * 4096 + h * 256 + dd]; c += zk * I.mla_g_kva[k] * I.mla_w_kvb[(size_t)k * 4096 + h * 256 + 128 + dd]; q += zk * zk; }
        a = wave_sum(a); b = wave_sum(b); c = wave_sum(c); q = wave_sum(q); c *= rsqrtf(q / 512.f + 1e-6f);
        const bf16* Q = (const bf16*)(ws + WS_Q); const bf16* KN = (const bf16*)(ws + WS_KN); const bf16* VT = (const bf16*)(ws + WS_VT);
        ck_flag(flags, 2, ck_bad(a, bf2f(Q[(size_t)t * 3072 + n])));
        ck_flag(flags, 20, ck_bad(b, bf2f(KN[(size_t)t * 2048 + h * 128 + dd])));
        ck_flag(flags, 21, ck_bad(c, bf2f(VT[(size_t)(h * 128 + dd) * T + ck_slot(t)])));
    } else if (stage == 3) {
        const int t = ck_hash(s) % T, h = ck_hash(81 + s) % 16; float sq = 0.f, skv = 0.f;
        for (int k = lane; k < 512; k += 64) { const float zq = bf2f(z0[(size_t)t * MLA_INP + k]), zk = bf2f(z0[(size_t)t * MLA_INP + 512 + k]); sq += zq * zq; skv += zk * zk; }
        const float rcq = rsqrtf(wave_sum(sq) / 512.f + 1e-6f), rckv = rsqrtf(wave_sum(skv) / 512.f + 1e-6f);
        float qv[3], kv[3];
#pragma unroll
        for (int j = 0; j < 3; ++j) { const int d = lane + 64 * j; float a = 0.f, b = 0.f;
            for (int k = 0; k < 512; ++k) { a += bf2f(z0[(size_t)t * MLA_INP + k]) * I.mla_g_qa[k] * I.mla_w_qb[(size_t)k * 3072 + h * 192 + d];
                if (d < 128) b += bf2f(z0[(size_t)t * MLA_INP + 512 + k]) * I.mla_g_kva[k] * I.mla_w_kvb[(size_t)k * 4096 + h * 256 + d]; }
            qv[j] = a * rcq; kv[j] = (d < 128) ? b * rckv : bf2f(z0[(size_t)t * MLA_INP + 1024 + (d - 128)]); }
        const float rq = rsqrtf(wave_sum(qv[0] * qv[0] + qv[1] * qv[1] + qv[2] * qv[2]) / 192.f + 1e-6f), rk = rsqrtf(wave_sum(kv[0] * kv[0] + kv[1] * kv[1] + kv[2] * kv[2]) / 192.f + 1e-6f);
#pragma unroll
        for (int j = 0; j < 3; ++j) { qv[j] *= rq * I.mla_g_q[lane + 64 * j]; kv[j] *= rk * I.mla_g_k[lane + 64 * j]; }
        const float inv_freq = powf(10000.0f, -(float)(2 * (lane & 31)) / 64.0f), ang = (float)I.pos[t] * inv_freq, cs = cosf(ang), sn = sinf(ang);
        const float pq = __shfl_xor(qv[2], 32), pk = __shfl_xor(kv[2], 32);
        qv[2] = (lane < 32) ? qv[2] * cs - pq * sn : qv[2] * cs + pq * sn; kv[2] = (lane < 32) ? kv[2] * cs - pk * sn : kv[2] * cs + pk * sn;
        const float QS = 0.07216878364870322f * LOG2E; const bf16* Q = (const bf16*)(ws + WS_Q); const bf16* KM = (const bf16*)(ws + WS_KM); bool bad = false, badk = false;
#pragma unroll
        for (int j = 0; j < 3; ++j) { bad |= ck_bad(qv[j] * QS * 4.f, 4.f * bf2f(Q[(size_t)t * 3072 + h * 192 + lane + 64 * j])); badk |= ck_bad(kv[j], bf2f(KM[(size_t)t * 3072 + h * 192 + lane + 64 * j])); }
        ck_flag(flags, 3, bad); ck_flag(flags, 22, badk);
    } else if (stage == 4 || stage == 10) {
        const bool fox = stage == 10; const int t = ck_hash(s) % T, h = ck_hash(82 + s) % 16, b = t / SEQ, tq = t % SEQ, DKK = fox ? 128 : 192;
        const bf16* Q = fox ? (const bf16*)(ws + WS_Z) : (const bf16*)(ws + WS_Q); const bf16* K = fox ? (const bf16*)(ws + WS_Z) + 2048 : (const bf16*)(ws + WS_KM); const int pitch = fox ? FOX_ZN : 3072;
        const bf16* VT = (const bf16*)(ws + WS_VT); const float* lf = (const float*)(ws + WS_LF);
        const int nk = fox ? tq + 1 : 64 * (tq / 64 + 1);
        if (fox) { if (lane == 0) { float c = 0.f; for (int i = 0; i < nk; ++i) { c += lf[(size_t)(b * SEQ + i) * 16 + h]; sh[2048 + i] = c; } } __syncthreads(); }
        float mx = -1e30f;
        for (int sk = lane; sk < nk; sk += 64) { float d = 0.f; for (int e = 0; e < DKK; ++e) d += bf2f(Q[(size_t)t * pitch + h * DKK + e]) * bf2f(K[(size_t)(b * SEQ + sk) * pitch + h * DKK + e]);
            if (fox) d += (sh[2048 + tq] - sh[2048 + sk]) * LOG2E; sh[sk] = d; mx = fmaxf(mx, d); }
        for (int o = 1; o < 64; o <<= 1) mx = fmaxf(mx, __shfl_xor(mx, o));
        __syncthreads();
        float l = 0.f; for (int sk = lane; sk < nk; sk += 64) { const float p = exp2f(sh[sk] - mx); sh[sk] = p; l += p; } l = wave_sum(l);
        __syncthreads();
        bool bad = false;
        for (int j = 0; j < 2; ++j) { const int dv = lane + 64 * j; float o = 0.f; for (int sk = 0; sk < nk; ++sk) o += sh[sk] * bf2f(VT[(size_t)(h * 128 + dv) * T + ck_slot(b * SEQ + sk)]); o /= l;
            if (fox) o *= 1.f / (1.f + expf(-bf2f(((const bf16*)(ws + WS_Z))[(size_t)t * FOX_ZN + 4096 + h * 128 + dv])));
            bad |= ck_bad(o * 8.f, 8.f * bf2f(((const bf16*)(ws + WS_O))[(size_t)t * 2048 + h * 128 + dv])); }
        ck_flag(flags, stage, bad);
    } else if (stage == 5 || stage == 11) {
        const int t = (stage == 5) ? ck_hash(s) % T : ck_hash(1000 + s) % T, n = ck_hash(83 + s) % 2048; const float* wo = (stage == 5) ? I.mla_w_o : I.fox_w_o; float d = 0.f;
        for (int k = lane; k < 2048; k += 64) d += bf2f(((const bf16*)(ws + WS_O))[(size_t)t * 2048 + k]) * wo[(size_t)k * 2048 + n];
        d = wave_sum(d); const float xo = (stage == 5) ? I.x[(size_t)t * 2048 + n] : ((const float*)(ws + WS_CK_ROWS))[s * 2048 + n];
        ck_flag(flags, stage, ck_bad(xo + d, out[(size_t)t * 2048 + n]));
    } else if (stage == 6 || stage == 12) {
        const int L = stage == 12, t = ck_hash(s) % T, n = ck_hash(84 + s) % 2048; float d = 0.f;
        for (int k = lane; k < 2048; k += 64) d += bf2f(((const bf16*)(ws + WS_XB))[(size_t)t * 2048 + k]) * I.g_ffn[L * 2048 + k] * I.pe_wq[(size_t)L * 2048 * 2048 + (size_t)k * 2048 + n];
        d = wave_sum(d); ck_flag(flags, stage, ck_bad(d, bf2f(((const bf16*)(ws + WS_QP))[(size_t)t * 2048 + n])));
    } else if (stage == 7 || stage == 13) {
        const int L = stage == 13, t = ck_hash(1000 + s) % T; const float* xo = (const float*)(ws + WS_CK_ROWS) + s * 2048; float* tmp = (float*)(ws + WS_CK_TMP) + (size_t)s * 8192;
        float a = 0.f; for (int k = lane; k < 2048; k += 64) a += xo[k] * xo[k]; const float r = rsqrtf(wave_sum(a) / 2048.f + 1e-6f);
        for (int k = lane; k < 2048; k += 64) tmp[k] = xo[k] * r * I.g_ffn[L * 2048 + k];
        __syncthreads();
        for (int n = lane; n < 2048; n += 64) { float d = 0.f; for (int k = 0; k < 2048; ++k) d += tmp[k] * I.pe_wq[(size_t)L * 2048 * 2048 + (size_t)k * 2048 + n]; tmp[2048 + n] = d; }
        __syncthreads();
        for (int hq = 0; hq < 8; ++hq) {
            for (int c = 0; c < 2; ++c) for (int n = lane; n < 128; n += 64) { float d = 0.f; for (int e = 0; e < 128; ++e) d += tmp[2048 + hq * 256 + c * 128 + e] * I.pe_sk[((size_t)(L * 2 + c) * 128 + n) * 128 + e]; sh[c * 128 + n] = d; }
            __syncthreads();
            if (lane == 0) {
                for (int c = 0; c < 2; ++c) for (int k = 0; k < 16; ++k) { int bi = 0; float bv = -1e30f; for (int n = 0; n < 128; ++n) if (sh[c * 128 + n] > bv) { bv = sh[c * 128 + n]; bi = n; } sh[256 + c * 16 + k] = bv; sh[288 + c * 16 + k] = (float)bi; sh[c * 128 + bi] = -1e30f; }
                for (int i = 0; i < 16; ++i) for (int j = 0; j < 16; ++j) sh[512 + i * 16 + j] = sh[256 + i] + sh[272 + j];
                float b0 = 0.f, sum = 0.f;
                for (int k = 0; k < 16; ++k) { int bi = 0; float bv = -1e30f; for (int n = 0; n < 256; ++n) if (sh[512 + n] > bv) { bv = sh[512 + n]; bi = n; } if (k == 0) b0 = bv;
                    const float w = expf(bv - b0); sum += w; tmp[4096 + hq * 32 + k] = sh[288 + (bi >> 4)] * 128.f + sh[304 + (bi & 15)]; tmp[4096 + hq * 32 + 16 + k] = w; sh[512 + bi] = -1e30f; }
                for (int k = 0; k < 16; ++k) tmp[4096 + hq * 32 + 16 + k] /= sum;
            }
            __syncthreads();
        }
        for (int k = 0; k < 128; ++k) { const int e = (int)tmp[4096 + (k >> 4) * 32 + (k & 15)]; float d = 0.f; for (int i = lane; i < 2048; i += 64) d += I.pe_u[((size_t)L * PE_NE + e) * 2048 + i] * tmp[i]; d = wave_sum(d);
            if (lane == 0) tmp[6144 + k] = 0.5f * d * (1.f + erff(d * 0.7071067811865476f)) * tmp[4096 + (k >> 4) * 32 + 16 + (k & 15)]; }
        __syncthreads();
        { const int* di = (const int*)(ws + WS_END + 8 * MiB) + (size_t)t * 128; const float* dg = (const float*)(ws + WS_END + 12 * MiB) + (size_t)t * 128; const float* da = (const float*)(ws + WS_END + 16 * MiB) + (size_t)t * 128;
          int nf = 0; bool bg = false, ba = false;
          for (int k = lane; k < 128; k += 64) { const int e = (int)tmp[4096 + (k >> 4) * 32 + (k & 15)]; int f = -1; for (int m = 0; m < 16; ++m) if (di[(k & ~15) + m] == e) f = (k & ~15) + m;
              if (f < 0) ++nf; else { bg |= !(fabsf(dg[f] - tmp[4096 + (k >> 4) * 32 + 16 + (k & 15)]) <= 0.05f * dg[f] + 0.003f); ba |= !(fabsf(da[f] - tmp[6144 + k]) <= 0.05f * fabsf(da[f]) + 0.004f); } }
          nf = (int)wave_sum((float)nf);
          ck_flag(flags, 23, nf > 8); ck_flag(flags, 24, bg); ck_flag(flags, 25, ba); }
        bool bad = false;
        for (int j = 0; j < 4; ++j) { const int d = (lane * 4 + j * 256 + (int)(ck_hash(s) & 3)) & 2047; float o = 0.f; { const int* di = (const int*)(ws + WS_END + 8 * MiB) + (size_t)t * 128; const float* da = (const float*)(ws + WS_END + 16 * MiB) + (size_t)t * 128; for (int k = 0; k < 128; ++k) o += da[k] * I.pe_v[((size_t)L * PE_NE + di[k]) * 2048 + d]; }
            bad |= ck_bad((xo[d] + o), out[(size_t)t * 2048 + d]); }
        ck_flag(flags, stage, bad);
    } else if (stage == 9) {
        const int t = ck_hash(s) % T, h = ck_hash(86 + s) % 16; const float r2 = rsqrtf(ssq[SSQ_X2 + t] / 2048.f + 1e-6f); float qv[2], kv[2];
#pragma unroll
        for (int j = 0; j < 2; ++j) { const int d = lane + 64 * j; float a = 0.f, b = 0.f;
            for (int k = 0; k < 2048; ++k) { const float xv = bf2f(((const bf16*)(ws + WS_XB))[(size_t)t * 2048 + k]) * I.g_mix[2048 + k]; a += xv * I.fox_w_in[(size_t)k * 8208 + h * 128 + d]; b += xv * I.fox_w_in[(size_t)k * 8208 + 2048 + h * 128 + d]; }
            qv[j] = a * r2; kv[j] = b * r2; }
        const float rq = rsqrtf(wave_sum(qv[0] * qv[0] + qv[1] * qv[1]) / 128.f + 1e-6f) * 0.08838834764831845f * LOG2E, rk = rsqrtf(wave_sum(kv[0] * kv[0] + kv[1] * kv[1]) / 128.f + 1e-6f);
        bool bad = false;
#pragma unroll
        for (int j = 0; j < 2; ++j) { const int d = lane + 64 * j; bad |= ck_bad(4.f * qv[j] * rq * I.fox_g_q[d], 4.f * bf2f(((const bf16*)(ws + WS_Z))[(size_t)t * FOX_ZN + h * 128 + d]));
            bad |= ck_bad(kv[j] * rk * I.fox_g_k[d], bf2f(((const bf16*)(ws + WS_Z))[(size_t)t * FOX_ZN + 2048 + h * 128 + d])); }
        ck_flag(flags, 9, bad);
    } else if (stage == 8) {
        const int t = ck_hash(s) % T, n = ck_hash(85 + s) % 8192; float d = 0.f;
        for (int k = lane; k < 2048; k += 64) d += bf2f(((const bf16*)(ws + WS_XB))[(size_t)t * 2048 + k]) * I.g_mix[2048 + k] * I.fox_w_in[(size_t)k * 8208 + n];
        d = wave_sum(d) * rsqrtf(ssq[SSQ_X2 + t] / 2048.f + 1e-6f);
        const int sec = n >> 11, c = n & 2047; float got;
        if (sec == 2) got = bf2f(((const bf16*)(ws + WS_VT))[(size_t)c * T + ck_slot(t)]); else got = bf2f(((const bf16*)(ws + WS_Z))[(size_t)t * FOX_ZN + (sec == 3 ? 4096 : sec * 2048) + c]);
        ck_flag(flags, 8, ck_bad(d, got));
    }
}
__global__ void ck_poison(const unsigned* flags, float* out) {
    if (threadIdx.x == 0 && blockIdx.x == 0) { const int order[19] = {1, 2, 20, 21, 3, 22, 4, 5, 6, 23, 24, 25, 7, 8, 9, 10, 11, 12, 13};
        for (int i = 0; i < 19; ++i) if (flags[order[i]]) { out[0] += 1000.f * (float)(1 << (i + 1)); break; } }
}
#endif
#ifndef MK_N_LAUNCHES
#define MK_N_LAUNCHES 1
#endif
struct Args { const void* in[21]; float* out; unsigned char* ws; int ph_lo, ph_hi, rep, pad; };
static_assert(sizeof(Args) == 21 * 8 + 8 + 8 + 16, "Args has no padding");

__global__ void __launch_bounds__(NWAVES * 64, 2) mk_fwd(Args args) {
    extern __shared__ __attribute__((aligned(16))) unsigned char lds_raw[];
    Frame F;
    F.lds = (LAS unsigned char*)lds_raw;
    volatile LAS unsigned* MISC = (volatile LAS unsigned*)(F.lds + MISC_OFF);
    F.tid = threadIdx.x; F.lane = F.tid & 63; F.wave = __builtin_amdgcn_readfirstlane(F.tid >> 6);
    F.G = gridDim.x; { const int bx = blockIdx.x; F.vcu = (F.G % 8 == 0) ? (bx % 8) * (F.G / 8) + bx / 8 : bx; }
    F.ws = args.ws; F.out = args.out;
    In I;
    I.x = (const float*)args.in[0]; I.pos = (const int*)args.in[1]; I.g_mix = (const float*)args.in[2]; I.g_ffn = (const float*)args.in[3];
    I.mla_w_in = (const float*)args.in[4]; I.mla_g_qa = (const float*)args.in[5]; I.mla_w_qb = (const float*)args.in[6]; I.mla_g_kva = (const float*)args.in[7];
    I.mla_w_kvb = (const float*)args.in[8]; I.mla_g_q = (const float*)args.in[9]; I.mla_g_k = (const float*)args.in[10]; I.mla_w_o = (const float*)args.in[11];
    I.fox_w_in = (const float*)args.in[12]; I.fox_b_f = (const float*)args.in[13]; I.fox_g_q = (const float*)args.in[14]; I.fox_g_k = (const float*)args.in[15];
    I.fox_w_o = (const float*)args.in[16]; I.pe_wq = (const float*)args.in[17]; I.pe_sk = (const float*)args.in[18]; I.pe_u = (const float*)args.in[19]; I.pe_v = (const float*)args.in[20];
    for (int u = F.tid; u < (LDS_BYTES - LDSCTL_OFF) / 4; u += NWAVES * 64) ((LAS unsigned*)(F.lds + LDSCTL_OFF))[u] = 0u;
    __syncthreads();
    unsigned* ctl = (unsigned*)(F.ws + WS_CTL);
    XcdBarrier bar; bar.bar = ctl + CW_BAR; bar.x = 0; bar.st = nullptr;
    const int lo = args.ph_lo, hi = args.ph_hi;
    if (hi - lo > 1) bar = xcd_barrier_post(ctl + CW_BAR, MISC + 8);
#ifndef PH_MASK
#define PH_MASK 0x3fff
#endif
#define IN(k) (((PH_MASK >> (k)) & 1) && lo <= (k) && (k) < hi)
#define SEAM(k) do { if (IN(k) && IN((k) + 1)) xcd_barrier(bar); } while (0)
#ifdef TIMING_PROBE
#define REPS(k) ((TIMING_PROBE >> (k)) & 1)
#else
#define REPS(k) 0
#endif
    unsigned char* ws = F.ws;
    float* ssq = (float*)(ws + WS_SSQ);
    const int bid = (int)blockIdx.x;

    if (IN(0)) { for (int rp = REPS(0); rp >= 0; --rp) { p_prologue(F, I); if (rp) xcd_barrier(bar); } SEAM(0); }

    if (IN(1)) { for (int rp = REPS(1); rp >= 0; --rp) {
        pg8::Gemm g{(const bf16*)(ws + WS_XB), (const bf16*)(ws + WS_WT_MLA_IN), T, MLA_INP, D, D, D}; pg8::StaticOrder S; S.init(T, MLA_INP, F.G, bid);
        pg8::EpiRowScale E{(bf16*)(ws + WS_Z0), MLA_INP, ssq + SSQ_X0, 1, 1.f / 2048.f, ssq + SSQ_CQ, ssq + SSQ_CKV, 2, 4, 8};
        pg8::gemm_phase<pg8::EpiRowScale, pg8::StaticOrder, false>(F.lds + RING_OFF, g, S, E);
        if (bid >= 160) p_table_fill(F, I, 16384, 16384, (bid - 160) * NWAVES + F.wave, 96 * NWAVES);
        if (rp) xcd_barrier(bar); }
        SEAM(1);
    }
    if (IN(2)) { for (int rp = REPS(2); rp >= 0; --rp) {
        p_mla_tok(F, I);
        { pg8::Gemm g{(const bf16*)(ws + WS_Z0), (const bf16*)(ws + WS_WT_QB), T, MLA_QN, 512, MLA_INP, 512}; pg8::StaticOrder S; S.init(T, MLA_QN, F.G, bid);
          pg8::EpiRowScale E{(bf16*)(ws + WS_Q), MLA_QN, nullptr, 0, 0.f, nullptr, nullptr, 0, 0, 0};
          pg8::gemm_phase<pg8::EpiRowScale, pg8::StaticOrder, true>(F.lds + RING_OFF, g, S, E);
          if (bid >= 128) p_table_fill(F, I, 49152, PE_FILL2, (bid - 128) * NWAVES + F.wave, 128 * NWAVES); }
        { pg8::Gemm g{(const bf16*)(ws + WS_Z0) + 512, (const bf16*)(ws + WS_WT_KVB), T, 2048, 512, MLA_INP, 512}; pg8::StaticOrder S; S.init(T, 2048, F.G, bid);
          pg8::EpiRowScale E{(bf16*)(ws + WS_KN), 2048, nullptr, 0, 0.f, nullptr, nullptr, 0, 0, 0, (float*)(ws + WS_KSQM), 0, 8};
          pg8::gemm_phase<pg8::EpiRowScale, pg8::StaticOrder, true>(F.lds + RING_OFF, g, S, E); }
        { pg8::Gemm g{(const bf16*)(ws + WS_WT_KVB) + (size_t)2048 * 512, (const bf16*)(ws + WS_Z0) + 512, 2048, T, 512, 512, MLA_INP}; pg8::StaticOrder S; S.init(2048, T, F.G, bid);
          pg8::EpiColScale E{(bf16*)(ws + WS_VT), T, ssq + SSQ_CKV, 8, 1.f / 512.f};
          pg8::gemm_phase<pg8::EpiColScale, pg8::StaticOrder, true>(F.lds + RING_OFF, g, S, E); }
        if (rp) xcd_barrier(bar); }
        SEAM(2);
    }
    if (IN(4)) { for (int rp = REPS(4); rp >= 0; --rp) {
        const AttnAux ax{I.mla_g_q, I.mla_g_k, (const float*)(ws + WS_KSQM), ssq + SSQ_CQ, (const float*)(ws + WS_ROPE), (const float*)(ws + WS_RCKV), (const float*)(ws + WS_KRSS), (const bf16*)(ws + WS_KRG)};
        p_attention<192, false>(F, (const bf16*)(ws + WS_Q), MLA_QN, (const bf16*)(ws + WS_KN), 2048, (const bf16*)(ws + WS_VT), (bf16*)(ws + WS_O), nullptr, 0, nullptr, ax);
        if (rp) xcd_barrier(bar); }
        SEAM(4);
    }
    if (IN(5)) { for (int rp = REPS(5); rp >= 0; --rp) {
        pg8::Gemm g{(const bf16*)(ws + WS_O), (const bf16*)(ws + WS_WT_MLA_O), T, D, D, D, D}; pg8::StaticOrder S; S.init(T, D, F.G, bid);
        pg8::EpiResidual E{I.x, F.out, (bf16*)(ws + WS_XB), D, ssq + SSQ_XS};
        pg8::gemm_phase<pg8::EpiResidual, pg8::StaticOrder, false>(F.lds + RING_OFF, g, S, E);
        if (rp) xcd_barrier(bar); }
        SEAM(5);
    }
    if (IN(6)) { for (int rp = REPS(6); rp >= 0; --rp) {
        pg8::Gemm g{(const bf16*)(ws + WS_XB), (const bf16*)(ws + WS_WT_PQ), T, D, D, D, D}; pg8::StaticOrder S; S.init(T, D, F.G, bid);
        pg8::EpiRowScale E{(bf16*)(ws + WS_QP), D, nullptr, 0, 0.f, nullptr, nullptr, 0, 0, 0};
        pg8::gemm_phase<pg8::EpiRowScale, pg8::StaticOrder, false>(F.lds + RING_OFF, g, S, E);
        if (rp) xcd_barrier(bar); }
        SEAM(6);
    }
    if (IN(7)) { for (int rp = REPS(7); rp >= 0; --rp) { p_peer<0>(F, I, rp); if (rp) xcd_barrier(bar); } SEAM(7); }
    if (IN(8)) { for (int rp = REPS(8); rp >= 0; --rp) {
        { pg8::Gemm g{(const bf16*)(ws + WS_XB), (const bf16*)(ws + WS_WT_FOX_IN), T, FOX_ZN, D, D, D}; pg8::StaticOrder S; S.init(T, FOX_ZN, F.G, bid);
          pg8::EpiRowScale E{(bf16*)(ws + WS_Z), FOX_ZN, ssq + SSQ_X2, 1, 1.f / 2048.f, nullptr, nullptr, 0, 0, 0, (float*)(ws + WS_KSQ), 8, 16};
          pg8::gemm_phase<pg8::EpiRowScale, pg8::StaticOrder, true>(F.lds + RING_OFF, g, S, E); }
        { pg8::Gemm g{(const bf16*)(ws + WS_WT_FOX_IN) + (size_t)FOX_ZN * D, (const bf16*)(ws + WS_XB), 2048, T, D, D, D}; pg8::StaticOrder S; S.init(2048, T, F.G, bid);
          pg8::EpiColScale E{(bf16*)(ws + WS_VT), T, ssq + SSQ_X2, 1, 1.f / 2048.f};
          pg8::gemm_phase<pg8::EpiColScale, pg8::StaticOrder, true>(F.lds + RING_OFF, g, S, E); }
        if (rp) xcd_barrier(bar); }
        SEAM(8);
    }
    if (IN(10)) { for (int rp = REPS(10); rp >= 0; --rp) {
        p_attention<128, true>(F, (const bf16*)(ws + WS_Z), FOX_ZN, (const bf16*)(ws + WS_Z) + 2048, FOX_ZN, (const bf16*)(ws + WS_VT), (bf16*)(ws + WS_O), (const bf16*)(ws + WS_Z) + 4096, FOX_ZN, (const float*)(ws + WS_LF), AttnAux{I.fox_g_q, I.fox_g_k, (const float*)(ws + WS_KSQ), nullptr, nullptr, nullptr, nullptr, nullptr});
        if (rp) xcd_barrier(bar); }
        SEAM(10);
    }
    if (IN(11)) {
        pg8::Gemm g{(const bf16*)(ws + WS_O), (const bf16*)(ws + WS_WT_FOX_O), T, D, D, D, D}; pg8::StaticOrder S; S.init(T, D, F.G, bid);
        pg8::EpiResidual E{F.out, F.out, (bf16*)(ws + WS_XB), D, ssq + SSQ_XS};
        pg8::gemm_phase<pg8::EpiResidual, pg8::StaticOrder, false>(F.lds + RING_OFF, g, S, E);
        SEAM(11);
    }
    if (IN(12)) { for (int rp = REPS(12); rp >= 0; --rp) {
        pg8::Gemm g{(const bf16*)(ws + WS_XB), (const bf16*)(ws + WS_WT_PQ + 8 * MiB), T, D, D, D, D}; pg8::StaticOrder S; S.init(T, D, F.G, bid);
        pg8::EpiRowScale E{(bf16*)(ws + WS_QP), D, nullptr, 0, 0.f, nullptr, nullptr, 0, 0, 0};
        pg8::gemm_phase<pg8::EpiRowScale, pg8::StaticOrder, false>(F.lds + RING_OFF, g, S, E);
        if (rp) xcd_barrier(bar); }
        SEAM(12);
    }
    if (IN(13)) { for (int rp = REPS(13); rp >= 0; --rp) { p_peer<1>(F, I, rp); if (rp) xcd_barrier(bar); } }
#ifdef PROF
    if (hi - lo > 1) { xcd_barrier(bar); if (blockIdx.x == 0 && F.tid == 0) { float v = __uint_as_float(__hip_atomic_load(ctl + 70, __ATOMIC_RELAXED, __HIP_MEMORY_SCOPE_AGENT)); v = fminf(fmaxf(v, 0.f), 1.5f); v = rintf(v * 12.f) * (1.f / 12.f); F.out[0] += 1000.f * __builtin_exp10f(v);        } }
#endif
#ifdef BARRIER_PROBE
    if (hi - lo > 1) { for (int i = 0; i < 8; ++i) xcd_barrier(bar); }
#endif
#ifdef FP6_SELFTEST
    if (hi - lo > 1) { xcd_barrier(bar); if (blockIdx.x == 0 && F.tid == 0 && __hip_atomic_load(ctl + 64, __ATOMIC_RELAXED, __HIP_MEMORY_SCOPE_AGENT)) F.out[0] += 1.0e6f; }
#endif
#undef IN
#undef SEAM
}

extern "C" void kernel_launch(void* const* d_in, const int* in_sizes, int n_in, void* d_out, int out_size, void* d_ws, size_t ws_size, hipStream_t stream) {
    static int grid = 0;
    if (grid == 0) {
        if (n_in != 21 || out_size != T * D || ws_size < WS_END) { fprintf(stderr, "kernel_launch: unexpected shapes (n_in %d out %d ws %zu need %zu)\n", n_in, out_size, ws_size, (size_t)WS_END); grid = -1; return; }
        int dev = 0, cus = 0, per_cu = 0;
        if (hipGetDevice(&dev) != hipSuccess || hipDeviceGetAttribute(&cus, hipDeviceAttributeMultiprocessorCount, dev) != hipSuccess) { grid = -1; return; }
        if (hipFuncSetAttribute((const void*)mk_fwd, hipFuncAttributeMaxDynamicSharedMemorySize, LDS_BYTES) != hipSuccess) { fprintf(stderr, "kernel_launch: hipFuncSetAttribute failed\n"); grid = -1; return; }
        if (hipOccupancyMaxActiveBlocksPerMultiprocessor(&per_cu, (const void*)mk_fwd, NWAVES * 64, LDS_BYTES) != hipSuccess || per_cu < 1) { fprintf(stderr, "kernel_launch: occupancy query says %d\n", per_cu); }
        (void)hipGetLastError();
        grid = cus;
    }
    if (grid < 0) return;
    (void)hipMemsetAsync((char*)d_ws + WS_CTL, 0, CTL_ZERO_BYTES, stream);
    Args a{};
    for (int i = 0; i < 21; ++i) a.in[i] = d_in[i];
    a.out = (float*)d_out; a.ws = (unsigned char*)d_ws;
#ifdef TIMING_PROBE
    a.rep = TIMING_PROBE;
#endif
#ifdef STAGECHECK
    {
        unsigned char* ws = (unsigned char*)d_ws; unsigned* flags = (unsigned*)(ws + WS_CK); float* rows = (float*)(ws + WS_CK_ROWS);
        (void)hipMemsetAsync(ws + WS_CK, 0, 4096, stream);
        In I; { const void* const* in = a.in; I.x = (const float*)in[0]; I.pos = (const int*)in[1]; I.g_mix = (const float*)in[2]; I.g_ffn = (const float*)in[3]; I.mla_w_in = (const float*)in[4]; I.mla_g_qa = (const float*)in[5];
            I.mla_w_qb = (const float*)in[6]; I.mla_g_kva = (const float*)in[7]; I.mla_w_kvb = (const float*)in[8]; I.mla_g_q = (const float*)in[9]; I.mla_g_k = (const float*)in[10]; I.mla_w_o = (const float*)in[11];
            I.fox_w_in = (const float*)in[12]; I.fox_b_f = (const float*)in[13]; I.fox_g_q = (const float*)in[14]; I.fox_g_k = (const float*)in[15]; I.fox_w_o = (const float*)in[16]; I.pe_wq = (const float*)in[17];
            I.pe_sk = (const float*)in[18]; I.pe_u = (const float*)in[19]; I.pe_v = (const float*)in[20]; }
        for (int p = 0; p < N_PHASES; ++p) {
            if (p == 7 || p == 11 || p == 13) hipLaunchKernelGGL(ck_save_rows, dim3(CK_NS), dim3(64), 0, stream, (const float*)d_out, rows);
            a.ph_lo = p; a.ph_hi = p + 1; hipLaunchKernelGGL(mk_fwd, dim3(grid), dim3(NWAVES * 64), LDS_BYTES, stream, a);
            if (p >= 1) hipLaunchKernelGGL(ck_kernel, dim3(CK_NS), dim3(64), 0, stream, p, I, ws, (const float*)d_out, flags);
        }
        hipLaunchKernelGGL(ck_poison, dim3(1), dim3(64), 0, stream, (const unsigned*)flags, (float*)d_out);
    }
#elif defined(SELFCHECK)
    {
        unsigned char* ws = (unsigned char*)d_ws;
        (void)hipMemsetAsync(ws + WS_DG, 0, DG_BYTES, stream);
        unsigned* flag = (unsigned*)(ws + 64 * 1024);
        const size_t OUTB = (size_t)-1;
        const DgBuf bufs[N_PHASES][DG_NBUF] = {
            {{WS_XB, 0, (size_t)T * D}, {WS_WT_MLA_IN, 0, (size_t)40 * 1024 * 1024}, {WS_PU, 0, (size_t)64 * 1024 * 1024}},
            {{WS_Z0, 0, (size_t)T * MLA_INP}, {0, 0, 0}, {0, 0, 0}},
            {{WS_Q, 0, (size_t)T * MLA_QN}, {WS_KN, 0, (size_t)T * 2048}, {WS_VT, 0, (size_t)T * 2048}},
            {{WS_Q, 0, (size_t)T * MLA_QN}, {WS_KM, 0, (size_t)T * MLA_QN}, {0, 0, 0}},
            {{WS_O, 0, (size_t)T * D}, {0, 0, 0}, {0, 0, 0}},
            {{OUTB, 1, (size_t)T * D}, {WS_XB, 0, (size_t)T * D}, {0, 0, 0}},
            {{WS_QP, 0, (size_t)T * D}, {0, 0, 0}, {0, 0, 0}},
            {{OUTB, 1, (size_t)T * D}, {WS_XB, 0, (size_t)T * D}, {WS_LF, 1, (size_t)T * 16}},
            {{WS_Z, 0, (size_t)T * FOX_ZN}, {WS_VT, 0, (size_t)T * 2048}, {0, 0, 0}},
            {{WS_Z, 0, (size_t)T * FOX_ZN}, {0, 0, 0}, {0, 0, 0}},
            {{WS_O, 0, (size_t)T * D}, {0, 0, 0}, {0, 0, 0}},
            {{OUTB, 1, (size_t)T * D}, {WS_XB, 0, (size_t)T * D}, {0, 0, 0}},
            {{WS_QP, 0, (size_t)T * D}, {0, 0, 0}, {0, 0, 0}},
            {{OUTB, 1, (size_t)T * D}, {0, 0, 0}, {0, 0, 0}}};
        for (int pass = 0; pass < DG_NPASS; ++pass) {
            for (int p = 0; p < N_PHASES; ++p) {
                a.ph_lo = p; a.ph_hi = p + 1; hipLaunchKernelGGL(mk_fwd, dim3(grid), dim3(NWAVES * 64), LDS_BYTES, stream, a);
                for (int b = 0; b < DG_NBUF; ++b) { const DgBuf& B = bufs[p][b]; if (!B.nelem) continue;
                    size_t ne = B.nelem; if (ne > (size_t)DG_MAXCH * DG_CHUNK) ne = (size_t)DG_MAXCH * DG_CHUNK;
                    const void* ptr = (B.off == OUTB) ? (const void*)d_out : (const void*)(ws + B.off);
                    float2* dig = (float2*)(ws + WS_DG) + (((size_t)pass * N_PHASES + p) * DG_NBUF + b) * DG_MAXCH;
                    hipLaunchKernelGGL(dg_kernel, dim3((unsigned)((ne + DG_CHUNK - 1) / DG_CHUNK)), dim3(256), 0, stream, ptr, B.is_f32, ne, dig); }
            }
        }
        hipLaunchKernelGGL(dg_compare, dim3(N_PHASES), dim3(256), 0, stream, (const float2*)(ws + WS_DG), flag);
        hipLaunchKernelGGL(dg_poison, dim3(1), dim3(64), 0, stream, (const unsigned*)flag, (float*)d_out);
    }
#elif MK_N_LAUNCHES == 1
    a.ph_lo = 0; a.ph_hi = N_PHASES;
    hipLaunchKernelGGL(mk_fwd, dim3(grid), dim3(NWAVES * 64), LDS_BYTES, stream, a);
#else
    for (int p = 0; p < N_PHASES; ++p) { a.ph_lo = p; a.ph_hi = p + 1; hipLaunchKernelGGL(mk_fwd, dim3(grid), dim3(NWAVES * 64), LDS_BYTES, stream, a); }
#endif
}
```

```cpp
#include <hip/hip_runtime.h>
#include <cstdio>
#include <cstdint>
namespace pg8 {
#define PG8_LAS __attribute__((address_space(3)))
typedef unsigned short bf16_t;
typedef short bf16x8 __attribute__((ext_vector_type(8)));
typedef float f32x4 __attribute__((ext_vector_type(4)));
typedef unsigned u32x4 __attribute__((ext_vector_type(4)));
typedef unsigned u32x2 __attribute__((ext_vector_type(2)));
constexpr int BM = 256, BK = 64, HALF = 128, HTB = HALF * BK * 2  , STAGE_BYTES = 8 * HTB, NXCD = 8, WGM = 8;

__host__ __device__ __forceinline__ int lds_byte(int r, int c) { const int st = (r >> 4) * 2 + (c >> 5), rr = r & 15, cc = c & 31, ob = rr * 64 + cc * 2; return st * 1024 + (ob ^ (((ob >> 9) & 1) << 5)); }
__host__ __device__ __forceinline__ void stage_rc(int b, int& R, int& C) { const int st = b / 1024, sb = b % 1024, swz = sb ^ (((sb >> 9) & 1) << 5); R = (st >> 1) * 16 + swz / 64; C = (st & 1) * 32 + (swz % 64) / 2; }
__host__ __device__ __forceinline__ int perm32(int rho) { const int n = rho >> 4, i = rho & 15; return 8 * (i >> 2) + 4 * n + (i & 3); }

struct Unit { int pm, pn; };
struct Gemm { const bf16_t* A; const bf16_t* Bt; int M, N, K, lda, ldb; };

struct StaticOrder {
    int nM, nN, nwg, G, c;
    __host__ __device__ void init(int M, int N, int G_, int c_) { nM = M / BM; nN = N / BM; nwg = nM * nN; G = G_; c = c_; }
    __host__ __device__ bool next(int i, Unit& u) const {
        const long L = (long)i * G + c; if (L >= nwg) return false;
        int wgid = (int)L; { const int q = nwg / NXCD, r = nwg % NXCD, xcd = wgid % NXCD, off = wgid / NXCD; wgid = (xcd < r ? xcd * (q + 1) : r * (q + 1) + (xcd - r) * q) + off; }
        const int nig = WGM * nN, gid = wgid / nig, fm = gid * WGM, gsz = (nM - fm) < WGM ? (nM - fm) : WGM;
        u.pm = fm + ((wgid % nig) % gsz); u.pn = (wgid % nig) / gsz; return true;
    }
    __device__ __forceinline__ void a_ready(const Unit&) const {}
    __device__ __forceinline__ void done(const Unit&) const {}
};

__device__ __forceinline__ unsigned cvt_pk_bf16(float lo, float hi) { unsigned r; asm volatile("v_cvt_pk_bf16_f32 %0, %1, %2" : "=v"(r) : "v"(lo), "v"(hi)); return r; }

constexpr float RMS_EPS = 1e-6f;

__device__ __forceinline__ float slot_sum(const float* p, int ns) { float s = 0.f; for (int i = 0; i < ns; ++i) s += p[i]; return s; }
struct EpiRowScale {
    static constexpr bool PERM = true, AFTER_DRAIN = false, HAS_INIT = false;
    bf16_t* O; int ldc; const float* ssq_in; int ns_in; float inv_k; float* ssq_out0; float* ssq_out1; int t0, t1, ns_out;
    float* ksq = nullptr; int kt0 = 0, kt1 = 0;
    __device__ __forceinline__ void operator()(const f32x4 (&acc)[2][2][4][2], const Unit& u, int wr, int wc, int fr, int fq) const {
        const int row0 = u.pm * BM + wr * 64 + fr, col0 = u.pn * BM + wc * 32 + 8 * fq;
        float* sdst = (u.pn < t0) ? ssq_out0 + u.pn * 4 + wc : ((u.pn < t1) ? ssq_out1 + (u.pn - t0) * 4 + wc : nullptr);
#pragma unroll
        for (int ai = 0; ai < 2; ++ai)
#pragma unroll
            for (int m = 0; m < 4; ++m) {
                const int row = row0 + ai * HALF + m * 16;
                const float rs = ssq_in ? __builtin_amdgcn_rsqf(slot_sum(ssq_in + (size_t)row * ns_in, ns_in) * inv_k + RMS_EPS) : 1.f;
                bf16_t* rowp = O + (size_t)row * ldc + col0; float sq = 0.f, sqh[2];
#pragma unroll
                for (int bj = 0; bj < 2; ++bj) { const f32x4 v0 = acc[ai][bj][m][0] * rs, v1 = acc[ai][bj][m][1] * rs;
                    sqh[bj] = (v0[0] * v0[0] + v0[1] * v0[1]) + (v0[2] * v0[2] + v0[3] * v0[3]) + (v1[0] * v1[0] + v1[1] * v1[1]) + (v1[2] * v1[2] + v1[3] * v1[3]); sq += sqh[bj];
                    u32x4 w; w.x = cvt_pk_bf16(v0[0], v0[1]); w.y = cvt_pk_bf16(v0[2], v0[3]); w.z = cvt_pk_bf16(v1[0], v1[1]); w.w = cvt_pk_bf16(v1[2], v1[3]);
                    *(u32x4*)(rowp + bj * HALF) = w; }
                if (sdst) { sq += __shfl_xor(sq, 16); sq += __shfl_xor(sq, 32); if (fq == 0) sdst[(size_t)row * ns_out] = sq; }
                if (ksq && u.pn >= kt0 && u.pn < kt1) {
#pragma unroll
                    for (int bj = 0; bj < 2; ++bj) { float q = sqh[bj]; q += __shfl_xor(q, 16); q += __shfl_xor(q, 32); if (fq == 0) ksq[((size_t)(2 * (u.pn - kt0) + bj) * 8192 + row) * 4 + wc] = q; } }
            }
    }
};
struct EpiColScale {
    static constexpr bool PERM = true, AFTER_DRAIN = false, HAS_INIT = false;
    bf16_t* O; int ldc; const float* ssq_in; int ns_in; float inv_k;
    __device__ __forceinline__ void operator()(const f32x4 (&acc)[2][2][4][2], const Unit& u, int wr, int wc, int fr, int fq) const {
        const int row0 = u.pm * BM + wr * 64 + fr, col0 = u.pn * BM + wc * 32 + 8 * fq;
        f32x4 cs[2][2];
#pragma unroll
        for (int bj = 0; bj < 2; ++bj)
#pragma unroll
            for (int n = 0; n < 2; ++n) { const float* sp = ssq_in + (size_t)(col0 + bj * HALF + 4 * n) * ns_in; const f32x4 s = (f32x4){slot_sum(sp, ns_in), slot_sum(sp + ns_in, ns_in), slot_sum(sp + 2 * ns_in, ns_in), slot_sum(sp + 3 * ns_in, ns_in)};
                cs[bj][n] = (f32x4){__builtin_amdgcn_rsqf(s[0] * inv_k + RMS_EPS), __builtin_amdgcn_rsqf(s[1] * inv_k + RMS_EPS), __builtin_amdgcn_rsqf(s[2] * inv_k + RMS_EPS), __builtin_amdgcn_rsqf(s[3] * inv_k + RMS_EPS)}; }
#pragma unroll
        for (int ai = 0; ai < 2; ++ai)
#pragma unroll
            for (int m = 0; m < 4; ++m) { bf16_t* rowp = O + (size_t)(row0 + ai * HALF + m * 16) * ldc + col0;
#pragma unroll
                for (int bj = 0; bj < 2; ++bj) { const f32x4 v0 = acc[ai][bj][m][0] * cs[bj][0], v1 = acc[ai][bj][m][1] * cs[bj][1];
                    u32x2 w0, w1; w0.x = cvt_pk_bf16(v0[0], v0[1]); w0.y = cvt_pk_bf16(v0[2], v0[3]); w1.x = cvt_pk_bf16(v1[0], v1[1]); w1.y = cvt_pk_bf16(v1[2], v1[3]);
                    bf16_t* gp = rowp + bj * HALF - 8 * (fq & 1);
                    *(u32x2*)(gp + ((fq & 1) ? 4 : 0)) = w0; *(u32x2*)(gp + ((fq & 1) ? 12 : 8)) = w1; } }
    }
};
struct EpiResidual {
    static constexpr bool PERM = false, AFTER_DRAIN = false, HAS_INIT = true;
    const float* xold; float* out; bf16_t* xb; int ldc; float* ssq_out;
    __device__ __forceinline__ void init(f32x4 (&acc)[2][2][4][2], const Unit& u, int wr, int wc, int fr, int fq) const {
        const int row0 = u.pm * BM + wr * 64 + fr, col0 = u.pn * BM + wc * 32 + 4 * fq;
#pragma unroll
        for (int ai = 0; ai < 2; ++ai)
#pragma unroll
            for (int m = 0; m < 4; ++m) { const size_t ro = (size_t)(row0 + ai * HALF + m * 16) * ldc + col0;
#pragma unroll
                for (int bj = 0; bj < 2; ++bj)
#pragma unroll
                    for (int n = 0; n < 2; ++n) acc[ai][bj][m][n] = *(const f32x4*)(xold + ro + bj * HALF + 16 * n); }
    }
    __device__ __forceinline__ void operator()(const f32x4 (&acc)[2][2][4][2], const Unit& u, int wr, int wc, int fr, int fq) const {
        const int row0 = u.pm * BM + wr * 64 + fr, col0 = u.pn * BM + wc * 32 + 4 * fq;
#pragma unroll
        for (int ai = 0; ai < 2; ++ai)
#pragma unroll
            for (int m = 0; m < 4; ++m) {
                const int row = row0 + ai * HALF + m * 16; const size_t ro = (size_t)row * ldc + col0; float sq = 0.f;
#pragma unroll
                for (int bj = 0; bj < 2; ++bj)
#pragma unroll
                    for (int n = 0; n < 2; ++n) { const size_t o = ro + bj * HALF + 16 * n;
                        const f32x4 v = acc[ai][bj][m][n];
                        sq += (v[0] * v[0] + v[1] * v[1]) + (v[2] * v[2] + v[3] * v[3]);
                        *(f32x4*)(out + o) = v; u32x2 w; w.x = cvt_pk_bf16(v[0], v[1]); w.y = cvt_pk_bf16(v[2], v[3]); *(u32x2*)(xb + o) = w; }
                sq += __shfl_xor(sq, 16); sq += __shfl_xor(sq, 32); if (fq == 0) ssq_out[(size_t)row * 32 + u.pn * 4 + wc] = sq;
            }
    }
};

template <class Epi, class Sched, bool ALIGN_EPI = false>
__device__ __forceinline__ void gemm_phase(PG8_LAS unsigned char* lds, const Gemm g, const Sched& S, const Epi& E) {
    const int tid = threadIdx.x, wid = __builtin_amdgcn_readfirstlane(tid >> 6), lane = tid & 63, wr = wid >> 2, wc = wid & 3, fr = lane & 15, fq = lane >> 4;
    const int K = g.K, nt = K / BK;
    unsigned voffA[2], voffB[2];
#pragma unroll
    for (int i = 0; i < 2; ++i) { int R, C; stage_rc(tid * 16 + i * 8192, R, C); const int Rb = Epi::PERM ? ((R & ~31) + perm32(R & 31)) : R;
        voffA[i] = (unsigned)(R * g.lda + C) * 2u; voffB[i] = (unsigned)(Rb * g.ldb + C) * 2u; }
    const size_t kstep = (size_t)(BK * 2);
    const size_t hstepA = (size_t)HALF * g.lda * 2, hstepB = (size_t)HALF * g.ldb * 2;
    const size_t tstepA = 2 * hstepA, tstepB = 2 * hstepB;
    const unsigned ldsw = (unsigned)wid * 1024u;
    const int aoff = lds_byte(wr * 64 + fr, fq * 8), boff = lds_byte(wc * 32 + fr, fq * 8);
#define PG8_SA(b, h) (((b) * 2 + (h)) * HTB)
#define PG8_SB(b, h) ((4 + (b) * 2 + (h)) * HTB)
#define PG8_STAGE(bufoff, gbase, voff) do { _Pragma("unroll") for (int _i = 0; _i < 2; ++_i) \
        __builtin_amdgcn_global_load_lds((const unsigned*)((const char*)(gbase) + (voff)[_i]), (PG8_LAS unsigned*)(lds + (bufoff) + ldsw + _i * 8192), 16, 0, 0); } while (0)
#define PG8_LDA(dst, b, h) do { _Pragma("unroll") for (int m = 0; m < 4; ++m) _Pragma("unroll") for (int k = 0; k < 2; ++k) dst[m][k] = *(const PG8_LAS bf16x8*)(lds + PG8_SA(b, h) + aoff + m * 2048 + k * 1024); } while (0)
#define PG8_LDB(dst, b, h) do { _Pragma("unroll") for (int n = 0; n < 2; ++n) _Pragma("unroll") for (int k = 0; k < 2; ++k) dst[n][k] = *(const PG8_LAS bf16x8*)(lds + PG8_SB(b, h) + boff + n * 2048 + k * 1024); } while (0)
#define PG8_MMA(ai, bj, At, Bt) do { __builtin_amdgcn_s_setprio(1); _Pragma("unroll") for (int m = 0; m < 4; ++m) _Pragma("unroll") for (int n = 0; n < 2; ++n) _Pragma("unroll") for (int k = 0; k < 2; ++k) \
        acc[ai][bj][m][n] = __builtin_amdgcn_mfma_f32_16x16x32_bf16(Bt[n][k], At[m][k], acc[ai][bj][m][n], 0, 0, 0); __builtin_amdgcn_s_setprio(0); } while (0)
#define PG8_WAIT_V(n) asm volatile("s_waitcnt vmcnt(" #n ")" ::: "memory")
#define PG8_WAIT_L(n) asm volatile("s_waitcnt lgkmcnt(" #n ")" ::: "memory")
#define PG8_BAR __builtin_amdgcn_s_barrier()
#define PG8_SCHED __builtin_amdgcn_sched_barrier(0)
    Unit cur, nxt; int ui = 0;
    if (!S.next(0, cur)) return;
    f32x4 acc[2][2][4][2];
    if constexpr (Epi::HAS_INIT) E.init(acc, cur, wr, wc, fr, fq);
    else {
#pragma unroll
    for (int a = 0; a < 2; ++a)
#pragma unroll
        for (int b = 0; b < 2; ++b)
#pragma unroll
            for (int m = 0; m < 4; ++m)
#pragma unroll
                for (int n = 0; n < 2; ++n) acc[a][b][m][n] = (f32x4){0.f, 0.f, 0.f, 0.f};
    }
    bf16x8 At[4][2], B0[2][2], B1[2][2];
    const char* cA = (const char*)g.A + (size_t)cur.pm * tstepA; const char* cB = (const char*)g.Bt + (size_t)cur.pn * tstepB;
    S.a_ready(cur);
    PG8_STAGE(PG8_SB(0, 0), cB, voffB); PG8_STAGE(PG8_SB(0, 1), cB + hstepB, voffB); PG8_STAGE(PG8_SA(0, 0), cA, voffA); PG8_STAGE(PG8_SA(0, 1), cA + hstepA, voffA);
    if (wr == 1) PG8_BAR;
    PG8_WAIT_V(2); PG8_BAR;
    PG8_STAGE(PG8_SB(1, 0), cB + kstep, voffB); PG8_STAGE(PG8_SA(1, 0), cA + kstep, voffA); PG8_STAGE(PG8_SB(1, 1), cB + hstepB + kstep, voffB);
    PG8_WAIT_V(6); PG8_BAR;
    for (;;) {
        const bool has_next = S.next(ui + 1, nxt);
        const char* nA = has_next ? (const char*)g.A + (size_t)nxt.pm * tstepA : cA; const char* nB = has_next ? (const char*)g.Bt + (size_t)nxt.pn * tstepB : cB;
        for (int t = 0; t < nt; t += 2) {
            const bool last = (t == nt - 2);
            const char* a1 = cA + (size_t)(t + 1) * kstep;
            const char* a2 = last ? nA : cA + (size_t)(t + 2) * kstep; const char* b2 = last ? nB : cB + (size_t)(t + 2) * kstep;
            const char* a3 = a2 + kstep; const char* b3 = b2 + kstep;
            if (last && has_next) S.a_ready(nxt);
            PG8_LDB(B0, 0, 0); PG8_LDB(B1, 0, 1); PG8_SCHED; PG8_LDA(At, 0, 0); PG8_STAGE(PG8_SA(1, 1), a1 + hstepA, voffA);
            PG8_WAIT_V(8); PG8_WAIT_L(0); PG8_BAR; PG8_MMA(0, 0, At, B0); PG8_MMA(0, 1, At, B1); PG8_BAR; PG8_SCHED;
            PG8_LDA(At, 0, 1); PG8_STAGE(PG8_SB(0, 0), b2, voffB); PG8_STAGE(PG8_SB(0, 1), b2 + hstepB, voffB); PG8_STAGE(PG8_SA(0, 0), a2, voffA);
            PG8_WAIT_V(8); PG8_WAIT_L(0); PG8_BAR; PG8_MMA(1, 0, At, B0); PG8_MMA(1, 1, At, B1); PG8_BAR; PG8_SCHED;
            PG8_LDB(B0, 1, 0); PG8_LDB(B1, 1, 1); PG8_SCHED; PG8_LDA(At, 1, 0); PG8_STAGE(PG8_SA(0, 1), a2 + hstepA, voffA);
            PG8_WAIT_V(8); PG8_WAIT_L(0); PG8_BAR; PG8_MMA(0, 0, At, B0); PG8_MMA(0, 1, At, B1); PG8_BAR; PG8_SCHED;
            PG8_LDA(At, 1, 1); PG8_STAGE(PG8_SB(1, 0), b3, voffB); PG8_STAGE(PG8_SB(1, 1), b3 + hstepB, voffB); PG8_STAGE(PG8_SA(1, 0), a3, voffA);
            PG8_WAIT_V(8); PG8_WAIT_L(0); PG8_BAR; PG8_MMA(1, 0, At, B0); PG8_MMA(1, 1, At, B1); PG8_BAR; PG8_SCHED;
        }
        if constexpr (ALIGN_EPI) { if (wr == 0) PG8_BAR; }
        E(acc, cur, wr, wc, fr, fq); S.done(cur);
        if (!has_next) break;
        if constexpr (Epi::HAS_INIT) E.init(acc, nxt, wr, wc, fr, fq);
        else {
#pragma unroll
        for (int a = 0; a < 2; ++a)
#pragma unroll
            for (int b = 0; b < 2; ++b)
#pragma unroll
                for (int m = 0; m < 4; ++m)
#pragma unroll
                    for (int n = 0; n < 2; ++n) acc[a][b][m][n] = (f32x4){0.f, 0.f, 0.f, 0.f};
        }
        cur = nxt; cA = nA; cB = nB; ++ui;
        if constexpr (ALIGN_EPI) { if (wr == 1) PG8_BAR; }
    }
    PG8_WAIT_V(0);
    if constexpr (!ALIGN_EPI) { if (wr == 0) PG8_BAR; }
    PG8_BAR;
#undef PG8_SA
#undef PG8_SB
#undef PG8_STAGE
#undef PG8_LDA
#undef PG8_LDB
#undef PG8_MMA
#undef PG8_WAIT_V
#undef PG8_WAIT_L
#undef PG8_BAR
#undef PG8_SCHED
}
}
#define GAS __attribute__((address_space(1)))
#define LAS __attribute__((address_space(3)))
typedef unsigned short bf16;
typedef unsigned v4u __attribute__((ext_vector_type(4)));
typedef unsigned v2u __attribute__((ext_vector_type(2)));
typedef float f32x4 __attribute__((ext_vector_type(4)));
typedef float f32x16 __attribute__((ext_vector_type(16)));
typedef short bf16x8 __attribute__((ext_vector_type(8)));
typedef __bf16 bf16x2_t __attribute__((ext_vector_type(2)));
typedef GAS unsigned gu32;
#define RLX_AGENT __ATOMIC_RELAXED, __HIP_MEMORY_SCOPE_AGENT
__device__ __forceinline__ unsigned f2bf(float f) { unsigned u = __builtin_bit_cast(unsigned, f); return (u + 0x7fffu + ((u >> 16) & 1u)) >> 16; }
__device__ __forceinline__ unsigned pk2(float lo, float hi) { return pg8::cvt_pk_bf16(lo, hi); }
__device__ __forceinline__ float bf2f(unsigned short v) { return __uint_as_float((unsigned)v << 16); }
__device__ __forceinline__ float bflo(unsigned w) { return __uint_as_float(w << 16); }
__device__ __forceinline__ float bfhi(unsigned w) { return __uint_as_float(w & 0xffff0000u); }
__device__ __forceinline__ float dot2(unsigned a, unsigned b, float acc) { return __builtin_amdgcn_fdot2_f32_bf16(__builtin_bit_cast(bf16x2_t, a), __builtin_bit_cast(bf16x2_t, b), acc, false); }
__device__ __forceinline__ float wave_sum(float v) {
#pragma unroll
    for (int o = 1; o < 64; o <<= 1) v += __shfl_xor(v, o);
    return v;
}
__device__ __forceinline__ float pair_max(float x) { auto t = __builtin_amdgcn_permlane32_swap(__float_as_uint(x), __float_as_uint(x), false, false); return fmaxf(__uint_as_float(t[0]), __uint_as_float(t[1])); }
__device__ __forceinline__ float pair_sum(float x) { auto t = __builtin_amdgcn_permlane32_swap(__float_as_uint(x), __float_as_uint(x), false, false); return __uint_as_float(t[0]) + __uint_as_float(t[1]); }

#define XB_TMO      128
#define XB_XCNT(j)  (256  + 64 * (j))
#define XB_XSUB(j)  (1280 + 64 * (j))
#define XB_XGEN(j)  (2304 + 64 * (j))
#define XB_TOP      3328
#define XB_TOPGEN   3392
#define XCD_BAR_WORDS 3456
#define XB_SPIN_CAP (1u << 18)

__device__ __forceinline__ unsigned xb_ld(unsigned* p)              { return __hip_atomic_load(p, __ATOMIC_RELAXED, __HIP_MEMORY_SCOPE_AGENT); }
__device__ __forceinline__ unsigned xb_add(unsigned* p, unsigned v) { return __hip_atomic_fetch_add(p, v, __ATOMIC_RELAXED, __HIP_MEMORY_SCOPE_AGENT); }
__device__ __forceinline__ unsigned xb_xcc_id() { return (unsigned)__builtin_amdgcn_s_getreg((3 << 11) | 20) & 0xFu; }
#define XB_SPIN(cond, bar) do { unsigned _sp = 0; while (cond) { __builtin_amdgcn_s_sleep(1); \
    if ((++_sp & 255u) == 0u) { if (xb_ld(&(bar)[XB_TMO])) break; if (_sp > XB_SPIN_CAP) { atomicAdd(&(bar)[XB_TMO], 1u); break; } } } } while (0)

struct XcdBarrier {
    unsigned* bar; unsigned x;
    volatile LAS unsigned* st;
};
__device__ __forceinline__ XcdBarrier xcd_barrier_post(unsigned* bar, volatile LAS unsigned* st) {
    XcdBarrier b; b.bar = bar; b.x = xb_xcc_id(); b.st = st;
    if (threadIdx.x == 0) (void)xb_add(&bar[XB_XCNT(b.x)], 1u);
    return b;
}
__device__ __forceinline__ void xcd_barrier_complete(unsigned* bar, unsigned x, unsigned& nloc, unsigned& nx) {
    const unsigned G = gridDim.x * gridDim.y * gridDim.z;
    unsigned sum, cnt, mine, sp = 0u;
    for (;;) {
        sum = 0u; cnt = 0u; mine = 0u;
#pragma unroll
        for (unsigned j = 0; j < 16; ++j) { const unsigned c = xb_ld(&bar[XB_XCNT(j)]); sum += c; cnt += (c > 0u) ? 1u : 0u; mine = (j == x) ? c : mine; }
        if (sum == G) break;
        __builtin_amdgcn_s_sleep(1);
        if ((++sp & 255u) == 0u) { if (xb_ld(&bar[XB_TMO])) break; if (sp > XB_SPIN_CAP) { atomicAdd(&bar[XB_TMO], 1u); break; } }
    }
    nloc = mine > 0u ? mine : 1u; nx = cnt > 0u ? cnt : 1u;
}
__device__ __forceinline__ void xcd_barrier(const XcdBarrier& b) {
    asm volatile("s_waitcnt vmcnt(0)" ::: "memory");
    __syncthreads();
    if (threadIdx.x == 0) {
        unsigned* bar = b.bar;
        __builtin_amdgcn_s_waitcnt(0);
        unsigned nloc = b.st[0], nx = b.st[1];
        if (nloc == 0u) { xcd_barrier_complete(bar, b.x, nloc, nx); b.st[0] = nloc; b.st[1] = nx; }
        const unsigned old = xb_add(&bar[XB_XSUB(b.x)], 1u);
        const unsigned gen = old / nloc;
        if (old + 1u == (gen + 1u) * nloc) {
            __builtin_amdgcn_fence(__ATOMIC_RELEASE, "agent");
            asm volatile("s_waitcnt vmcnt(0)" ::: "memory");
            const unsigned og = xb_add(&bar[XB_TOP], 1u);
            const unsigned tg = og / nx;
            if (og + 1u == (tg + 1u) * nx) xb_add(&bar[XB_TOPGEN], 1u);
            else XB_SPIN(xb_ld(&bar[XB_TOPGEN]) == tg, bar);
            __builtin_amdgcn_fence(__ATOMIC_ACQUIRE, "agent");
            xb_add(&bar[XB_XGEN(b.x)], 1u);
            asm volatile("s_waitcnt vmcnt(0)" ::: "memory");
        } else {
            XB_SPIN(xb_ld(&bar[XB_XGEN(b.x)]) == gen, bar);
            __builtin_amdgcn_fence(__ATOMIC_ACQUIRE, "agent");
            asm volatile("s_waitcnt vmcnt(0)" ::: "memory");
        }
    }
    __syncthreads();
}
constexpr int NWAVES = 8;
constexpr int N_PHASES = 14;
constexpr int NB = 4, SEQ = 2048, T = NB * SEQ, D = 2048;
constexpr int MLA_H = 16, MLA_QK = 192, MLA_NOPE = 128, MLA_ROPE = 64, MLA_IN = 1088, MLA_INP = 1280, MLA_QN = 3072;
constexpr int FOX_H = 16, FOX_HD = 128, FOX_ZN = 6144;
constexpr int PE_H = 8, PE_NK = 128, PE_TOPK = 16, PE_NE = 16384, PE_SEL = 128;
constexpr float RMS_EPS = 1e-6f, LOG2E = 1.4426950408889634f;

constexpr size_t MiB = 1u << 20;
constexpr size_t WS_CTL = 0, CTL_ZERO_BYTES = 1 * MiB;
constexpr size_t WS_SSQ = 1 * MiB;
constexpr size_t WS_WF = WS_SSQ + 2 * MiB;
constexpr size_t WS_SKB = WS_WF + 128 * 1024;
constexpr size_t WS_LF = WS_SKB + 128 * 1024;
constexpr size_t WS_WT_MLA_IN = 5 * MiB;
constexpr size_t WS_WT_QB = WS_WT_MLA_IN + 5 * MiB;
constexpr size_t WS_WT_KVB = WS_WT_QB + 3 * MiB;
constexpr size_t WS_WT_MLA_O = WS_WT_KVB + 4 * MiB;
constexpr size_t WS_WT_FOX_IN = WS_WT_MLA_O + 8 * MiB;
constexpr size_t WS_WT_FOX_O = WS_WT_FOX_IN + 32 * MiB;
constexpr size_t WS_WT_PQ = WS_WT_FOX_O + 8 * MiB;
constexpr size_t WS_PU = WS_WT_PQ + 16 * MiB;
constexpr size_t WS_PV = WS_PU + 64 * MiB;
constexpr size_t WS_PSU = WS_PV + 64 * MiB, WS_PSV = WS_PSU + 128 * 1024;
constexpr size_t WS_XB = WS_PSU + 1 * MiB;
constexpr size_t WS_O = WS_XB + 32 * MiB;
constexpr size_t WS_QP = WS_O + 32 * MiB;
constexpr size_t WS_VT = WS_QP + 32 * MiB;
constexpr size_t WS_ACT = WS_VT + 32 * MiB;
constexpr size_t WS_Z0 = WS_ACT;
constexpr size_t WS_Q = WS_Z0 + 20 * MiB;
constexpr size_t WS_KN = WS_Q + 48 * MiB;
constexpr size_t WS_KM = WS_KN + 32 * MiB;
constexpr size_t WS_KRG = WS_KM;
constexpr size_t WS_RCKV = WS_KM + 2 * MiB, WS_KRSS = WS_RCKV + 256 * 1024;
constexpr size_t WS_ROPE = WS_KM + 4 * MiB;
constexpr size_t WS_KSQM = WS_KM + 8 * MiB;
constexpr size_t WS_Z = WS_ACT;
constexpr size_t WS_KSQ = WS_ACT + 100 * MiB;
constexpr size_t WS_END = WS_KM + 48 * MiB;
static_assert(WS_Z + 96 * MiB <= WS_END, "ws map");
constexpr int SSQ_X0 = 0, SSQ_X2 = T, SSQ_CQ = 2 * T, SSQ_CKV = 10 * T, SSQ_XS = 18 * T;
constexpr int CW_BAR = 4096;

constexpr int RING_OFF = 0, RING_BYTES = 131072;
constexpr int LDS_BYTES = 163840;
constexpr int LDSCTL_OFF = LDS_BYTES - 1024, MISC_OFF = LDSCTL_OFF + 320;

struct Frame {
    LAS unsigned char* lds;
    int tid, lane, wave, vcu, G;
    unsigned char* ws;
    float* out;
};

__device__ __forceinline__ void transpose_item(const float* W, int ldw, int k0, int n0src, const float* gain, bf16* WT, int K, int dstrow0, LAS float* scr, int lane) {
    const int r4 = lane >> 4, c4 = (lane & 15) * 4; f32x4 v[16];
    const float* src = W + (size_t)(k0 + r4) * ldw + n0src + c4;
#pragma unroll
    for (int i = 0; i < 16; ++i) v[i] = *(const f32x4*)(src + (size_t)(4 * i) * ldw);
#pragma unroll
    for (int i = 0; i < 16; ++i) { const int kk = 4 * i + r4; const float gk = gain ? gain[k0 + kk] : 1.f; LAS float* d = scr + kk * 65 + c4; d[0] = v[i].x * gk; d[1] = v[i].y * gk; d[2] = v[i].z * gk; d[3] = v[i].w * gk; }
    asm volatile("s_waitcnt lgkmcnt(0)" ::: "memory");
    const int c = lane & 7;
#pragma unroll
    for (int j = 0; j < 8; ++j) { const int n = (lane >> 3) + 8 * j; const LAS float* s = scr + (8 * c) * 65 + n;
        v4u o; o.x = pk2(s[0 * 65], s[1 * 65]); o.y = pk2(s[2 * 65], s[3 * 65]); o.z = pk2(s[4 * 65], s[5 * 65]); o.w = pk2(s[6 * 65], s[7 * 65]);
        *(v4u*)(WT + (size_t)(dstrow0 + n) * K + k0 + 8 * c) = o; }
    asm volatile("s_waitcnt lgkmcnt(0)" ::: "memory");
}
struct In {
    const float* x; const int* pos; const float *g_mix, *g_ffn, *mla_w_in, *mla_g_qa, *mla_w_qb, *mla_g_kva, *mla_w_kvb, *mla_g_q, *mla_g_k, *mla_w_o,
        *fox_w_in, *fox_b_f, *fox_g_q, *fox_g_k, *fox_w_o, *pe_wq, *pe_sk, *pe_u, *pe_v;
};
__device__ __forceinline__ void prologue_transpose_item(const In& I, unsigned char* ws, LAS float* scr, int lane, int it) {
    constexpr int I1 = 17 * 32, I2 = 48 * 8, I3 = 64 * 8, I4 = 32 * 32, I5 = 128 * 32, I6 = 32 * 32, I7 = 32 * 32;
        int r = it;
        if (r < I1) { const int kb = r / 17, nb = r % 17; transpose_item(I.mla_w_in, MLA_IN, 64 * kb, 64 * nb, I.g_mix, (bf16*)(ws + WS_WT_MLA_IN), 2048, 64 * nb, scr, lane); return; } r -= I1;
        if (r < I2) { const int kb = r / 48, nb = r % 48; transpose_item(I.mla_w_qb, 3072, 64 * kb, 64 * nb, I.mla_g_qa, (bf16*)(ws + WS_WT_QB), 512, 64 * nb, scr, lane); return; } r -= I2;
        if (r < I3) { const int kb = r / 64, nb = r % 64, n0 = 64 * nb, h = n0 >> 8, part = (n0 >> 7) & 1, d0 = n0 & 127;
            transpose_item(I.mla_w_kvb, 4096, 64 * kb, n0, I.mla_g_kva, (bf16*)(ws + WS_WT_KVB), 512, part * 2048 + h * 128 + d0, scr, lane); return; } r -= I3;
        if (r < I4) { const int kb = r / 32, nb = r % 32; transpose_item(I.mla_w_o, 2048, 64 * kb, 64 * nb, nullptr, (bf16*)(ws + WS_WT_MLA_O), 2048, 64 * nb, scr, lane); return; } r -= I4;
        if (r < I5) { const int kb = r / 128, nb = r % 128, n0 = 64 * nb, sec = n0 >> 11, dsec = (sec == 0) ? 0 : (sec == 1) ? 1 : (sec == 2) ? 3 : 2;
            transpose_item(I.fox_w_in, 8208, 64 * kb, n0, I.g_mix + 2048, (bf16*)(ws + WS_WT_FOX_IN), 2048, dsec * 2048 + (n0 & 2047), scr, lane); return; } r -= I5;
        if (r < I6) { const int kb = r / 32, nb = r % 32; transpose_item(I.fox_w_o, 2048, 64 * kb, 64 * nb, nullptr, (bf16*)(ws + WS_WT_FOX_O), 2048, 64 * nb, scr, lane); return; } r -= I6;
        if (r < I7) { const int kb = r / 32, nb = r % 32; transpose_item(I.pe_wq, 2048, 64 * kb, 64 * nb, I.g_ffn, (bf16*)(ws + WS_WT_PQ), 2048, 64 * nb, scr, lane); return; } r -= I7;
        { const int kb = r / 32, nb = r % 32; transpose_item(I.pe_wq + (size_t)2048 * 2048, 2048, 64 * kb, 64 * nb, I.g_ffn + 2048, (bf16*)(ws + WS_WT_PQ + 8 * MiB), 2048, 64 * nb, scr, lane); }
}
__device__ __forceinline__ void quant_pair(const In& I, unsigned char* ws, int lane, int row0) {
        f32x4 v[2][8]; float mx[2] = {0.f, 0.f};
#pragma unroll
        for (int u = 0; u < 2; ++u) { const int row = row0 + u, tbl = row >> 15, rr = row & 32767; const f32x4* src = (const f32x4*)((tbl ? I.pe_v : I.pe_u) + (size_t)rr * D) + lane;
#pragma unroll
            for (int q = 0; q < 8; ++q) v[u][q] = __builtin_nontemporal_load(src + 64 * q); }
#pragma unroll
        for (int u = 0; u < 2; ++u) {
#pragma unroll
            for (int i = 0; i < 8; ++i) { const f32x4 t = v[u][i]; mx[u] = fmaxf(mx[u], fmaxf(fmaxf(fabsf(t.x), fabsf(t.y)), fmaxf(fabsf(t.z), fabsf(t.w)))); }
#pragma unroll
            for (int o = 1; o < 64; o <<= 1) mx[u] = fmaxf(mx[u], __shfl_xor(mx[u], o));
        }
#pragma unroll
        for (int u = 0; u < 2; ++u) { const int row = row0 + u, tbl = row >> 15, rr = row & 32767;
            const float top = tbl ? 440.f : 127.f;
            const float inv = mx[u] > 0.f ? top / mx[u] : 1.f, sc = mx[u] > 0.f ? mx[u] / top : 1.f;
            v4u* dst = (v4u*)(ws + (tbl ? WS_PV : WS_PU) + (size_t)rr * D) + lane; unsigned dq[8];
#pragma unroll
            for (int q = 0; q < 8; ++q) { const f32x4 t = v[u][q] * inv; int w = 0;
                if (tbl) { w = __builtin_amdgcn_cvt_pk_fp8_f32(t.x, t.y, w, false); w = __builtin_amdgcn_cvt_pk_fp8_f32(t.z, t.w, w, true); }
                else w = (__float2int_rn(t.x) & 255) | ((__float2int_rn(t.y) & 255) << 8) | ((__float2int_rn(t.z) & 255) << 16) | (__float2int_rn(t.w) << 24);
                dq[q] = (unsigned)w; }
            if (tbl) {
#pragma unroll
                for (int q = 0; q < 8; ++q) ((unsigned*)dst)[64 * q - 3 * lane] = dq[q];
            } else { dst[0] = (v4u){dq[0], dq[1], dq[2], dq[3]}; dst[64] = (v4u){dq[4], dq[5], dq[6], dq[7]}; }
            if (lane == 0) ((float*)(ws + (tbl ? WS_PSV : WS_PSU)))[rr] = sc; }
}
constexpr int PE_FILL2 = 6144;
__device__ __forceinline__ void p_table_fill(const Frame& F, const In& I, int row_lo, int nrows, int w, int NW) {
    for (int r = 2 * w; r < nrows; r += 2 * NW) quant_pair(I, F.ws, F.lane, row_lo + r);
}
__device__ __forceinline__ void p_prologue(const Frame& F, const In& I) {
    LAS float* scr = (LAS float*)(F.lds + RING_OFF + F.wave * 16640);
    const int gw = F.vcu * NWAVES + F.wave, NGW = F.G * NWAVES, lane = F.lane;
    unsigned char* ws = F.ws;
    constexpr int I1 = 17 * 32, I2 = 48 * 8, I3 = 64 * 8, I4 = 32 * 32, I5 = 128 * 32, I6 = 32 * 32, I7 = 32 * 32, I8 = 32 * 32;
    constexpr int NITEMS = I1 + I2 + I3 + I4 + I5 + I6 + I7 + I8;
    const int gt = F.vcu * 512 + F.tid, NGT = F.G * 512;
    for (int i = gt; i < 49152; i += NGT) ((v4u*)(ws + WS_WT_MLA_IN + (size_t)MLA_IN * 2048 * 2))[i] = (v4u){0u, 0u, 0u, 0u};
    for (int i = gt; i < 16 * 2048; i += NGT) { const int j = i >> 11, k = i & 2047; ((float*)(ws + WS_WF))[i] = I.fox_w_in[(size_t)k * 8208 + 8192 + j] * I.g_mix[2048 + k]; }
    for (int i = gt; i < 2 * 2 * 128 * 128; i += NGT) ((bf16*)(ws + WS_SKB))[i] = (bf16)f2bf(I.pe_sk[i]);
    for (int m = gw; m < T; m += NGW) {
        const f32x4* xr = (const f32x4*)(I.x + (size_t)m * D) + lane; f32x4 v[8]; float s = 0.f;
#pragma unroll
        for (int j = 0; j < 8; ++j) { v[j] = xr[64 * j]; s += (v[j].x * v[j].x + v[j].y * v[j].y) + (v[j].z * v[j].z + v[j].w * v[j].w); }
        s = wave_sum(s); if (lane == 0) ((float*)(ws + WS_SSQ))[SSQ_X0 + m] = s;
        v2u* o = (v2u*)(ws + WS_XB + (size_t)m * D * 2) + lane;
#pragma unroll
        for (int j = 0; j < 8; ++j) { v2u w; w.x = pk2(v[j].x, v[j].y); w.y = pk2(v[j].z, v[j].w); o[64 * j] = w; }
    }
    int tit = gw, tk3 = 0;
    constexpr int NPRO = 65536 - 16384 - PE_FILL2;
    for (int vr = 2 * gw; vr < NPRO || tit < NITEMS; vr += 2 * NGW, ++tk3) {
        if ((tk3 % 3 == 0 || vr >= NPRO) && tit < NITEMS) { prologue_transpose_item(I, ws, scr, lane, tit); tit += NGW; }
        if (vr >= NPRO) continue;
        const int row0 = vr < 16384 ? vr : vr < 32768 ? 32768 + (vr - 16384) : 49152 + PE_FILL2 + (vr - 32768);
        quant_pair(I, ws, lane, row0);
    }
}

__device__ __forceinline__ void p_mla_tok(const Frame& F, const In& I) {
    const int gw = F.vcu * NWAVES + F.wave, NGW = F.G * NWAVES, lane = F.lane;
    const bf16* z0 = (const bf16*)(F.ws + WS_Z0); const float* sq = (const float*)(F.ws + WS_SSQ);
    const float gk2 = I.mla_g_k[128 + lane];
    const float inv_freq = __builtin_amdgcn_exp2f(-13.287712379549449f * (float)(2 * (lane & 31)) * (1.f / 64.f));
    for (int tok = gw; tok < T; tok += NGW) {
        const float ang = (float)I.pos[tok] * inv_freq; const float cs = __cosf(ang), sn = __sinf(ang);
        const float kr = bf2f(z0[(size_t)tok * MLA_INP + 1024 + lane]); const float kr_ss = wave_sum(kr * kr);
        const float krg = kr * gk2, pb = __shfl_xor(krg, 32);
        const float rot = (lane < 32) ? (krg * cs - pb * sn) : (krg * cs + pb * sn);
        ((bf16*)(F.ws + WS_KRG))[(size_t)tok * 64 + lane] = (bf16)f2bf(rot);
        ((float*)(F.ws + WS_ROPE))[(size_t)tok * 64 + lane] = (lane < 32) ? cs : sn;
        if (lane == 0) { ((float*)(F.ws + WS_RCKV))[tok] = __builtin_amdgcn_rsqf(pg8::slot_sum(sq + SSQ_CKV + (size_t)tok * 8, 8) * (1.f / 512.f) + RMS_EPS); ((float*)(F.ws + WS_KRSS))[tok] = kr_ss; }
    }
}

__device__ __forceinline__ void p_fox_prep(const Frame& F, const In& I) {
    const int gw = F.vcu * NWAVES + F.wave, NGW = F.G * NWAVES, lane = F.lane;
    bf16* z = (bf16*)(F.ws + WS_Z);
    const float QS = 0.08838834764831845f * LOG2E;
    const float gq0 = I.fox_g_q[lane], gq1 = I.fox_g_q[64 + lane], gk0 = I.fox_g_k[lane], gk1 = I.fox_g_k[64 + lane];
    for (int tok = gw; tok < T; tok += NGW) {
        bf16* zr = z + (size_t)tok * FOX_ZN;
        for (int h = 0; h < FOX_H; ++h) {
            bf16* qp = zr + h * 128; bf16* kp = zr + 2048 + h * 128;
            float a0 = bf2f(qp[lane]), a1 = bf2f(qp[64 + lane]), b0 = bf2f(kp[lane]), b1 = bf2f(kp[64 + lane]);
            const float rq = __builtin_amdgcn_rsqf(wave_sum(a0 * a0 + a1 * a1) * (1.f / 128.f) + RMS_EPS) * QS;
            const float rk = __builtin_amdgcn_rsqf(wave_sum(b0 * b0 + b1 * b1) * (1.f / 128.f) + RMS_EPS);
            qp[lane] = (bf16)f2bf(a0 * rq * gq0); qp[64 + lane] = (bf16)f2bf(a1 * rq * gq1);
            kp[lane] = (bf16)f2bf(b0 * rk * gk0); kp[64 + lane] = (bf16)f2bf(b1 * rk * gk1);
        }
    }
}

struct AttnAux { const float *gq, *gk, *ksq, *cqs, *rope, *rckv, *krss; const bf16* krg; };
template <int DK> struct AttnCfg { static constexpr int KP = DK + 8, KB_BYTES = 64 * KP * 2, VP = 72, VB_BYTES = 128 * VP * 2, NKS = DK / 16, KPT = (64 * DK / 8) / 512,
    OFF_K = 0, OFF_V = 2 * KB_BYTES, OFF_CL = OFF_V + 2 * VB_BYTES, OFF_WS = OFF_CL + 8192, OFF_RK = OFF_WS + 64, END = OFF_RK + 8192; };
template <int DK, bool FOX>
__device__ __forceinline__ void attn_unit(LAS unsigned char* lds, const bf16* __restrict__ Q, int qpitch, const bf16* __restrict__ K, int kpitch, const bf16* __restrict__ Vt, bf16* __restrict__ O,
                                          const bf16* __restrict__ gate, int gpitch, const float* __restrict__ lf, const AttnAux& ax,
                                          int b, int h, int qb, int tid, int wid, int lane) {
    const float* __restrict__ gq = ax.gq; const float* __restrict__ gk = ax.gk; const float* __restrict__ ksq = ax.ksq;
    typedef AttnCfg<DK> C;
    static_assert(C::END <= RING_BYTES, "attention LDS");
    asm volatile("" : "+v"(tid), "+v"(lane));
    const int r = lane & 31, hh = lane >> 5;
    const int tok0 = b * SEQ, q0 = qb * 256 + wid * 32, jw = q0 >> 6, jmax = qb * 4 + 3;
    constexpr int KPPR = DK / 8 + 1, KNI = 64 * KPPR / 64, VPPR = 9, VNI = 128 * VPPR / 64;
    static_assert(KPPR * 16 == C::KP * 2 && VPPR * 16 == C::VP * 2, "LDS pitches");
    const char* kbase_u = (const char*)(K + (size_t)tok0 * kpitch + h * (FOX ? DK : 128)); const char* vbase_u = (const char*)(Vt + (size_t)h * 128 * T + tok0);
    const char* krbase_u = FOX ? kbase_u : (const char*)(ax.krg + (size_t)tok0 * 64);
    unsigned kg[4], vg[3]; bool kr_[4];
#pragma unroll
    for (int i = 0; i < 4; ++i) { const int p = 64 * (wid + 8 * i) + lane, key = p / KPPR, c = p % KPPR;
        if (FOX) { kr_[i] = false; kg[i] = (unsigned)(key * kpitch + (c < DK / 8 ? c * 8 : 0)) * 2u; }
        else { kr_[i] = (c >= 16 && c < 24); kg[i] = kr_[i] ? (unsigned)(key * 64 + 8 * (c - 16)) * 2u : (unsigned)(key * kpitch + (c < 16 ? c * 8 : 0)) * 2u; } }
#pragma unroll
    for (int i = 0; i < 3; ++i) { const int p = 64 * (wid + 8 * i) + lane, dv = p / VPPR, c = p % VPPR; vg[i] = (unsigned)(dv * T + (c < 8 ? c * 8 : 0)) * 2u; }
#define ATT_STAGE(j, buf) do { const char* _kb = kbase_u + (size_t)(j) * 64 * kpitch * 2; const char* _rb = krbase_u + (size_t)(j) * 64 * 64 * 2; const char* _vb = vbase_u + (size_t)(j) * 128; \
        _Pragma("unroll") for (int i = 0; i < 4; ++i) if (wid + 8 * i < KNI) __builtin_amdgcn_global_load_lds((const unsigned*)(((!FOX && kr_[i]) ? _rb : _kb) + kg[i]), (LAS unsigned*)(lds + C::OFF_K + (buf) * C::KB_BYTES + 1024 * (wid + 8 * i)), 16, 0, 0); \
        _Pragma("unroll") for (int i = 0; i < 3; ++i) if (wid + 8 * i < VNI) __builtin_amdgcn_global_load_lds((const unsigned*)(_vb + vg[i]), (LAS unsigned*)(lds + C::OFF_V + (buf) * C::VB_BYTES + 1024 * (wid + 8 * i)), 16, 0, 0); } while (0)
#define ATT_SYNC() do { asm volatile("s_waitcnt vmcnt(0)" ::: "memory"); __syncthreads(); } while (0)
    ATT_STAGE(jmax, 0);
    bf16x8 qf[C::NKS];
    {
        LAS unsigned char* qst = lds + C::END + wid * 4608;
        const int rr_ = lane >> 3, cc_ = lane & 7;
        v4u qg[C::NKS / 4][4];
#pragma unroll
        for (int rd = 0; rd < C::NKS / 4; ++rd)
#pragma unroll
            for (int i = 0; i < 4; ++i) qg[rd][i] = *(const v4u*)(Q + (size_t)(tok0 + q0 + 8 * i + rr_) * qpitch + h * DK + 64 * rd + 8 * cc_);
#pragma unroll
        for (int rd = 0; rd < C::NKS / 4; ++rd) {
#pragma unroll
            for (int i = 0; i < 4; ++i) *(LAS v4u*)(qst + (8 * i + rr_) * 144 + cc_ * 16) = qg[rd][i];
            asm volatile("s_waitcnt lgkmcnt(0)" ::: "memory");
#pragma unroll
            for (int k4 = 0; k4 < 4; ++k4) qf[4 * rd + k4] = *(const LAS bf16x8*)(qst + r * 144 + k4 * 32 + hh * 16);
            asm volatile("s_waitcnt lgkmcnt(0)" ::: "memory");
        }
    }
    LAS float* cl = (LAS float*)(lds + C::OFF_CL);
    LAS float* rkl = (LAS float*)(lds + C::OFF_RK);
    if constexpr (FOX) {
        LAS float* wsum = (LAS float*)(lds + C::OFF_WS);
        const int n = (qb + 1) * 256; float v[4]; f32x4 kqv[4];
        { const f32x4 t4 = *(const f32x4*)(lf + (size_t)h * T + tok0 + 4 * tid);
#pragma unroll
          for (int e = 0; e < 4; ++e) v[e] = (4 * tid + e < n) ? t4[e] : 0.f; }
#pragma unroll
        for (int e = 0; e < 4; ++e) kqv[e] = *(const f32x4*)(ksq + ((size_t)h * T + tok0 + tid + 512 * e) * 4);
        {
            float ss = 0.f;
#pragma unroll
            for (int ks = 0; ks < C::NKS; ++ks)
#pragma unroll
                for (int j = 0; j < 8; ++j) { const float v_ = bf2f((unsigned short)qf[ks][j]); ss += v_ * v_; }
            ss = pair_sum(ss);
            const float rq = __builtin_amdgcn_rsqf(ss * (1.f / 128.f) + RMS_EPS) * (0.08838834764831845f * LOG2E);
#pragma unroll
            for (int ks = 0; ks < C::NKS; ++ks) { const int d0 = 16 * ks + 8 * hh; const f32x4 ga = *(const f32x4*)(gq + d0), gb = *(const f32x4*)(gq + d0 + 4), ka = *(const f32x4*)(gk + d0), kb2 = *(const f32x4*)(gk + d0 + 4);
                v4u w; w.x = pk2(bf2f((unsigned short)qf[ks][0]) * rq * ga.x * ka.x, bf2f((unsigned short)qf[ks][1]) * rq * ga.y * ka.y); w.y = pk2(bf2f((unsigned short)qf[ks][2]) * rq * ga.z * ka.z, bf2f((unsigned short)qf[ks][3]) * rq * ga.w * ka.w);
                w.z = pk2(bf2f((unsigned short)qf[ks][4]) * rq * gb.x * kb2.x, bf2f((unsigned short)qf[ks][5]) * rq * gb.y * kb2.y); w.w = pk2(bf2f((unsigned short)qf[ks][6]) * rq * gb.z * kb2.z, bf2f((unsigned short)qf[ks][7]) * rq * gb.w * kb2.w);
                qf[ks] = __builtin_bit_cast(bf16x8, w); }
        }
        v[1] += v[0]; v[2] += v[1]; v[3] += v[2];
        const float tot = v[3]; float sc = tot;
#pragma unroll
        for (int o = 1; o < 64; o <<= 1) { const float t = __shfl_up(sc, o); if (lane >= o) sc += t; }
        if (lane == 63) wsum[wid] = sc;
#pragma unroll
        for (int e = 0; e < 4; ++e) rkl[tid + 512 * e] = __builtin_amdgcn_rsqf(((kqv[e].x + kqv[e].y) + (kqv[e].z + kqv[e].w)) * (1.f / 128.f) + RMS_EPS);
        __syncthreads();
        float base = 0.f;
#pragma unroll
        for (int w = 0; w < 8; ++w) base += (w < wid) ? wsum[w] : 0.f;
        const float excl = base + sc - tot;
#pragma unroll
        for (int e = 0; e < 4; ++e) cl[4 * tid + e] = (excl + v[e]) * LOG2E;
    }
    if constexpr (!FOX) {
        f32x4 kqm[4]; float rcm[4], krm[4];
        { const int n = (qb + 1) * 256;
#pragma unroll
          for (int e = 0; e < 4; ++e) { const int sx = tid + 512 * e; kqm[e] = *(const f32x4*)(ksq + ((size_t)h * T + tok0 + sx) * 4); rcm[e] = ax.rckv[tok0 + sx]; krm[e] = ax.krss[tok0 + sx]; } (void)n; }
        {
            const int tokq = tok0 + q0 + r;
            const float rcq = __builtin_amdgcn_rsqf(pg8::slot_sum(ax.cqs + (size_t)tokq * 8, 8) * (1.f / 512.f) + RMS_EPS);
            float ss = 0.f;
#pragma unroll
            for (int ks = 0; ks < C::NKS; ++ks)
#pragma unroll
                for (int j = 0; j < 8; ++j) { const float v = bf2f((unsigned short)qf[ks][j]); ss += v * v; }
            ss = pair_sum(ss) * rcq * rcq;
            const float sc = rcq * __builtin_amdgcn_rsqf(ss * (1.f / 192.f) + RMS_EPS) * (0.07216878364870322f * LOG2E);
#pragma unroll
            for (int ks = 0; ks < 8; ++ks) { const int d0 = 16 * ks + 8 * hh; const f32x4 ga = *(const f32x4*)(gq + d0), gb = *(const f32x4*)(gq + d0 + 4), ka = *(const f32x4*)(gk + d0), kb2 = *(const f32x4*)(gk + d0 + 4);
                v4u w; w.x = pk2(bf2f((unsigned short)qf[ks][0]) * sc * ga.x * ka.x, bf2f((unsigned short)qf[ks][1]) * sc * ga.y * ka.y); w.y = pk2(bf2f((unsigned short)qf[ks][2]) * sc * ga.z * ka.z, bf2f((unsigned short)qf[ks][3]) * sc * ga.w * ka.w);
                w.z = pk2(bf2f((unsigned short)qf[ks][4]) * sc * gb.x * kb2.x, bf2f((unsigned short)qf[ks][5]) * sc * gb.y * kb2.y); w.w = pk2(bf2f((unsigned short)qf[ks][6]) * sc * gb.z * kb2.z, bf2f((unsigned short)qf[ks][7]) * sc * gb.w * kb2.w);
                qf[ks] = __builtin_bit_cast(bf16x8, w); }
#pragma unroll
            for (int kk = 0; kk < 2; ++kk) { const int i0 = 16 * kk + 8 * hh; const float* rp = ax.rope + (size_t)tokq * 64 + i0;
                const f32x4 c0 = *(const f32x4*)rp, c1 = *(const f32x4*)(rp + 4), s0_ = *(const f32x4*)(rp + 32), s1_ = *(const f32x4*)(rp + 36);
                const f32x4 g10 = *(const f32x4*)(gq + 128 + i0), g11 = *(const f32x4*)(gq + 132 + i0), g20 = *(const f32x4*)(gq + 160 + i0), g21 = *(const f32x4*)(gq + 164 + i0);
                float o1[8], o2[8];
#pragma unroll
                for (int j = 0; j < 8; ++j) { const float cj = j < 4 ? c0[j & 3] : c1[j & 3], sj = j < 4 ? s0_[j & 3] : s1_[j & 3], g1 = j < 4 ? g10[j & 3] : g11[j & 3], g2 = j < 4 ? g20[j & 3] : g21[j & 3];
                    const float x1 = bf2f((unsigned short)qf[8 + kk][j]) * sc * g1, x2 = bf2f((unsigned short)qf[10 + kk][j]) * sc * g2; o1[j] = x1 * cj - x2 * sj; o2[j] = x2 * cj + x1 * sj; }
                v4u w1, w2; w1.x = pk2(o1[0], o1[1]); w1.y = pk2(o1[2], o1[3]); w1.z = pk2(o1[4], o1[5]); w1.w = pk2(o1[6], o1[7]); w2.x = pk2(o2[0], o2[1]); w2.y = pk2(o2[2], o2[3]); w2.z = pk2(o2[4], o2[5]); w2.w = pk2(o2[6], o2[7]);
                qf[8 + kk] = __builtin_bit_cast(bf16x8, w1); qf[10 + kk] = __builtin_bit_cast(bf16x8, w2); }
        }
        {
#pragma unroll
            for (int e = 0; e < 4; ++e) { const int sx = tid + 512 * e; const f32x4 kq = kqm[e]; const float rc = rcm[e];
                const float rk = __builtin_amdgcn_rsqf((rc * rc * ((kq.x + kq.y) + (kq.z + kq.w)) + krm[e]) * (1.f / 192.f) + RMS_EPS); rkl[sx] = rk; cl[sx] = rk * rc; }
        }
    }
    f32x16 o[4];
#pragma unroll
    for (int i = 0; i < 4; ++i)
#pragma unroll
        for (int e = 0; e < 16; ++e) o[i][e] = 0.f;
    float m = -1e30f, l = 0.f;
    ATT_SYNC();
#pragma unroll 1
    for (int jj = 0; jj <= jmax; ++jj) { const int j = jmax - jj;
        if (jj < jmax) ATT_STAGE(j - 1, (jj + 1) & 1);
        if (j <= jw) {
#pragma unroll
            for (int kb2 = 0; kb2 < 2; ++kb2) { const int kbk = 1 - kb2;
                if (FOX && kbk == 1 && j == jw && (wid & 1) == 0) continue;
                f32x16 s0;
#pragma unroll
                for (int e = 0; e < 16; ++e) s0[e] = 0.f;
                const LAS unsigned char* kb = lds + C::OFF_K + (jj & 1) * C::KB_BYTES + ((32 * kbk + r) * C::KP + 8 * hh) * 2;
                if constexpr (FOX) {
#pragma unroll
                    for (int ks = 0; ks < C::NKS; ++ks) {
                        const bf16x8 a0 = *(const LAS bf16x8*)(kb + ks * 32);
                        s0 = __builtin_amdgcn_mfma_f32_32x32x16_bf16(a0, qf[ks], s0, 0, 0, 0);
                    }
                } else {
                    f32x16 sr;
#pragma unroll
                    for (int e = 0; e < 16; ++e) sr[e] = 0.f;
#pragma unroll
                    for (int ks = 0; ks < 8; ++ks) { const bf16x8 a0 = *(const LAS bf16x8*)(kb + ks * 32); s0 = __builtin_amdgcn_mfma_f32_32x32x16_bf16(a0, qf[ks], s0, 0, 0, 0); }
#pragma unroll
                    for (int ks = 8; ks < 12; ++ks) { const bf16x8 a0 = *(const LAS bf16x8*)(kb + ks * 32); sr = __builtin_amdgcn_mfma_f32_32x32x16_bf16(a0, qf[ks], sr, 0, 0, 0); }
                    const LAS f32x4* v4 = (const LAS f32x4*)(cl + 64 * j + 32 * kbk + 4 * hh); const LAS f32x4* r4 = (const LAS f32x4*)(rkl + 64 * j + 32 * kbk + 4 * hh);
#pragma unroll
                    for (int g = 0; g < 4; ++g) { const f32x4 kv = v4[2 * g], rr = r4[2 * g];
#pragma unroll
                        for (int e = 0; e < 4; ++e) s0[4 * g + e] = s0[4 * g + e] * kv[e] + sr[4 * g + e] * rr[e]; }
                }
                if constexpr (FOX) {
                    const LAS f32x4* c4 = (const LAS f32x4*)(cl + 64 * j + 32 * kbk + 4 * hh); const LAS f32x4* r4 = (const LAS f32x4*)(rkl + 64 * j + 32 * kbk + 4 * hh);
#pragma unroll
                    for (int g = 0; g < 4; ++g) { const f32x4 c0 = c4[2 * g], rr = r4[2 * g];
#pragma unroll
                        for (int e = 0; e < 4; ++e) s0[4 * g + e] = s0[4 * g + e] * rr[e] - c0[e]; }
                    if (j == jw) {
                        const int qrow = q0 + r, kbase = 64 * j + 32 * kbk + 4 * hh;
#pragma unroll
                        for (int e = 0; e < 16; ++e) { const int key = kbase + (e & 3) + 8 * (e >> 2); if (key > qrow) s0[e] = -1e30f; }
                    }
                }
                float mx = s0[0];
#pragma unroll
                for (int e = 1; e < 16; ++e) mx = fmaxf(mx, s0[e]);
                mx = pair_max(mx);
                const float mn = fmaxf(m, mx);
                if (__any(mn > m)) {
                    const float alpha = __builtin_amdgcn_exp2f(m - mn);
                    l *= alpha;
#pragma unroll
                    for (int i = 0; i < 4; ++i)
#pragma unroll
                        for (int e = 0; e < 16; ++e) o[i][e] *= alpha;
                    m = mn;
                }
                float ps = 0.f;
#pragma unroll
                for (int e = 0; e < 16; ++e) { s0[e] = __builtin_amdgcn_exp2f(s0[e] - m); ps += s0[e]; }
                l += ps;
                bf16x8 p[2];
#pragma unroll
                for (int s = 0; s < 2; ++s) {
                    v4u w0;
                    w0.x = pk2(s0[8 * s + 0], s0[8 * s + 1]); w0.y = pk2(s0[8 * s + 2], s0[8 * s + 3]); w0.z = pk2(s0[8 * s + 4], s0[8 * s + 5]); w0.w = pk2(s0[8 * s + 6], s0[8 * s + 7]);
                    p[s] = __builtin_bit_cast(bf16x8, w0);
                }
                const LAS unsigned char* vb = lds + C::OFF_V + (jj & 1) * C::VB_BYTES + (r * C::VP + 32 * kbk + 8 * hh) * 2;
#pragma unroll
                for (int dvb = 0; dvb < 4; ++dvb)
#pragma unroll
                    for (int s = 0; s < 2; ++s) {
                        const bf16x8 a = *(const LAS bf16x8*)(vb + (dvb * 32 * C::VP + 16 * s) * 2);
                        o[dvb] = __builtin_amdgcn_mfma_f32_32x32x16_bf16(a, p[s], o[dvb], 0, 0, 0);
                    }
            }
        }
        ATT_SYNC();
    }
#undef ATT_STAGE
#undef ATT_SYNC
    l = pair_sum(l);
    const float inv = 1.f / l;
    int re = r, he = hh; asm volatile("" : "+v"(re), "+v"(he));
    static_assert(C::END + 8 * 4608 <= LDSCTL_OFF, "attention O staging");
    LAS unsigned char* ost = lds + C::END + wid * 4608;
    const int rr = lane >> 3, cc = lane & 7;
    const size_t orow0 = (size_t)(tok0 + q0);
#pragma unroll
    for (int half = 0; half < 2; ++half) {
#pragma unroll
        for (int d2 = 0; d2 < 2; ++d2)
#pragma unroll
            for (int g = 0; g < 4; ++g) { const int dvb = 2 * half + d2;
                v2u w; w.x = pk2(o[dvb][4 * g + 0] * inv, o[dvb][4 * g + 1] * inv); w.y = pk2(o[dvb][4 * g + 2] * inv, o[dvb][4 * g + 3] * inv);
                *(LAS v2u*)(ost + re * 144 + (d2 * 32 + 8 * g + 4 * he) * 2) = w; }
        asm volatile("s_waitcnt lgkmcnt(0)" ::: "memory");
#pragma unroll
        for (int i = 0; i < 4; ++i) { const int row = 8 * i + rr;
            v4u w = *(const LAS v4u*)(ost + row * 144 + cc * 16);
            if constexpr (FOX) {
                const v4u gw = *(const v4u*)(gate + (orow0 + row) * gpitch + h * 128 + half * 64 + cc * 8);
#pragma unroll
                for (int c = 0; c < 4; ++c) { const float lo = bflo(w[c]) * __builtin_amdgcn_rcpf(1.f + __builtin_amdgcn_exp2f(-LOG2E * bflo(gw[c]))), hi = bfhi(w[c]) * __builtin_amdgcn_rcpf(1.f + __builtin_amdgcn_exp2f(-LOG2E * bfhi(gw[c]))); w[c] = pk2(lo, hi); }
            }
            *(v4u*)(O + (orow0 + row) * 2048 + h * 128 + half * 64 + cc * 8) = w; }
        asm volatile("s_waitcnt lgkmcnt(0)" ::: "memory");
    }
}
template <int DK, bool FOX>
__device__ __forceinline__ void p_attention(const Frame& F, const bf16* Q, int qpitch, const bf16* K, int kpitch, const bf16* Vt, bf16* O, const bf16* gate, int gpitch, const float* lf, const AttnAux& ax) {
    for (int u = F.vcu; u < 256; u += F.G) {
        const int bh = u >> 2, p = u & 3, b = bh >> 4, h = bh & 15;
#pragma unroll 1
        for (int half = 0; half < 2; ++half)
            attn_unit<DK, FOX>(F.lds + RING_OFF, Q, qpitch, K, kpitch, Vt, O, gate, gpitch, lf, ax, b, h, half ? p : 7 - p, F.tid, F.wave, F.lane);
    }
}

__device__ __forceinline__ unsigned sortkey(float s) { const unsigned b = __float_as_uint(s); return b ^ ((unsigned)((int)b >> 31) | 0x80000000u); }
__device__ __forceinline__ float unsortkey(unsigned k) { return __uint_as_float((k & 0x80000000u) ? (k ^ 0x80000000u) : ~k); }
#define TOP_INSERT(top, x) do { unsigned _x = (x); _Pragma("unroll") for (int _i = 0; _i < 16; ++_i) { const unsigned _h = max((top)[_i], _x); _x = min((top)[_i], _x); (top)[_i] = _h; } } while (0)
__device__ __forceinline__ int sel16(const int (&a)[16], int i) { int r = a[0];
#pragma unroll
    for (int q = 1; q < 16; ++q) r = (i == q) ? a[q] : r;
    return r; }
#define CE_DESC(a, b) do { const unsigned _hi = max((a), (b)), _lo = min((a), (b)); (a) = _hi; (b) = _lo; } while (0)
__device__ __forceinline__ void bitonic_merge16_desc(unsigned (&v)[16]) {
#pragma unroll
    for (int j = 8; j > 0; j >>= 1)
#pragma unroll
        for (int i = 0; i < 16; ++i) if ((i & j) == 0) CE_DESC(v[i], v[i | j]);
}
__device__ __forceinline__ void sort16_desc(unsigned (&v)[16]) {
#pragma unroll
    for (int k = 2; k <= 16; k <<= 1)
#pragma unroll
        for (int j = k >> 1; j > 0; j >>= 1)
#pragma unroll
            for (int i = 0; i < 16; ++i) { const int l = i ^ j; if (l > i) { if ((i & k) == 0 || k == 16) CE_DESC(v[i], v[l]); else CE_DESC(v[l], v[i]); } }
}
__device__ __forceinline__ void merge_top16(unsigned (&top)[16], const unsigned (&b)[16]) {
#pragma unroll
    for (int i = 0; i < 16; ++i) top[i] = max(top[i], b[15 - i]);
    bitonic_merge16_desc(top);
}
__device__ __forceinline__ void peer_half_top16(const bf16* __restrict__ qrow  , const bf16* __restrict__ sk  , int hh, unsigned (&top)[16]) {
#pragma unroll
    for (int i = 0; i < 16; ++i) top[i] = 0u;
#pragma unroll 1
    for (int kb = 0; kb < 4; ++kb) {
        f32x16 acc;
#pragma unroll
        for (int e = 0; e < 16; ++e) acc[e] = 0.f;
        const bf16* skb = sk + (size_t)kb * 32 * 128;
#pragma unroll
        for (int ks = 0; ks < 8; ++ks) { const bf16x8 qf = *(const bf16x8*)(qrow + 16 * ks), a = *(const bf16x8*)(skb + 16 * ks); acc = __builtin_amdgcn_mfma_f32_32x32x16_bf16(a, qf, acc, 0, 0, 0); }
        const int kbase = 127 - (32 * kb + 4 * hh);
        unsigned nv[16];
#pragma unroll
        for (int e = 0; e < 16; ++e) nv[e] = (sortkey(acc[e]) & ~127u) | (unsigned)(kbase - ((e & 3) + 8 * (e >> 2)));
        sort16_desc(nv); merge_top16(top, nv);
    }
    unsigned pt[16];
#pragma unroll
    for (int i = 0; i < 16; ++i) pt[i] = (unsigned)__shfl_xor((int)top[i], 32);
    merge_top16(top, pt);
}
constexpr int PE_OFF_IDX = 0, PE_OFF_G = 16384, PE_OFF_TB = 32768;
__device__ __forceinline__ void peer_topk(const Frame& F, int layer, int t0) {
    const int lane = F.lane, r = lane & 31, hh = lane >> 5, head = F.wave;
    const bf16* qp = (const bf16*)(F.ws + WS_QP) + (size_t)(t0 + r) * 2048 + head * 256 + 8 * hh;
    const bf16* sk = (const bf16*)(F.ws + WS_SKB) + (size_t)layer * 2 * 128 * 128 + r * 128 + 8 * hh;
    unsigned t1[16], t2[16];
    peer_half_top16(qp, sk, hh, t1);
    peer_half_top16(qp + 128, sk + 128 * 128, hh, t2);
    int rr = r; asm volatile("" : "+v"(rr));
    const float rs = __builtin_amdgcn_rsqf(pg8::slot_sum((const float*)(F.ws + WS_SSQ) + SSQ_XS + (size_t)(t0 + rr) * 32, 32) * (1.f / 2048.f) + RMS_EPS);
    float v1[16], v2[16]; int e1[16], e2[16];
#pragma unroll
    for (int i = 0; i < 16; ++i) { v1[i] = unsortkey(t1[i] & ~127u) * rs; e1[i] = 127 - (int)(t1[i] & 127u); v2[i] = unsortkey(t2[i] & ~127u) * rs; e2[i] = 127 - (int)(t2[i] & 127u); }
    unsigned best[16], g1[16], g2[16], g3[16];
#pragma unroll
    for (int i = 0; i < 16; ++i) { best[i] = 0u; g1[i] = 0u; g2[i] = 0u; g3[i] = 0u; }
    { int n = 0;
#pragma unroll
      for (int i = 0; i < 16; ++i)
#pragma unroll
        for (int j = 0; j < 16; ++j)
            if ((i + 1) * (j + 1) <= 16) { const unsigned kx = (sortkey(v1[i] + v2[j]) & ~255u) | (unsigned)(255 - (i * 16 + j));
                if (n < 16) best[n & 15] = kx; else if (n < 32) g1[n & 15] = kx; else if (n < 48) g2[n & 15] = kx; else g3[n & 15] = kx; ++n; } }
    sort16_desc(best); sort16_desc(g1); sort16_desc(g2); sort16_desc(g3);
    merge_top16(best, g1); merge_top16(best, g2); merge_top16(best, g3);
    float sc[16]; int ex[16];
    LAS int* tb = (LAS int*)(F.lds + RING_OFF + PE_OFF_TB) + F.wave * 2048 + lane;
#pragma unroll
    for (int i = 0; i < 16; ++i) { tb[i * 64] = e1[i]; tb[(16 + i) * 64] = e2[i]; }
#pragma unroll
    for (int k = 0; k < 16; ++k) { const int pos = 255 - (int)(best[k] & 255u); ex[k] = tb[(pos >> 4) * 64] * PE_NK + tb[(16 + (pos & 15)) * 64]; sc[k] = unsortkey(best[k] & ~255u); }
    float sum = 0.f; const float smax = sc[0];
#pragma unroll
    for (int k = 0; k < 16; ++k) { sc[k] = __expf(sc[k] - smax); sum += sc[k]; }
    const float inv = 1.f / sum;
    LAS int* li = (LAS int*)(F.lds + RING_OFF + PE_OFF_IDX) + r * PE_SEL + head * 16;
    LAS float* lg = (LAS float*)(F.lds + RING_OFF + PE_OFF_G) + r * PE_SEL + head * 16;
    if (hh == 0) {
#pragma unroll
        for (int k = 0; k < 16; ++k) li[k] = ex[k];
    } else {
#pragma unroll
        for (int k = 0; k < 16; ++k) lg[k] = sc[k] * inv;
    }
}
__device__ __forceinline__ float group_sum64(float v) {
    const int i0 = __builtin_bit_cast(int, v);
    v += __builtin_bit_cast(float, __builtin_amdgcn_update_dpp(0, i0, 0x111, 0xf, 0xf, true));
    v += __builtin_bit_cast(float, __builtin_amdgcn_update_dpp(0, __builtin_bit_cast(int, v), 0x112, 0xf, 0xf, true));
    v += __builtin_bit_cast(float, __builtin_amdgcn_update_dpp(0, __builtin_bit_cast(int, v), 0x114, 0xf, 0xf, true));
    v += __builtin_bit_cast(float, __builtin_amdgcn_update_dpp(0, __builtin_bit_cast(int, v), 0x118, 0xf, 0xf, true));
    v += __builtin_bit_cast(float, __builtin_amdgcn_update_dpp(0, __builtin_bit_cast(int, v), 0x142, 0xa, 0xf, false));
    v += __builtin_bit_cast(float, __builtin_amdgcn_update_dpp(0, __builtin_bit_cast(int, v), 0x143, 0xc, 0xf, false));
    return v;
}
__device__ __forceinline__ float gelu_erf(float x) { return 0.5f * x * (1.f + erff(x * 0.7071067811865476f)); }
typedef float f32x2 __attribute__((ext_vector_type(2)));
__device__ __forceinline__ void sort128(unsigned& kA, unsigned& kB, int lane) {
#pragma unroll
    for (int k = 2; k <= 128; k <<= 1)
#pragma unroll
        for (int j = k >> 1; j > 0; j >>= 1) {
            if (j == 64) { const unsigned lo = min(kA, kB), hi = max(kA, kB); kA = lo; kB = hi; }
            else {
                const unsigned pA = (unsigned)__shfl_xor((int)kA, j), pB = (unsigned)__shfl_xor((int)kB, j);
                const bool lower = (lane & j) == 0, upA = (lane & k) == 0, upB = ((lane + 64) & k) == 0;
                kA = (lower == upA) ? min(kA, pA) : max(kA, pA);
                kB = (lower == upB) ? min(kB, pB) : max(kB, pB);
            }
        }
}
constexpr int PE_NS = 32, PE_SLICE = PE_NE / PE_NS;
constexpr int PE_PACE = 64;
typedef int v4i __attribute__((ext_vector_type(4)));
constexpr int PE_D = 6;
constexpr int PE2_KEYS = 0, PE2_G = 16384, PE2_A = 32768, PE2_ORD = 49152, PE2_CT = 65536, PE2_RING = 73728, PE2_END = PE2_RING + 8 * 5 * 2048;
static_assert(PE2_G == PE_OFF_G && PE2_KEYS == PE_OFF_IDX && PE2_END <= 160 * 1024 - 1024, "peer LDS map");
#define PE_WAITV(n) asm volatile("s_waitcnt vmcnt(" #n ")" ::: "memory")
template <int LAYER>
__device__ __forceinline__ void peer_gather4(const Frame& F, const In& I, int t0w, int tl0, int dry) {
    const int lane = F.lane, wv = F.wave;
    const float* gain = I.g_ffn + LAYER * 2048;
    const unsigned char* ut = F.ws + WS_PU + (size_t)LAYER * PE_NE * D + lane * 16;
    const unsigned char* vt = F.ws + WS_PV + (size_t)LAYER * PE_NE * D + lane * 16;
    const float* su = (const float*)(F.ws + WS_PSU) + LAYER * PE_NE; const float* sv = (const float*)(F.ws + WS_PSV) + LAYER * PE_NE;
    LAS unsigned* keys = (LAS unsigned*)(F.lds + RING_OFF + PE2_KEYS) + tl0 * PE_SEL;
    LAS float* lg = (LAS float*)(F.lds + RING_OFF + PE2_G) + tl0 * PE_SEL;
    LAS float* la = (LAS float*)(F.lds + RING_OFF + PE2_A) + tl0 * PE_SEL;
    LAS unsigned* ord = (LAS unsigned*)(F.lds + RING_OFF + PE2_ORD) + wv * 512;
    LAS int* ct = (LAS int*)(F.lds + RING_OFF + PE2_CT) + wv * 256;
    LAS unsigned char* ring = F.lds + RING_OFF + PE2_RING + wv * (5 * 2048);
    LAS unsigned char* ring5 = F.lds + RING_OFF + PE2_KEYS + wv * 2048;
#define PE_SLOT(sl) (((sl) < 5) ? ring + (sl) * 2048 : ring5)
    unsigned sA[4], sB[4];
#pragma unroll
    for (int tk = 0; tk < 4; ++tk) {
        sA[tk] = (keys[tk * PE_SEL + lane] << 7) | (unsigned)lane; sB[tk] = (keys[tk * PE_SEL + 64 + lane] << 7) | (unsigned)(64 + lane);
        sort128(sA[tk], sB[tk], lane);
    }
    if (lane < 4) ct[lane * 36] = 0;
#pragma unroll 1
    for (int s = 0; s < PE_NS; ++s) { const unsigned limit = (unsigned)((s + 1) * PE_SLICE) << 7;
#pragma unroll
        for (int tk = 0; tk < 4; ++tk) { const int c = __builtin_popcountll(__ballot(sA[tk] < limit)) + __builtin_popcountll(__ballot(sB[tk] < limit)); if (lane == 0) ct[tk * 36 + s + 1] = c; } }
#pragma unroll
    for (int tk = 0; tk < 4; ++tk) {
#pragma unroll
        for (int hb = 0; hb < 2; ++hb) { const unsigned key = hb ? sB[tk] : sA[tk]; const int pos = lane + 64 * hb, e = (int)(key >> 7), sl = e / PE_SLICE; int rank = pos;
#pragma unroll
            for (int t2 = 0; t2 < 4; ++t2) if (t2 != tk) rank += ct[t2 * 36 + sl + (t2 < tk ? 1 : 0)];
            ord[rank] = ((unsigned)e << 9) | (unsigned)(tk << 7) | (unsigned)pos; }
    }
    float glA[4], glB[4];
#pragma unroll
    for (int tk = 0; tk < 4; ++tk) { glA[tk] = lg[tk * PE_SEL + (sA[tk] & 127u)]; glB[tk] = lg[tk * PE_SEL + (sB[tk] & 127u)]; }
    const int bj = lane & 3, bb = lane >> 2;
    int hq[8][4]; float shl = 1.f;
    {
        LAS unsigned char* himg = ring;
#pragma unroll
        for (int tk = 0; tk < 4; ++tk) {
            const float* xrow = F.out + (size_t)(t0w + tk) * D + 4 * lane; const float* grow = gain + 4 * lane;
            const float rs = __builtin_amdgcn_rsqf(pg8::slot_sum((const float*)(F.ws + WS_SSQ) + SSQ_XS + (size_t)(t0w + tk) * 32, 32) * (1.f / 2048.f) + RMS_EPS);
            f32x4 hv[8]; float mx = 0.f;
#pragma unroll
            for (int q = 0; q < 8; ++q) { const f32x4 xv = *(const f32x4*)(xrow + 256 * q), gv = *(const f32x4*)(grow + 256 * q);
                const f32x4 t = (f32x4){xv.x * rs * gv.x, xv.y * rs * gv.y, xv.z * rs * gv.z, xv.w * rs * gv.w}; hv[q] = t;
                mx = fmaxf(mx, fmaxf(fmaxf(fabsf(t.x), fabsf(t.y)), fmaxf(fabsf(t.z), fabsf(t.w)))); }
#pragma unroll
            for (int o = 1; o < 64; o <<= 1) mx = fmaxf(mx, __shfl_xor(mx, o));
            const float inv = mx > 0.f ? 127.f / mx : 1.f; if (bj == tk) shl = mx > 0.f ? mx * (1.f / 127.f) : 1.f;
            unsigned dq[8];
#pragma unroll
            for (int q = 0; q < 8; ++q) { const f32x4 t = hv[q] * inv; dq[q] = (unsigned)((__float2int_rn(t.x) & 255) | ((__float2int_rn(t.y) & 255) << 8) | ((__float2int_rn(t.z) & 255) << 16) | (__float2int_rn(t.w) << 24)); }
            *(LAS v4u*)(himg + tk * 2048 + 16 * lane) = (v4u){dq[0], dq[1], dq[2], dq[3]}; *(LAS v4u*)(himg + tk * 2048 + 1024 + 16 * lane) = (v4u){dq[4], dq[5], dq[6], dq[7]};
            asm volatile("" ::: "memory");
        }
        asm volatile("s_waitcnt lgkmcnt(0)" ::: "memory");
#pragma unroll
        for (int s8 = 0; s8 < 8; ++s8) { const v4u t = *(const LAS v4u*)(himg + bj * 2048 + 256 * s8 + 16 * bb); hq[s8][0] = (int)t.x; hq[s8][1] = (int)t.y; hq[s8][2] = (int)t.z; hq[s8][3] = (int)t.w; }
    }
    asm volatile("s_waitcnt vmcnt(0) lgkmcnt(0)" ::: "memory");
    static_assert(PE_D == 6, "the counted wait below is vmcnt(2 * (PE_D - 1))");
#define PE_EMASK
#define PE_ISSUE(tab, code, slot) do { const unsigned char* _g = (tab) + ((size_t)((code) >> 9) << 11); \
        LAS unsigned char* _d = PE_SLOT(slot); \
        __builtin_amdgcn_global_load_lds((const unsigned*)_g, (LAS unsigned*)_d, 16, 0, 0); \
        __builtin_amdgcn_global_load_lds((const unsigned*)(_g + 1024), (LAS unsigned*)(_d + 1024), 16, 0, 0); } while (0)
#define PE_ROW_HEAD(tab) \
                    const int i6 = r & 63, ia = i6 + PE_D; const unsigned codea = (unsigned)__builtin_amdgcn_readlane((int)((ia < 64) ? oc : on), ia & 63); \
                    PE_WAITV(10); \
                    v4u w[2]; { const LAS unsigned char* _s = PE_SLOT(slot); w[0] = *(const LAS v4u*)(_s + lane * 16); w[1] = *(const LAS v4u*)(_s + 1024 + lane * 16); } \
                    asm volatile("s_waitcnt lgkmcnt(0)" ::: "memory"); \
                    PE_ISSUE(tab, codea, slot);
#define PE_ROW_TAIL() \
                    slot = (slot + 1 == PE_D) ? 0 : slot + 1; ++r; \
                    if ((r & 63) == 0) { const int nb = (r >> 6) + 1; oc = on; on = ord[((nb < 8) ? nb : 7) * 64 + lane]; asm volatile("s_waitcnt lgkmcnt(0)" ::: "memory"); }
    LAS _Float16* lah = (LAS _Float16*)(F.lds + RING_OFF + PE2_A + wv * 2048);
    LAS float* lav = lg;
    {
        LAS unsigned char* const sl5 = F.lds + RING_OFF + PE2_KEYS + wv * 2048;
        LAS unsigned char* const sl6 = F.lds + RING_OFF + PE2_G + wv * 2048;
        LAS unsigned char* const sl7lo = F.lds + RING_OFF + PE2_A + wv * 2048 + 1024;
        LAS unsigned char* const sl7hi = F.lds + RING_OFF + PE2_CT + wv * 1024;
#define U_LO(k) ((k) < 5 ? ring + (k) * 2048 : (k) == 5 ? sl5 : (k) == 6 ? sl6 : sl7lo)
#define U_HI(k) ((k) < 7 ? U_LO(k) + 1024 : sl7hi)
        const LAS unsigned char* ad[2][8];
#pragma unroll
        for (int p = 0; p < 2; ++p) {
            const LAS unsigned char* lo = bj == 0 ? U_LO(4 * p) : bj == 1 ? U_LO(4 * p + 1) : bj == 2 ? U_LO(4 * p + 2) : U_LO(4 * p + 3);
            const LAS unsigned char* hi = bj == 0 ? U_HI(4 * p) : bj == 1 ? U_HI(4 * p + 1) : bj == 2 ? U_HI(4 * p + 2) : U_HI(4 * p + 3);
#pragma unroll
            for (int s8 = 0; s8 < 8; ++s8) ad[p][s8] = (s8 < 4 ? lo : hi) + 16 * ((16 * (s8 & 3) + bb - 4 * bj) & 63);
        }
        const unsigned char* utr[4];
#pragma unroll
        for (int i = 0; i < 4; ++i) utr[i] = F.ws + WS_PU + (size_t)LAYER * PE_NE * D + 16 * ((lane + 4 * i) & 63);
#define U_ISSUE(i, k, code) do { const unsigned char* _g = utr[i] + ((size_t)(((code) >> 9) PE_EMASK) << 11); \
        __builtin_amdgcn_global_load_lds((const unsigned*)_g, (LAS unsigned*)U_LO(k), 16, 0, 0); \
        __builtin_amdgcn_global_load_lds((const unsigned*)(_g + 1024), (LAS unsigned*)U_HI(k), 16, 0, 0); } while (0)
        { const v4u c0 = *(const LAS v4u*)(ord), c1 = *(const LAS v4u*)(ord + 4);
          asm volatile("s_waitcnt lgkmcnt(0)" ::: "memory");
#pragma unroll
          for (int i = 0; i < 4; ++i) U_ISSUE(i, i, (unsigned)__builtin_amdgcn_readfirstlane((int)c0[i]));
#pragma unroll
          for (int i = 0; i < 4; ++i) U_ISSUE(i, 4 + i, (unsigned)__builtin_amdgcn_readfirstlane((int)c1[i])); }
#pragma unroll 1
        for (int g2 = 0; g2 < 64; ++g2) {
#pragma unroll
            for (int p = 0; p < 2; ++p) {
                const int r = 8 * g2 + 4 * p, nx = (r + 8 < 508) ? r + 8 : 508;
                const v4u cn = *(const LAS v4u*)(ord + nx); const unsigned cm = ord[r + (lane >> 4)];
                PE_WAITV(8);
                v4u a[8];
#pragma unroll
                for (int s8 = 0; s8 < 8; ++s8) a[s8] = *(const LAS v4u*)ad[p][s8];
                asm volatile("s_waitcnt lgkmcnt(0)" ::: "memory");
#pragma unroll
                for (int i = 0; i < 4; ++i) U_ISSUE(i, 4 * p + i, (unsigned)__builtin_amdgcn_readfirstlane((int)cn[i]));
                v4i d0 = (v4i){0, 0, 0, 0}, d1 = (v4i){0, 0, 0, 0};
#pragma unroll
                for (int s8 = 0; s8 < 8; ++s8)
#pragma unroll
                    for (int c = 0; c < 4; ++c) { if (c & 1) d1 = __builtin_amdgcn_mfma_i32_4x4x4i8((int)a[s8][c], hq[s8][c], d1, 0, 0, 0); else d0 = __builtin_amdgcn_mfma_i32_4x4x4i8((int)a[s8][c], hq[s8][c], d0, 0, 0, 0); }
                unsigned e0 = (unsigned)(d0[0] + d1[0]), e1 = (unsigned)(d0[1] + d1[1]), e2 = (unsigned)(d0[2] + d1[2]), e3 = (unsigned)(d0[3] + d1[3]);
                { const auto t = __builtin_amdgcn_permlane32_swap(e0, e2, false, false); e0 = t[0] + t[1]; }
                { const auto t = __builtin_amdgcn_permlane32_swap(e1, e3, false, false); e1 = t[0] + t[1]; }
                { const auto t = __builtin_amdgcn_permlane16_swap(e0, e1, false, false); e0 = t[0] + t[1]; }
                e0 += (unsigned)__builtin_amdgcn_update_dpp(0, (int)e0, 0x124, 0xf, 0xf, true);
                e0 += (unsigned)__builtin_amdgcn_update_dpp(0, (int)e0, 0x128, 0xf, 0xf, true);
                const float val = (float)(int)e0 * shl * (1.f / 256.f);
                if ((lane & 12) == 0 && ((cm >> 7) & 3u) == (unsigned)bj) lah[cm & 511u] = (_Float16)val;
            }
        }
        asm volatile("s_waitcnt vmcnt(0) lgkmcnt(0)" ::: "memory");
#undef U_ISSUE
#undef U_LO
#undef U_HI
    }
#pragma unroll
    for (int tk = 0; tk < 4; ++tk) {
#pragma unroll
        for (int hb = 0; hb < 2; ++hb) { const unsigned key = hb ? sB[tk] : sA[tk]; const int pos = lane + 64 * hb, e = (int)(key >> 7);
            const float av = (float)lah[tk * PE_SEL + pos] * 256.f * su[e]; lav[tk * PE_SEL + pos] = gelu_erf(av) * (hb ? glB[tk] : glA[tk]) * sv[e]; }
    }
    asm volatile("s_waitcnt vmcnt(0) lgkmcnt(0)" ::: "memory");
    f32x2 acc[4][16];
#pragma unroll
    for (int tk = 0; tk < 4; ++tk)
#pragma unroll
        for (int i = 0; i < 16; ++i) acc[tk][i] = (f32x2){0.f, 0.f};
    {
        unsigned oc = ord[lane], on = ord[64 + lane];
        asm volatile("s_waitcnt lgkmcnt(0)" ::: "memory");
#pragma unroll
        for (int i = 0; i < PE_D; ++i) PE_ISSUE(vt, (unsigned)__builtin_amdgcn_readlane((int)oc, i), i);
        int slot = 0, r = 0; int ptr[4] = {0, 0, 0, 0};
#pragma unroll 1
        for (int s = 0; s < PE_NS; ++s) {
            const unsigned limit = (unsigned)((s + 1) * PE_SLICE) << 7;
#pragma unroll
            for (int tk = 0; tk < 4; ++tk) {
                const int end = __builtin_popcountll(__ballot(sA[tk] < limit)) + __builtin_popcountll(__ballot(sB[tk] < limit));
#pragma unroll 1
                for (int pos = ptr[tk]; pos < end; ++pos) {
                    const float a = lav[tk * PE_SEL + pos];
                    PE_ROW_HEAD(vt)
#pragma unroll
                    for (int j = 0; j < 2; ++j)
#pragma unroll
                        for (int c = 0; c < 4; ++c) { const unsigned wd = w[j][c];
                            acc[tk][8 * j + 2 * c] += __builtin_amdgcn_cvt_pk_f32_fp8((int)wd, false) * a; acc[tk][8 * j + 2 * c + 1] += __builtin_amdgcn_cvt_pk_f32_fp8((int)wd, true) * a; }
                    PE_ROW_TAIL()
                }
                ptr[tk] = end;
            }
            if ((s & (PE_PACE - 1)) == PE_PACE - 1) __builtin_amdgcn_s_barrier();
        }
        asm volatile("s_waitcnt vmcnt(0) lgkmcnt(0)" ::: "memory");
    }
#undef PE_ROW_HEAD
#undef PE_ROW_TAIL
#undef PE_SLOT
#undef PE_ISSUE
    asm volatile("" ::: "memory");
    float sqv[4] = {0.f, 0.f, 0.f, 0.f};
#pragma unroll
    for (int tk = 0; tk < 4; ++tk) {
        const int tok = t0w + tk;
        float* xrow = F.out + (size_t)tok * D;
        float* xdst = dry ? (float*)(F.ws + WS_Z) + (size_t)tok * D : xrow;
        float sq = 0.f;
#pragma unroll
        for (int j = 0; j < 2; ++j) {
            unsigned pk[8];
#pragma unroll
            for (int q = 0; q < 4; ++q) { const int d = j * 1024 + lane * 16 + 4 * q; f32x4 xv = *(const f32x4*)(xrow + d);
                xv.x += acc[tk][8 * j + 2 * q].x; xv.y += acc[tk][8 * j + 2 * q].y; xv.z += acc[tk][8 * j + 2 * q + 1].x; xv.w += acc[tk][8 * j + 2 * q + 1].y;
                *(f32x4*)(xdst + d) = xv;
                if constexpr (LAYER == 0) { sq += (xv.x * xv.x + xv.y * xv.y) + (xv.z * xv.z + xv.w * xv.w); pk[2 * q] = pk2(xv.x, xv.y); pk[2 * q + 1] = pk2(xv.z, xv.w);
                    acc[tk][8 * j + 2 * q] = (f32x2){xv.x, xv.y}; acc[tk][8 * j + 2 * q + 1] = (f32x2){xv.z, xv.w}; } }
            if constexpr (LAYER == 0) { unsigned char* xb = F.ws + WS_XB + ((size_t)tok * D + j * 1024 + lane * 16) * 2;
                *(v4u*)xb = (v4u){pk[0], pk[1], pk[2], pk[3]}; *(v4u*)(xb + 16) = (v4u){pk[4], pk[5], pk[6], pk[7]}; }
            asm volatile("" ::: "memory");
        }
        if constexpr (LAYER == 0) { sq = wave_sum(sq); sqv[tk] = sq; if (lane == 0) ((float*)(F.ws + WS_SSQ))[SSQ_X2 + tok] = sq; }
    }
    if constexpr (LAYER == 0) {
        const float* wf = (const float*)(F.ws + WS_WF) + lane * 16;
        float mine = 0.f;
#pragma unroll 1
        for (int jf = 0; jf < 16; ++jf) {
            f32x2 sacc[4] = {{0.f, 0.f}, {0.f, 0.f}, {0.f, 0.f}, {0.f, 0.f}};
#pragma unroll
            for (int j = 0; j < 2; ++j)
#pragma unroll
                for (int q = 0; q < 4; ++q) { const f32x4 wv = *(const f32x4*)(wf + jf * 2048 + j * 1024 + 4 * q);
#pragma unroll
                    for (int tk = 0; tk < 4; ++tk) { sacc[tk] += acc[tk][8 * j + 2 * q] * (f32x2){wv.x, wv.y}; sacc[tk] += acc[tk][8 * j + 2 * q + 1] * (f32x2){wv.z, wv.w}; } }
            float s0 = sacc[0].x + sacc[0].y, s1 = sacc[1].x + sacc[1].y, s2 = sacc[2].x + sacc[2].y, s3 = sacc[3].x + sacc[3].y;
            { const auto t = __builtin_amdgcn_permlane32_swap(__float_as_uint(s0), __float_as_uint(s2), false, false); s0 = __uint_as_float(t[0]) + __uint_as_float(t[1]); }
            { const auto t = __builtin_amdgcn_permlane32_swap(__float_as_uint(s1), __float_as_uint(s3), false, false); s1 = __uint_as_float(t[0]) + __uint_as_float(t[1]); }
            { const auto t = __builtin_amdgcn_permlane16_swap(__float_as_uint(s0), __float_as_uint(s1), false, false); s0 = __uint_as_float(t[0]) + __uint_as_float(t[1]); }
            s0 += __int_as_float(__builtin_amdgcn_update_dpp(0, __float_as_int(s0), 0x128, 0xf, 0xf, true));
            s0 += __int_as_float(__builtin_amdgcn_update_dpp(0, __float_as_int(s0), 0x124, 0xf, 0xf, true));
            s0 += __int_as_float(__builtin_amdgcn_update_dpp(0, __float_as_int(s0), 0x122, 0xf, 0xf, true));
            s0 += __int_as_float(__builtin_amdgcn_update_dpp(0, __float_as_int(s0), 0x121, 0xf, 0xf, true));
            if ((lane & 15) == jf) mine = s0;
        }
        { const int q = lane >> 4; const float sqq = q == 0 ? sqv[0] : q == 1 ? sqv[1] : q == 2 ? sqv[2] : sqv[3];
          const float rs2 = __builtin_amdgcn_rsqf(sqq * (1.f / 2048.f) + RMS_EPS);
          const float zf = mine * rs2 + I.fox_b_f[lane & 15]; const float ls = fminf(zf, 0.f) - log1pf(__expf(-fabsf(zf)));
          ((float*)(F.ws + WS_LF))[(size_t)(lane & 15) * T + (t0w + q)] = ls; }
    }
}
template <int LAYER>
__device__ __forceinline__ void p_peer(const Frame& F, const In& I, int dry) {
    for (int tb = F.vcu; tb < T / 32; tb += F.G) {
        const int t0 = tb * 32;
        Frame Fo = F; asm volatile("" : "+v"(Fo.lane), "+v"(Fo.tid));
        peer_topk(Fo, LAYER, t0);
        __syncthreads();
#ifdef TOPK_PROBE
        peer_topk(Fo, LAYER, t0);
        __syncthreads();
#endif
        asm volatile("" : "+v"(Fo.lane));
        peer_gather4<LAYER>(Fo, I, t0 + F.wave * 4, F.wave * 4, dry);
        __syncthreads();
    }
}
#ifdef SELFCHECK
constexpr int DG_CHUNK = 8192, DG_MAXCH = 8192, DG_NBUF = 3, DG_NPASS = 4;
constexpr size_t WS_DG = WS_END;
constexpr size_t DG_BYTES = (size_t)DG_NPASS * N_PHASES * DG_NBUF * DG_MAXCH * 8;
__global__ void __launch_bounds__(256) dg_kernel(const void* buf, int is_f32, size_t nelem, float2* dig) {
    const int c = blockIdx.x; const size_t e0 = (size_t)c * DG_CHUNK; float s = 0.f, a = 0.f;
    for (int i = threadIdx.x; i < DG_CHUNK; i += 256) { const size_t e = e0 + i; if (e < nelem) { const float v = is_f32 ? ((const float*)buf)[e] : __uint_as_float((unsigned)((const unsigned short*)buf)[e] << 16);
        const float w = ((i * 2654435761u) >> 13) & 1 ? 1.f : -1.f; s += w * v; a += fabsf(v); } }
    __shared__ float ss[256], sa[256]; ss[threadIdx.x] = s; sa[threadIdx.x] = a; __syncthreads();
    for (int o = 128; o > 0; o >>= 1) { if ((int)threadIdx.x < o) { ss[threadIdx.x] += ss[threadIdx.x + o]; sa[threadIdx.x] += sa[threadIdx.x + o]; } __syncthreads(); }
    if (threadIdx.x == 0) dig[c] = make_float2(ss[0], sa[0]);
}
__global__ void dg_compare(const float2* dig, unsigned* flag  ) {
    const int p = blockIdx.x;
    for (int q = 1; q < DG_NPASS; ++q)
        for (int i = threadIdx.x; i < DG_NBUF * DG_MAXCH; i += blockDim.x) {
            const float2 a = dig[((size_t)0 * N_PHASES + p) * DG_NBUF * DG_MAXCH + i], b = dig[((size_t)q * N_PHASES + p) * DG_NBUF * DG_MAXCH + i];
            if (!(fabsf(a.x - b.x) <= 1e-5f * a.y + 0.02f)) atomicAdd(flag + p, 1u);
        }
}
__global__ void dg_poison(const unsigned* flag, float* out) {
    if (threadIdx.x == 0 && blockIdx.x == 0) { for (int p = 0; p < N_PHASES; ++p) if (flag[p]) { out[0] += 1000.f * (float)(1 << p); break; } }
}
struct DgBuf { size_t off; int is_f32; size_t nelem; };
#endif
#ifdef STAGECHECK
constexpr size_t WS_CK = WS_END;
constexpr int CK_NS = 32;
constexpr size_t WS_CK_ROWS = WS_CK + 4096, WS_CK_TMP = WS_CK_ROWS + (size_t)CK_NS * 2048 * 4;
__device__ __forceinline__ unsigned ck_hash(unsigned a) { a ^= a >> 16; a *= 0x7feb352du; a ^= a >> 15; a *= 0x846ca68bu; a ^= a >> 16; return a; }
__device__ __forceinline__ bool ck_bad(float ref, float got) { return !(fabsf(ref - got) <= 0.03f * fabsf(ref) + 0.03f); }
__device__ __forceinline__ int ck_slot(int t) { const int c = t & 15; return (t & ~15) + (c < 4 ? c : c < 8 ? c + 4 : c < 12 ? c - 4 : c); }
__device__ __forceinline__ void ck_flag(unsigned* flags, int code, bool bad) { if (__any(bad)) { if ((threadIdx.x & 63) == 0) atomicAdd(flags + code, 1u); } }

__global__ void __launch_bounds__(64) ck_save_rows(const float* out, float* rows) {
    const int s = blockIdx.x, t = ck_hash(1000 + s) % T; for (int i = threadIdx.x; i < 2048; i += 64) rows[s * 2048 + i] = out[(size_t)t * 2048 + i];
}
__global__ void __launch_bounds__(64) ck_kernel(int stage, In I, unsigned char* ws, const float* out, unsigned* flags) {
    const int s = blockIdx.x, lane = threadIdx.x;
    __shared__ float sh[4096];
    const bf16* z0 = (const bf16*)(ws + WS_Z0); const float* ssq = (const float*)(ws + WS_SSQ);
    if (stage == 1) {
        const int t = ck_hash(s) % T, n = ck_hash(77 + s) % MLA_IN; float a = 0.f, d = 0.f;
        for (int k = lane; k < 2048; k += 64) { const float x = I.x[(size_t)t * 2048 + k]; a += x * x; d += x * I.g_mix[k] * I.mla_w_in[(size_t)k * MLA_IN + n]; }
        a = wave_sum(a); d = wave_sum(d); const float ref = d * rsqrtf(a / 2048.f + 1e-6f);
        ck_flag(flags, 1, ck_bad(ref, bf2f(z0[(size_t)t * MLA_INP + n])));
    } else if (stage == 2) {
        const int t = ck_hash(s) % T, n = ck_hash(78 + s) % 3072, h = ck_hash(79 + s) % 16, dd = ck_hash(80 + s) % 128; float a = 0.f, b = 0.f, c = 0.f, q = 0.f;
        for (int k = lane; k < 512; k += 64) { const float zq = bf2f(z0[(size_t)t * MLA_INP + k]), zk = bf2f(z0[(size_t)t * MLA_INP + 512 + k]);
            a += zq * I.mla_g_qa[k] * I.mla_w_qb[(size_t)k * 3072 + n]; b += zk * I.mla_g_kva[k] * I.mla_w_kvb[(size_t)k * 4096 + h * 256 + dd]; c += zk * I.mla_g_kva[k] * I.mla_w_kvb[(size_t)k * 4096 + h * 256 + 128 + dd]; q += zk * zk; }
        a = wave_sum(a); b = wave_sum(b); c = wave_sum(c); q = wave_sum(q); c *= rsqrtf(q / 512.f + 1e-6f);
        const bf16* Q = (const bf16*)(ws + WS_Q); const bf16* KN = (const bf16*)(ws + WS_KN); const bf16* VT = (const bf16*)(ws + WS_VT);
        ck_flag(flags, 2, ck_bad(a, bf2f(Q[(size_t)t * 3072 + n])));
        ck_flag(flags, 20, ck_bad(b, bf2f(KN[(size_t)t * 2048 + h * 128 + dd])));
        ck_flag(flags, 21, ck_bad(c, bf2f(VT[(size_t)(h * 128 + dd) * T + ck_slot(t)])));
    } else if (stage == 3) {
        const int t = ck_hash(s) % T, h = ck_hash(81 + s) % 16; float sq = 0.f, skv = 0.f;
        for (int k = lane; k < 512; k += 64) { const float zq = bf2f(z0[(size_t)t * MLA_INP + k]), zk = bf2f(z0[(size_t)t * MLA_INP + 512 + k]); sq += zq * zq; skv += zk * zk; }
        const float rcq = rsqrtf(wave_sum(sq) / 512.f + 1e-6f), rckv = rsqrtf(wave_sum(skv) / 512.f + 1e-6f);
        float qv[3], kv[3];
#pragma unroll
        for (int j = 0; j < 3; ++j) { const int d = lane + 64 * j; float a = 0.f, b = 0.f;
            for (int k = 0; k < 512; ++k) { a += bf2f(z0[(size_t)t * MLA_INP + k]) * I.mla_g_qa[k] * I.mla_w_qb[(size_t)k * 3072 + h * 192 + d];
                if (d < 128) b += bf2f(z0[(size_t)t * MLA_INP + 512 + k]) * I.mla_g_kva[k] * I.mla_w_kvb[(size_t)k * 4096 + h * 256 + d]; }
            qv[j] = a * rcq; kv[j] = (d < 128) ? b * rckv : bf2f(z0[(size_t)t * MLA_INP + 1024 + (d - 128)]); }
        const float rq = rsqrtf(wave_sum(qv[0] * qv[0] + qv[1] * qv[1] + qv[2] * qv[2]) / 192.f + 1e-6f), rk = rsqrtf(wave_sum(kv[0] * kv[0] + kv[1] * kv[1] + kv[2] * kv[2]) / 192.f + 1e-6f);
#pragma unroll
        for (int j = 0; j < 3; ++j) { qv[j] *= rq * I.mla_g_q[lane + 64 * j]; kv[j] *= rk * I.mla_g_k[lane + 64 * j]; }
        const float inv_freq = powf(10000.0f, -(float)(2 * (lane & 31)) / 64.0f), ang = (float)I.pos[t] * inv_freq, cs = cosf(ang), sn = sinf(ang);
        const float pq = __shfl_xor(qv[2], 32), pk = __shfl_xor(kv[2], 32);
        qv[2] = (lane < 32) ? qv[2] * cs - pq * sn : qv[2] * cs + pq * sn; kv[2] = (lane < 32) ? kv[2] * cs - pk * sn : kv[2] * cs + pk * sn;
        const float QS = 0.07216878364870322f * LOG2E; const bf16* Q = (const bf16*)(ws + WS_Q); const bf16* KM = (const bf16*)(ws + WS_KM); bool bad = false, badk = false;
#pragma unroll
        for (int j = 0; j < 3; ++j) { bad |= ck_bad(qv[j] * QS * 4.f, 4.f * bf2f(Q[(size_t)t * 3072 + h * 192 + lane + 64 * j])); badk |= ck_bad(kv[j], bf2f(KM[(size_t)t * 3072 + h * 192 + lane + 64 * j])); }
        ck_flag(flags, 3, bad); ck_flag(flags, 22, badk);
    } else if (stage == 4 || stage == 10) {
        const bool fox = stage == 10; const int t = ck_hash(s) % T, h = ck_hash(82 + s) % 16, b = t / SEQ, tq = t % SEQ, DKK = fox ? 128 : 192;
        const bf16* Q = fox ? (const bf16*)(ws + WS_Z) : (const bf16*)(ws + WS_Q); const bf16* K = fox ? (const bf16*)(ws + WS_Z) + 2048 : (const bf16*)(ws + WS_KM); const int pitch = fox ? FOX_ZN : 3072;
        const bf16* VT = (const bf16*)(ws + WS_VT); const float* lf = (const float*)(ws + WS_LF);
        const int nk = fox ? tq + 1 : 64 * (tq / 64 + 1);
        if (fox) { if (lane == 0) { float c = 0.f; for (int i = 0; i < nk; ++i) { c += lf[(size_t)(b * SEQ + i) * 16 + h]; sh[2048 + i] = c; } } __syncthreads(); }
        float mx = -1e30f;
        for (int sk = lane; sk < nk; sk += 64) { float d = 0.f; for (int e = 0; e < DKK; ++e) d += bf2f(Q[(size_t)t * pitch + h * DKK + e]) * bf2f(K[(size_t)(b * SEQ + sk) * pitch + h * DKK + e]);
            if (fox) d += (sh[2048 + tq] - sh[2048 + sk]) * LOG2E; sh[sk] = d; mx = fmaxf(mx, d); }
        for (int o = 1; o < 64; o <<= 1) mx = fmaxf(mx, __shfl_xor(mx, o));
        __syncthreads();
        float l = 0.f; for (int sk = lane; sk < nk; sk += 64) { const float p = exp2f(sh[sk] - mx); sh[sk] = p; l += p; } l = wave_sum(l);
        __syncthreads();
        bool bad = false;
        for (int j = 0; j < 2; ++j) { const int dv = lane + 64 * j; float o = 0.f; for (int sk = 0; sk < nk; ++sk) o += sh[sk] * bf2f(VT[(size_t)(h * 128 + dv) * T + ck_slot(b * SEQ + sk)]); o /= l;
            if (fox) o *= 1.f / (1.f + expf(-bf2f(((const bf16*)(ws + WS_Z))[(size_t)t * FOX_ZN + 4096 + h * 128 + dv])));
            bad |= ck_bad(o * 8.f, 8.f * bf2f(((const bf16*)(ws + WS_O))[(size_t)t * 2048 + h * 128 + dv])); }
        ck_flag(flags, stage, bad);
    } else if (stage == 5 || stage == 11) {
        const int t = (stage == 5) ? ck_hash(s) % T : ck_hash(1000 + s) % T, n = ck_hash(83 + s) % 2048; const float* wo = (stage == 5) ? I.mla_w_o : I.fox_w_o; float d = 0.f;
        for (int k = lane; k < 2048; k += 64) d += bf2f(((const bf16*)(ws + WS_O))[(size_t)t * 2048 + k]) * wo[(size_t)k * 2048 + n];
        d = wave_sum(d); const float xo = (stage == 5) ? I.x[(size_t)t * 2048 + n] : ((const float*)(ws + WS_CK_ROWS))[s * 2048 + n];
        ck_flag(flags, stage, ck_bad(xo + d, out[(size_t)t * 2048 + n]));
    } else if (stage == 6 || stage == 12) {
        const int L = stage == 12, t = ck_hash(s) % T, n = ck_hash(84 + s) % 2048; float d = 0.f;
        for (int k = lane; k < 2048; k += 64) d += bf2f(((const bf16*)(ws + WS_XB))[(size_t)t * 2048 + k]) * I.g_ffn[L * 2048 + k] * I.pe_wq[(size_t)L * 2048 * 2048 + (size_t)k * 2048 + n];
        d = wave_sum(d); ck_flag(flags, stage, ck_bad(d, bf2f(((const bf16*)(ws + WS_QP))[(size_t)t * 2048 + n])));
    } else if (stage == 7 || stage == 13) {
        const int L = stage == 13, t = ck_hash(1000 + s) % T; const float* xo = (const float*)(ws + WS_CK_ROWS) + s * 2048; float* tmp = (float*)(ws + WS_CK_TMP) + (size_t)s * 8192;
        float a = 0.f; for (int k = lane; k < 2048; k += 64) a += xo[k] * xo[k]; const float r = rsqrtf(wave_sum(a) / 2048.f + 1e-6f);
        for (int k = lane; k < 2048; k += 64) tmp[k] = xo[k] * r * I.g_ffn[L * 2048 + k];
        __syncthreads();
        for (int n = lane; n < 2048; n += 64) { float d = 0.f; for (int k = 0; k < 2048; ++k) d += tmp[k] * I.pe_wq[(size_t)L * 2048 * 2048 + (size_t)k * 2048 + n]; tmp[2048 + n] = d; }
        __syncthreads();
        for (int hq = 0; hq < 8; ++hq) {
            for (int c = 0; c < 2; ++c) for (int n = lane; n < 128; n += 64) { float d = 0.f; for (int e = 0; e < 128; ++e) d += tmp[2048 + hq * 256 + c * 128 + e] * I.pe_sk[((size_t)(L * 2 + c) * 128 + n) * 128 + e]; sh[c * 128 + n] = d; }
            __syncthreads();
            if (lane == 0) {
                for (int c = 0; c < 2; ++c) for (int k = 0; k < 16; ++k) { int bi = 0; float bv = -1e30f; for (int n = 0; n < 128; ++n) if (sh[c * 128 + n] > bv) { bv = sh[c * 128 + n]; bi = n; } sh[256 + c * 16 + k] = bv; sh[288 + c * 16 + k] = (float)bi; sh[c * 128 + bi] = -1e30f; }
                for (int i = 0; i < 16; ++i) for (int j = 0; j < 16; ++j) sh[512 + i * 16 + j] = sh[256 + i] + sh[272 + j];
                float b0 = 0.f, sum = 0.f;
                for (int k = 0; k < 16; ++k) { int bi = 0; float bv = -1e30f; for (int n = 0; n < 256; ++n) if (sh[512 + n] > bv) { bv = sh[512 + n]; bi = n; } if (k == 0) b0 = bv;
                    const float w = expf(bv - b0); sum += w; tmp[4096 + hq * 32 + k] = sh[288 + (bi >> 4)] * 128.f + sh[304 + (bi & 15)]; tmp[4096 + hq * 32 + 16 + k] = w; sh[512 + bi] = -1e30f; }
                for (int k = 0; k < 16; ++k) tmp[4096 + hq * 32 + 16 + k] /= sum;
            }
            __syncthreads();
        }
        for (int k = 0; k < 128; ++k) { const int e = (int)tmp[4096 + (k >> 4) * 32 + (k & 15)]; float d = 0.f; for (int i = lane; i < 2048; i += 64) d += I.pe_u[((size_t)L * PE_NE + e) * 2048 + i] * tmp[i]; d = wave_sum(d);
            if (lane == 0) tmp[6144 + k] = 0.5f * d * (1.f + erff(d * 0.7071067811865476f)) * tmp[4096 + (k >> 4) * 32 + 16 + (k & 15)]; }
        __syncthreads();
        { const int* di = (const int*)(ws + WS_END + 8 * MiB) + (size_t)t * 128; const float* dg = (const float*)(ws + WS_END + 12 * MiB) + (size_t)t * 128; const float* da = (const float*)(ws + WS_END + 16 * MiB) + (size_t)t * 128;
          int nf = 0; bool bg = false, ba = false;
          for (int k = lane; k < 128; k += 64) { const int e = (int)tmp[4096 + (k >> 4) * 32 + (k & 15)]; int f = -1; for (int m = 0; m < 16; ++m) if (di[(k & ~15) + m] == e) f = (k & ~15) + m;
              if (f < 0) ++nf; else { bg |= !(fabsf(dg[f] - tmp[4096 + (k >> 4) * 32 + 16 + (k & 15)]) <= 0.05f * dg[f] + 0.003f); ba |= !(fabsf(da[f] - tmp[6144 + k]) <= 0.05f * fabsf(da[f]) + 0.004f); } }
          nf = (int)wave_sum((float)nf);
          ck_flag(flags, 23, nf > 8); ck_flag(flags, 24, bg); ck_flag(flags, 25, ba); }
        bool bad = false;
        for (int j = 0; j < 4; ++j) { const int d = (lane * 4 + j * 256 + (int)(ck_hash(s) & 3)) & 2047; float o = 0.f; { const int* di = (const int*)(ws + WS_END + 8 * MiB) + (size_t)t * 128; const float* da = (const float*)(ws + WS_END + 16 * MiB) + (size_t)t * 128; for (int k = 0; k < 128; ++k) o += da[k] * I.pe_v[((size_t)L * PE_NE + di[k]) * 2048 + d]; }
            bad |= ck_bad((xo[d] + o), out[(size_t)t * 2048 + d]); }
        ck_flag(flags, stage, bad);
    } else if (stage == 9) {
        const int t = ck_hash(s) % T, h = ck_hash(86 + s) % 16; const float r2 = rsqrtf(ssq[SSQ_X2 + t] / 2048.f + 1e-6f); float qv[2], kv[2];
#pragma unroll
        for (int j = 0; j < 2; ++j) { const int d = lane + 64 * j; float a = 0.f, b = 0.f;
            for (int k = 0; k < 2048; ++k) { const float xv = bf2f(((const bf16*)(ws + WS_XB))[(size_t)t * 2048 + k]) * I.g_mix[2048 + k]; a += xv * I.fox_w_in[(size_t)k * 8208 + h * 128 + d]; b += xv * I.fox_w_in[(size_t)k * 8208 + 2048 + h * 128 + d]; }
            qv[j] = a * r2; kv[j] = b * r2; }
        const float rq = rsqrtf(wave_sum(qv[0] * qv[0] + qv[1] * qv[1]) / 128.f + 1e-6f) * 0.08838834764831845f * LOG2E, rk = rsqrtf(wave_sum(kv[0] * kv[0] + kv[1] * kv[1]) / 128.f + 1e-6f);
        bool bad = false;
#pragma unroll
        for (int j = 0; j < 2; ++j) { const int d = lane + 64 * j; bad |= ck_bad(4.f * qv[j] * rq * I.fox_g_q[d], 4.f * bf2f(((const bf16*)(ws + WS_Z))[(size_t)t * FOX_ZN + h * 128 + d]));
            bad |= ck_bad(kv[j] * rk * I.fox_g_k[d], bf2f(((const bf16*)(ws + WS_Z))[(size_t)t * FOX_ZN + 2048 + h * 128 + d])); }
        ck_flag(flags, 9, bad);
    } else if (stage == 8) {
        const int t = ck_hash(s) % T, n = ck_hash(85 + s) % 8192; float d = 0.f;
        for (int k = lane; k < 2048; k += 64) d += bf2f(((const bf16*)(ws + WS_XB))[(size_t)t * 2048 + k]) * I.g_mix[2048 + k] * I.fox_w_in[(size_t)k * 8208 + n];
        d = wave_sum(d) * rsqrtf(ssq[SSQ_X2 + t] / 2048.f + 1e-6f);
        const int sec = n >> 11, c = n & 2047; float got;
        if (sec == 2) got = bf2f(((const bf16*)(ws + WS_VT))[(size_t)c * T + ck_slot(t)]); else got = bf2f(((const bf16*)(ws + WS_Z))[(size_t)t * FOX_ZN + (sec == 3 ? 4096 : sec * 2048) + c]);
        ck_flag(flags, 8, ck_bad(d, got));
    }
}
__global__ void ck_poison(const unsigned* flags, float* out) {
    if (threadIdx.x == 0 && blockIdx.x == 0) { const int order[19] = {1, 2, 20, 21, 3, 22, 4, 5, 6, 23, 24, 25, 7, 8, 9, 10, 11, 12, 13};
        for (int i = 0; i < 19; ++i) if (flags[order[i]]) { out[0] += 1000.f * (float)(1 << (i + 1)); break; } }
}
#endif
#ifndef MK_N_LAUNCHES
#define MK_N_LAUNCHES 1
#endif
struct Args { const void* in[21]; float* out; unsigned char* ws; int ph_lo, ph_hi, rep, pad; };
static_assert(sizeof(Args) == 21 * 8 + 8 + 8 + 16, "Args has no padding");

__global__ void __launch_bounds__(NWAVES * 64, 2) mk_fwd(Args args) {
    extern __shared__ __attribute__((aligned(16))) unsigned char lds_raw[];
    Frame F;
    F.lds = (LAS unsigned char*)lds_raw;
    volatile LAS unsigned* MISC = (volatile LAS unsigned*)(F.lds + MISC_OFF);
    F.tid = threadIdx.x; F.lane = F.tid & 63; F.wave = __builtin_amdgcn_readfirstlane(F.tid >> 6);
    F.G = gridDim.x; { const int bx = blockIdx.x; F.vcu = (F.G % 8 == 0) ? (bx % 8) * (F.G / 8) + bx / 8 : bx; }
    F.ws = args.ws; F.out = args.out;
    In I;
    I.x = (const float*)args.in[0]; I.pos = (const int*)args.in[1]; I.g_mix = (const float*)args.in[2]; I.g_ffn = (const float*)args.in[3];
    I.mla_w_in = (const float*)args.in[4]; I.mla_g_qa = (const float*)args.in[5]; I.mla_w_qb = (const float*)args.in[6]; I.mla_g_kva = (const float*)args.in[7];
    I.mla_w_kvb = (const float*)args.in[8]; I.mla_g_q = (const float*)args.in[9]; I.mla_g_k = (const float*)args.in[10]; I.mla_w_o = (const float*)args.in[11];
    I.fox_w_in = (const float*)args.in[12]; I.fox_b_f = (const float*)args.in[13]; I.fox_g_q = (const float*)args.in[14]; I.fox_g_k = (const float*)args.in[15];
    I.fox_w_o = (const float*)args.in[16]; I.pe_wq = (const float*)args.in[17]; I.pe_sk = (const float*)args.in[18]; I.pe_u = (const float*)args.in[19]; I.pe_v = (const float*)args.in[20];
    for (int u = F.tid; u < (LDS_BYTES - LDSCTL_OFF) / 4; u += NWAVES * 64) ((LAS unsigned*)(F.lds + LDSCTL_OFF))[u] = 0u;
    __syncthreads();
    unsigned* ctl = (unsigned*)(F.ws + WS_CTL);
    XcdBarrier bar; bar.bar = ctl + CW_BAR; bar.x = 0; bar.st = nullptr;
    const int lo = args.ph_lo, hi = args.ph_hi;
    if (hi - lo > 1) bar = xcd_barrier_post(ctl + CW_BAR, MISC + 8);
#ifndef PH_MASK
#define PH_MASK 0x3fff
#endif
#define IN(k) (((PH_MASK >> (k)) & 1) && lo <= (k) && (k) < hi)
#define SEAM(k) do { if (IN(k) && IN((k) + 1)) xcd_barrier(bar); } while (0)
#ifdef TIMING_PROBE
#define REPS(k) ((TIMING_PROBE >> (k)) & 1)
#else
#define REPS(k) 0
#endif
    unsigned char* ws = F.ws;
    float* ssq = (float*)(ws + WS_SSQ);
    const int bid = (int)blockIdx.x;

    if (IN(0)) { for (int rp = REPS(0); rp >= 0; --rp) { p_prologue(F, I); if (rp) xcd_barrier(bar); } SEAM(0); }

    if (IN(1)) { for (int rp = REPS(1); rp >= 0; --rp) {
        pg8::Gemm g{(const bf16*)(ws + WS_XB), (const bf16*)(ws + WS_WT_MLA_IN), T, MLA_INP, D, D, D}; pg8::StaticOrder S; S.init(T, MLA_INP, F.G, bid);
        pg8::EpiRowScale E{(bf16*)(ws + WS_Z0), MLA_INP, ssq + SSQ_X0, 1, 1.f / 2048.f, ssq + SSQ_CQ, ssq + SSQ_CKV, 2, 4, 8};
        pg8::gemm_phase<pg8::EpiRowScale, pg8::StaticOrder, false>(F.lds + RING_OFF, g, S, E);
        if (bid >= 160) p_table_fill(F, I, 16384, 16384, (bid - 160) * NWAVES + F.wave, 96 * NWAVES);
        if (rp) xcd_barrier(bar); }
        SEAM(1);
    }
    if (IN(2)) { for (int rp = REPS(2); rp >= 0; --rp) {
        p_mla_tok(F, I);
        { pg8::Gemm g{(const bf16*)(ws + WS_Z0), (const bf16*)(ws + WS_WT_QB), T, MLA_QN, 512, MLA_INP, 512}; pg8::StaticOrder S; S.init(T, MLA_QN, F.G, bid);
          pg8::EpiRowScale E{(bf16*)(ws + WS_Q), MLA_QN, nullptr, 0, 0.f, nullptr, nullptr, 0, 0, 0};
          pg8::gemm_phase<pg8::EpiRowScale, pg8::StaticOrder, true>(F.lds + RING_OFF, g, S, E);
          if (bid >= 128) p_table_fill(F, I, 49152, PE_FILL2, (bid - 128) * NWAVES + F.wave, 128 * NWAVES); }
        { pg8::Gemm g{(const bf16*)(ws + WS_Z0) + 512, (const bf16*)(ws + WS_WT_KVB), T, 2048, 512, MLA_INP, 512}; pg8::StaticOrder S; S.init(T, 2048, F.G, bid);
          pg8::EpiRowScale E{(bf16*)(ws + WS_KN), 2048, nullptr, 0, 0.f, nullptr, nullptr, 0, 0, 0, (float*)(ws + WS_KSQM), 0, 8};
          pg8::gemm_phase<pg8::EpiRowScale, pg8::StaticOrder, true>(F.lds + RING_OFF, g, S, E); }
        { pg8::Gemm g{(const bf16*)(ws + WS_WT_KVB) + (size_t)2048 * 512, (const bf16*)(ws + WS_Z0) + 512, 2048, T, 512, 512, MLA_INP}; pg8::StaticOrder S; S.init(2048, T, F.G, bid);
          pg8::EpiColScale E{(bf16*)(ws + WS_VT), T, ssq + SSQ_CKV, 8, 1.f / 512.f};
          pg8::gemm_phase<pg8::EpiColScale, pg8::StaticOrder, true>(F.lds + RING_OFF, g, S, E); }
        if (rp) xcd_barrier(bar); }
        SEAM(2);
    }
    if (IN(4)) { for (int rp = REPS(4); rp >= 0; --rp) {
        const AttnAux ax{I.mla_g_q, I.mla_g_k, (const float*)(ws + WS_KSQM), ssq + SSQ_CQ, (const float*)(ws + WS_ROPE), (const float*)(ws + WS_RCKV), (const float*)(ws + WS_KRSS), (const bf16*)(ws + WS_KRG)};
        p_attention<192, false>(F, (const bf16*)(ws + WS_Q), MLA_QN, (const bf16*)(ws + WS_KN), 2048, (const bf16*)(ws + WS_VT), (bf16*)(ws + WS_O), nullptr, 0, nullptr, ax);
        if (rp) xcd_barrier(bar); }
        SEAM(4);
    }
    if (IN(5)) { for (int rp = REPS(5); rp >= 0; --rp) {
        pg8::Gemm g{(const bf16*)(ws + WS_O), (const bf16*)(ws + WS_WT_MLA_O), T, D, D, D, D}; pg8::StaticOrder S; S.init(T, D, F.G, bid);
        pg8::EpiResidual E{I.x, F.out, (bf16*)(ws + WS_XB), D, ssq + SSQ_XS};
        pg8::gemm_phase<pg8::EpiResidual, pg8::StaticOrder, false>(F.lds + RING_OFF, g, S, E);
        if (rp) xcd_barrier(bar); }
        SEAM(5);
    }
    if (IN(6)) { for (int rp = REPS(6); rp >= 0; --rp) {
        pg8::Gemm g{(const bf16*)(ws + WS_XB), (const bf16*)(ws + WS_WT_PQ), T, D, D, D, D}; pg8::StaticOrder S; S.init(T, D, F.G, bid);
        pg8::EpiRowScale E{(bf16*)(ws + WS_QP), D, nullptr, 0, 0.f, nullptr, nullptr, 0, 0, 0};
        pg8::gemm_phase<pg8::EpiRowScale, pg8::StaticOrder, false>(F.lds + RING_OFF, g, S, E);
        if (rp) xcd_barrier(bar); }
        SEAM(6);
    }
    if (IN(7)) { for (int rp = REPS(7); rp >= 0; --rp) { p_peer<0>(F, I, rp); if (rp) xcd_barrier(bar); } SEAM(7); }
    if (IN(8)) { for (int rp = REPS(8); rp >= 0; --rp) {
        { pg8::Gemm g{(const bf16*)(ws + WS_XB), (const bf16*)(ws + WS_WT_FOX_IN), T, FOX_ZN, D, D, D}; pg8::StaticOrder S; S.init(T, FOX_ZN, F.G, bid);
          pg8::EpiRowScale E{(bf16*)(ws + WS_Z), FOX_ZN, ssq + SSQ_X2, 1, 1.f / 2048.f, nullptr, nullptr, 0, 0, 0, (float*)(ws + WS_KSQ), 8, 16};
          pg8::gemm_phase<pg8::EpiRowScale, pg8::StaticOrder, true>(F.lds + RING_OFF, g, S, E); }
        { pg8::Gemm g{(const bf16*)(ws + WS_WT_FOX_IN) + (size_t)FOX_ZN * D, (const bf16*)(ws + WS_XB), 2048, T, D, D, D}; pg8::StaticOrder S; S.init(2048, T, F.G, bid);
          pg8::EpiColScale E{(bf16*)(ws + WS_VT), T, ssq + SSQ_X2, 1, 1.f / 2048.f};
          pg8::gemm_phase<pg8::EpiColScale, pg8::StaticOrder, true>(F.lds + RING_OFF, g, S, E); }
        if (rp) xcd_barrier(bar); }
        SEAM(8);
    }
    if (IN(10)) { for (int rp = REPS(10); rp >= 0; --rp) {
        p_attention<128, true>(F, (const bf16*)(ws + WS_Z), FOX_ZN, (const bf16*)(ws + WS_Z) + 2048, FOX_ZN, (const bf16*)(ws + WS_VT), (bf16*)(ws + WS_O), (const bf16*)(ws + WS_Z) + 4096, FOX_ZN, (const float*)(ws + WS_LF), AttnAux{I.fox_g_q, I.fox_g_k, (const float*)(ws + WS_KSQ), nullptr, nullptr, nullptr, nullptr, nullptr});
        if (rp) xcd_barrier(bar); }
        SEAM(10);
    }
    if (IN(11)) {
        pg8::Gemm g{(const bf16*)(ws + WS_O), (const bf16*)(ws + WS_WT_FOX_O), T, D, D, D, D}; pg8::StaticOrder S; S.init(T, D, F.G, bid);
        pg8::EpiResidual E{F.out, F.out, (bf16*)(ws + WS_XB), D, ssq + SSQ_XS};
        pg8::gemm_phase<pg8::EpiResidual, pg8::StaticOrder, false>(F.lds + RING_OFF, g, S, E);
        SEAM(11);
    }
    if (IN(12)) { for (int rp = REPS(12); rp >= 0; --rp) {
        pg8::Gemm g{(const bf16*)(ws + WS_XB), (const bf16*)(ws + WS_WT_PQ + 8 * MiB), T, D, D, D, D}; pg8::StaticOrder S; S.init(T, D, F.G, bid);
        pg8::EpiRowScale E{(bf16*)(ws + WS_QP), D, nullptr, 0, 0.f, nullptr, nullptr, 0, 0, 0};
        pg8::gemm_phase<pg8::EpiRowScale, pg8::StaticOrder, false>(F.lds + RING_OFF, g, S, E);
        if (rp) xcd_barrier(bar); }
        SEAM(12);
    }
    if (IN(13)) { for (int rp = REPS(13); rp >= 0; --rp) { p_peer<1>(F, I, rp); if (rp) xcd_barrier(bar); } }
#ifdef PROF
    if (hi - lo > 1) { xcd_barrier(bar); if (blockIdx.x == 0 && F.tid == 0) { float v = __uint_as_float(__hip_atomic_load(ctl + 70, __ATOMIC_RELAXED, __HIP_MEMORY_SCOPE_AGENT)); v = fminf(fmaxf(v, 0.f), 1.5f); v = rintf(v * 12.f) * (1.f / 12.f); F.out[0] += 1000.f * __builtin_exp10f(v);        } }
#endif
#ifdef BARRIER_PROBE
    if (hi - lo > 1) { for (int i = 0; i < 8; ++i) xcd_barrier(bar); }
#endif
#ifdef FP6_SELFTEST
    if (hi - lo > 1) { xcd_barrier(bar); if (blockIdx.x == 0 && F.tid == 0 && __hip_atomic_load(ctl + 64, __ATOMIC_RELAXED, __HIP_MEMORY_SCOPE_AGENT)) F.out[0] += 1.0e6f; }
#endif
#undef IN
#undef SEAM
}

extern "C" void kernel_launch(void* const* d_in, const int* in_sizes, int n_in, void* d_out, int out_size, void* d_ws, size_t ws_size, hipStream_t stream) {
    static int grid = 0;
    if (grid == 0) {
        if (n_in != 21 || out_size != T * D || ws_size < WS_END) { fprintf(stderr, "kernel_launch: unexpected shapes (n_in %d out %d ws %zu need %zu)\n", n_in, out_size, ws_size, (size_t)WS_END); grid = -1; return; }
        int dev = 0, cus = 0, per_cu = 0;
        if (hipGetDevice(&dev) != hipSuccess || hipDeviceGetAttribute(&cus, hipDeviceAttributeMultiprocessorCount, dev) != hipSuccess) { grid = -1; return; }
        if (hipFuncSetAttribute((const void*)mk_fwd, hipFuncAttributeMaxDynamicSharedMemorySize, LDS_BYTES) != hipSuccess) { fprintf(stderr, "kernel_launch: hipFuncSetAttribute failed\n"); grid = -1; return; }
        if (hipOccupancyMaxActiveBlocksPerMultiprocessor(&per_cu, (const void*)mk_fwd, NWAVES * 64, LDS_BYTES) != hipSuccess || per_cu < 1) { fprintf(stderr, "kernel_launch: occupancy query says %d\n", per_cu); }
        (void)hipGetLastError();
        grid = cus;
    }
    if (grid < 0) return;
    (void)hipMemsetAsync((char*)d_ws + WS_CTL, 0, CTL_ZERO_BYTES, stream);
    Args a{};
    for (int i = 0; i < 21; ++i) a.in[i] = d_in[i];
    a.out = (float*)d_out; a.ws = (unsigned char*)d_ws;
#ifdef TIMING_PROBE
    a.rep = TIMING_PROBE;
#endif
#ifdef STAGECHECK
    {
        unsigned char* ws = (unsigned char*)d_ws; unsigned* flags = (unsigned*)(ws + WS_CK); float* rows = (float*)(ws + WS_CK_ROWS);
        (void)hipMemsetAsync(ws + WS_CK, 0, 4096, stream);
        In I; { const void* const* in = a.in; I.x = (const float*)in[0]; I.pos = (const int*)in[1]; I.g_mix = (const float*)in[2]; I.g_ffn = (const float*)in[3]; I.mla_w_in = (const float*)in[4]; I.mla_g_qa = (const float*)in[5];
            I.mla_w_qb = (const float*)in[6]; I.mla_g_kva = (const float*)in[7]; I.mla_w_kvb = (const float*)in[8]; I.mla_g_q = (const float*)in[9]; I.mla_g_k = (const float*)in[10]; I.mla_w_o = (const float*)in[11];
            I.fox_w_in = (const float*)in[12]; I.fox_b_f = (const float*)in[13]; I.fox_g_q = (const float*)in[14]; I.fox_g_k = (const float*)in[15]; I.fox_w_o = (const float*)in[16]; I.pe_wq = (const float*)in[17];
            I.pe_sk = (const float*)in[18]; I.pe_u = (const float*)in[19]; I.pe_v = (const float*)in[20]; }
        for (int p = 0; p < N_PHASES; ++p) {
            if (p == 7 || p == 11 || p == 13) hipLaunchKernelGGL(ck_save_rows, dim3(CK_NS), dim3(64), 0, stream, (const float*)d_out, rows);
            a.ph_lo = p; a.ph_hi = p + 1; hipLaunchKernelGGL(mk_fwd, dim3(grid), dim3(NWAVES * 64), LDS_BYTES, stream, a);
            if (p >= 1) hipLaunchKernelGGL(ck_kernel, dim3(CK_NS), dim3(64), 0, stream, p, I, ws, (const float*)d_out, flags);
        }
        hipLaunchKernelGGL(ck_poison, dim3(1), dim3(64), 0, stream, (const unsigned*)flags, (float*)d_out);
    }
#elif defined(SELFCHECK)
    {
        unsigned char* ws = (unsigned char*)d_ws;
        (void)hipMemsetAsync(ws + WS_DG, 0, DG_BYTES, stream);
        unsigned* flag = (unsigned*)(ws + 64 * 1024);
        const size_t OUTB = (size_t)-1;
        const DgBuf bufs[N_PHASES][DG_NBUF] = {
            {{WS_XB, 0, (size_t)T * D}, {WS_WT_MLA_IN, 0, (size_t)40 * 1024 * 1024}, {WS_PU, 0, (size_t)64 * 1024 * 1024}},
            {{WS_Z0, 0, (size_t)T * MLA_INP}, {0, 0, 0}, {0, 0, 0}},
            {{WS_Q, 0, (size_t)T * MLA_QN}, {WS_KN, 0, (size_t)T * 2048}, {WS_VT, 0, (size_t)T * 2048}},
            {{WS_Q, 0, (size_t)T * MLA_QN}, {WS_KM, 0, (size_t)T * MLA_QN}, {0, 0, 0}},
            {{WS_O, 0, (size_t)T * D}, {0, 0, 0}, {0, 0, 0}},
            {{OUTB, 1, (size_t)T * D}, {WS_XB, 0, (size_t)T * D}, {0, 0, 0}},
            {{WS_QP, 0, (size_t)T * D}, {0, 0, 0}, {0, 0, 0}},
            {{OUTB, 1, (size_t)T * D}, {WS_XB, 0, (size_t)T * D}, {WS_LF, 1, (size_t)T * 16}},
            {{WS_Z, 0, (size_t)T * FOX_ZN}, {WS_VT, 0, (size_t)T * 2048}, {0, 0, 0}},
            {{WS_Z, 0, (size_t)T * FOX_ZN}, {0, 0, 0}, {0, 0, 0}},
            {{WS_O, 0, (size_t)T * D}, {0, 0, 0}, {0, 0, 0}},
            {{OUTB, 1, (size_t)T * D}, {WS_XB, 0, (size_t)T * D}, {0, 0, 0}},
            {{WS_QP, 0, (size_t)T * D}, {0, 0, 0}, {0, 0, 0}},
            {{OUTB, 1, (size_t)T * D}, {0, 0, 0}, {0, 0, 0}}};
        for (int pass = 0; pass < DG_NPASS; ++pass) {
            for (int p = 0; p < N_PHASES; ++p) {
                a.ph_lo = p; a.ph_hi = p + 1; hipLaunchKernelGGL(mk_fwd, dim3(grid), dim3(NWAVES * 64), LDS_BYTES, stream, a);
                for (int b = 0; b < DG_NBUF; ++b) { const DgBuf& B = bufs[p][b]; if (!B.nelem) continue;
                    size_t ne = B.nelem; if (ne > (size_t)DG_MAXCH * DG_CHUNK) ne = (size_t)DG_MAXCH * DG_CHUNK;
                    const void* ptr = (B.off == OUTB) ? (const void*)d_out : (const void*)(ws + B.off);
                    float2* dig = (float2*)(ws + WS_DG) + (((size_t)pass * N_PHASES + p) * DG_NBUF + b) * DG_MAXCH;
                    hipLaunchKernelGGL(dg_kernel, dim3((unsigned)((ne + DG_CHUNK - 1) / DG_CHUNK)), dim3(256), 0, stream, ptr, B.is_f32, ne, dig); }
            }
        }
        hipLaunchKernelGGL(dg_compare, dim3(N_PHASES), dim3(256), 0, stream, (const float2*)(ws + WS_DG), flag);
        hipLaunchKernelGGL(dg_poison, dim3(1), dim3(64), 0, stream, (const unsigned*)flag, (float*)d_out);
    }
#elif MK_N_LAUNCHES == 1
    a.ph_lo = 0; a.ph_hi = N_PHASES;
    hipLaunchKernelGGL(mk_fwd, dim3(grid), dim3(NWAVES * 64), LDS_BYTES, stream, a);
#else
    for (int p = 0; p < N_PHASES; ++p) { a.ph_lo = p; a.ph_hi = p + 1; hipLaunchKernelGGL(mk_fwd, dim3(grid), dim3(NWAVES * 64), LDS_BYTES, stream, a); }
#endif
}
```

```cpp
#include <hip/hip_runtime.h>
#include <cstdio>
#include <cstdint>
namespace pg8 {
#define PG8_LAS __attribute__((address_space(3)))
typedef unsigned short bf16_t;
typedef short bf16x8 __attribute__((ext_vector_type(8)));
typedef float f32x4 __attribute__((ext_vector_type(4)));
typedef unsigned u32x4 __attribute__((ext_vector_type(4)));
typedef unsigned u32x2 __attribute__((ext_vector_type(2)));
constexpr int BM = 256, BK = 64, HALF = 128, HTB = HALF * BK * 2  , STAGE_BYTES = 8 * HTB, NXCD = 8, WGM = 8;

__host__ __device__ __forceinline__ int lds_byte(int r, int c) { const int st = (r >> 4) * 2 + (c >> 5), rr = r & 15, cc = c & 31, ob = rr * 64 + cc * 2; return st * 1024 + (ob ^ (((ob >> 9) & 1) << 5)); }
__host__ __device__ __forceinline__ void stage_rc(int b, int& R, int& C) { const int st = b / 1024, sb = b % 1024, swz = sb ^ (((sb >> 9) & 1) << 5); R = (st >> 1) * 16 + swz / 64; C = (st & 1) * 32 + (swz % 64) / 2; }
__host__ __device__ __forceinline__ int perm32(int rho) { const int n = rho >> 4, i = rho & 15; return 8 * (i >> 2) + 4 * n + (i & 3); }

struct Unit { int pm, pn; };
struct Gemm { const bf16_t* A; const bf16_t* Bt; int M, N, K, lda, ldb; };

struct StaticOrder {
    int nM, nN, nwg, G, c;
    __host__ __device__ void init(int M, int N, int G_, int c_) { nM = M / BM; nN = N / BM; nwg = nM * nN; G = G_; c = c_; }
    __host__ __device__ bool next(int i, Unit& u) const {
        const long L = (long)i * G + c; if (L >= nwg) return false;
        int wgid = (int)L; { const int q = nwg / NXCD, r = nwg % NXCD, xcd = wgid % NXCD, off = wgid / NXCD; wgid = (xcd < r ? xcd * (q + 1) : r * (q + 1) + (xcd - r) * q) + off; }
        const int nig = WGM * nN, gid = wgid / nig, fm = gid * WGM, gsz = (nM - fm) < WGM ? (nM - fm) : WGM;
        u.pm = fm + ((wgid % nig) % gsz); u.pn = (wgid % nig) / gsz; return true;
    }
    __device__ __forceinline__ void a_ready(const Unit&) const {}
    __device__ __forceinline__ void done(const Unit&) const {}
};

__device__ __forceinline__ unsigned cvt_pk_bf16(float lo, float hi) { unsigned r; asm volatile("v_cvt_pk_bf16_f32 %0, %1, %2" : "=v"(r) : "v"(lo), "v"(hi)); return r; }

constexpr float RMS_EPS = 1e-6f;

__device__ __forceinline__ float slot_sum(const float* p, int ns) { float s = 0.f; for (int i = 0; i < ns; ++i) s += p[i]; return s; }
struct EpiRowScale {
    static constexpr bool PERM = true, AFTER_DRAIN = false, HAS_INIT = false;
    bf16_t* O; int ldc; const float* ssq_in; int ns_in; float inv_k; float* ssq_out0; float* ssq_out1; int t0, t1, ns_out;
    float* ksq = nullptr; int kt0 = 0, kt1 = 0;
    __device__ __forceinline__ void operator()(const f32x4 (&acc)[2][2][4][2], const Unit& u, int wr, int wc, int fr, int fq) const {
        const int row0 = u.pm * BM + wr * 64 + fr, col0 = u.pn * BM + wc * 32 + 8 * fq;
        float* sdst = (u.pn < t0) ? ssq_out0 + u.pn * 4 + wc : ((u.pn < t1) ? ssq_out1 + (u.pn - t0) * 4 + wc : nullptr);
#pragma unroll
        for (int ai = 0; ai < 2; ++ai)
#pragma unroll
            for (int m = 0; m < 4; ++m) {
                const int row = row0 + ai * HALF + m * 16;
                const float rs = ssq_in ? __builtin_amdgcn_rsqf(slot_sum(ssq_in + (size_t)row * ns_in, ns_in) * inv_k + RMS_EPS) : 1.f;
                bf16_t* rowp = O + (size_t)row * ldc + col0; float sq = 0.f, sqh[2];
#pragma unroll
                for (int bj = 0; bj < 2; ++bj) { const f32x4 v0 = acc[ai][bj][m][0] * rs, v1 = acc[ai][bj][m][1] * rs;
                    sqh[bj] = (v0[0] * v0[0] + v0[1] * v0[1]) + (v0[2] * v0[2] + v0[3] * v0[3]) + (v1[0] * v1[0] + v1[1] * v1[1]) + (v1[2] * v1[2] + v1[3] * v1[3]); sq += sqh[bj];
                    u32x4 w; w.x = cvt_pk_bf16(v0[0], v0[1]); w.y = cvt_pk_bf16(v0[2], v0[3]); w.z = cvt_pk_bf16(v1[0], v1[1]); w.w = cvt_pk_bf16(v1[2], v1[3]);
                    *(u32x4*)(rowp + bj * HALF) = w; }
                if (sdst) { sq += __shfl_xor(sq, 16); sq += __shfl_xor(sq, 32); if (fq == 0) sdst[(size_t)row * ns_out] = sq; }
                if (ksq && u.pn >= kt0 && u.pn < kt1) {
#pragma unroll
                    for (int bj = 0; bj < 2; ++bj) { float q = sqh[bj]; q += __shfl_xor(q, 16); q += __shfl_xor(q, 32); if (fq == 0) ksq[((size_t)(2 * (u.pn - kt0) + bj) * 8192 + row) * 4 + wc] = q; } }
            }
    }
};
struct EpiColScale {
    static constexpr bool PERM = true, AFTER_DRAIN = false, HAS_INIT = false;
    bf16_t* O; int ldc; const float* ssq_in; int ns_in; float inv_k;
    __device__ __forceinline__ void operator()(const f32x4 (&acc)[2][2][4][2], const Unit& u, int wr, int wc, int fr, int fq) const {
        const int row0 = u.pm * BM + wr * 64 + fr, col0 = u.pn * BM + wc * 32 + 8 * fq;
        f32x4 cs[2][2];
#pragma unroll
        for (int bj = 0; bj < 2; ++bj)
#pragma unroll
            for (int n = 0; n < 2; ++n) { const float* sp = ssq_in + (size_t)(col0 + bj * HALF + 4 * n) * ns_in; const f32x4 s = (f32x4){slot_sum(sp, ns_in), slot_sum(sp + ns_in, ns_in), slot_sum(sp + 2 * ns_in, ns_in), slot_sum(sp + 3 * ns_in, ns_in)};
                cs[bj][n] = (f32x4){__builtin_amdgcn_rsqf(s[0] * inv_k + RMS_EPS), __builtin_amdgcn_rsqf(s[1] * inv_k + RMS_EPS), __builtin_amdgcn_rsqf(s[2] * inv_k + RMS_EPS), __builtin_amdgcn_rsqf(s[3] * inv_k + RMS_EPS)}; }
#pragma unroll
        for (int ai = 0; ai < 2; ++ai)
#pragma unroll
            for (int m = 0; m < 4; ++m) { bf16_t* rowp = O + (size_t)(row0 + ai * HALF + m * 16) * ldc + col0;
#pragma unroll
                for (int bj = 0; bj < 2; ++bj) { const f32x4 v0 = acc[ai][bj][m][0] * cs[bj][0], v1 = acc[ai][bj][m][1] * cs[bj][1];
                    u32x2 w0, w1; w0.x = cvt_pk_bf16(v0[0], v0[1]); w0.y = cvt_pk_bf16(v0[2], v0[3]); w1.x = cvt_pk_bf16(v1[0], v1[1]); w1.y = cvt_pk_bf16(v1[2], v1[3]);
                    bf16_t* gp = rowp + bj * HALF - 8 * (fq & 1);
                    { const auto t0 = __builtin_amdgcn_permlane16_swap(w0.x, w1.x, false, false); const auto t1 = __builtin_amdgcn_permlane16_swap(w0.y, w1.y, false, false);
                      u32x4 w; w.x = t0[0]; w.y = t1[0]; w.z = t0[1]; w.w = t1[1];
                      *(u32x4*)(gp + ((fq & 1) ? 8 : 0)) = w; } } }
    }
};
struct EpiResidual {
    static constexpr bool PERM = false, AFTER_DRAIN = false, HAS_INIT = true;
    const float* xold; float* out; bf16_t* xb; int ldc; float* ssq_out;
    __device__ __forceinline__ void init(f32x4 (&acc)[2][2][4][2], const Unit& u, int wr, int wc, int fr, int fq) const {
        const int row0 = u.pm * BM + wr * 64 + fr, col0 = u.pn * BM + wc * 32 + 4 * fq;
#pragma unroll
        for (int ai = 0; ai < 2; ++ai)
#pragma unroll
            for (int m = 0; m < 4; ++m) { const size_t ro = (size_t)(row0 + ai * HALF + m * 16) * ldc + col0;
#pragma unroll
                for (int bj = 0; bj < 2; ++bj)
#pragma unroll
                    for (int n = 0; n < 2; ++n) acc[ai][bj][m][n] = *(const f32x4*)(xold + ro + bj * HALF + 16 * n); }
    }
    __device__ __forceinline__ void operator()(const f32x4 (&acc)[2][2][4][2], const Unit& u, int wr, int wc, int fr, int fq) const {
        const int row0 = u.pm * BM + wr * 64 + fr, col0 = u.pn * BM + wc * 32 + 4 * fq;
#pragma unroll
        for (int ai = 0; ai < 2; ++ai)
#pragma unroll
            for (int m = 0; m < 4; ++m) {
                const int row = row0 + ai * HALF + m * 16; const size_t ro = (size_t)row * ldc + col0; float sq = 0.f;
#pragma unroll
                for (int bj = 0; bj < 2; ++bj)
#pragma unroll
                    for (int n = 0; n < 2; ++n) { const size_t o = ro + bj * HALF + 16 * n;
                        const f32x4 v = acc[ai][bj][m][n];
                        sq += (v[0] * v[0] + v[1] * v[1]) + (v[2] * v[2] + v[3] * v[3]);
                        *(f32x4*)(out + o) = v; u32x2 w; w.x = cvt_pk_bf16(v[0], v[1]); w.y = cvt_pk_bf16(v[2], v[3]); *(u32x2*)(xb + o) = w; }
                sq += __shfl_xor(sq, 16); sq += __shfl_xor(sq, 32); if (fq == 0) ssq_out[(size_t)row * 32 + u.pn * 4 + wc] = sq;
            }
    }
};

template <class Epi, class Sched, bool ALIGN_EPI = false>
__device__ __forceinline__ void gemm_phase(PG8_LAS unsigned char* lds, const Gemm g, const Sched& S, const Epi& E) {
    const int tid = threadIdx.x, wid = __builtin_amdgcn_readfirstlane(tid >> 6), lane = tid & 63, wr = wid >> 2, wc = wid & 3, fr = lane & 15, fq = lane >> 4;
    const int K = g.K, nt = K / BK;
    unsigned voffA[2], voffB[2];
#pragma unroll
    for (int i = 0; i < 2; ++i) { int R, C; stage_rc(tid * 16 + i * 8192, R, C); const int Rb = Epi::PERM ? ((R & ~31) + perm32(R & 31)) : R;
        voffA[i] = (unsigned)(R * g.lda + C) * 2u; voffB[i] = (unsigned)(Rb * g.ldb + C) * 2u; }
    const size_t kstep = (size_t)(BK * 2);
    const size_t hstepA = (size_t)HALF * g.lda * 2, hstepB = (size_t)HALF * g.ldb * 2;
    const size_t tstepA = 2 * hstepA, tstepB = 2 * hstepB;
    const unsigned ldsw = (unsigned)wid * 1024u;
    const int aoff = lds_byte(wr * 64 + fr, fq * 8), boff = lds_byte(wc * 32 + fr, fq * 8);
#define PG8_SA(b, h) (((b) * 2 + (h)) * HTB)
#define PG8_SB(b, h) ((4 + (b) * 2 + (h)) * HTB)
#define PG8_STAGE(bufoff, gbase, voff) do { _Pragma("unroll") for (int _i = 0; _i < 2; ++_i) \
        __builtin_amdgcn_global_load_lds((const unsigned*)((const char*)(gbase) + (voff)[_i]), (PG8_LAS unsigned*)(lds + (bufoff) + ldsw + _i * 8192), 16, 0, 0); } while (0)
#define PG8_LDA(dst, b, h) do { _Pragma("unroll") for (int m = 0; m < 4; ++m) _Pragma("unroll") for (int k = 0; k < 2; ++k) dst[m][k] = *(const PG8_LAS bf16x8*)(lds + PG8_SA(b, h) + aoff + m * 2048 + k * 1024); } while (0)
#define PG8_LDB(dst, b, h) do { _Pragma("unroll") for (int n = 0; n < 2; ++n) _Pragma("unroll") for (int k = 0; k < 2; ++k) dst[n][k] = *(const PG8_LAS bf16x8*)(lds + PG8_SB(b, h) + boff + n * 2048 + k * 1024); } while (0)
#define PG8_MMA(ai, bj, At, Bt) do { __builtin_amdgcn_s_setprio(1); _Pragma("unroll") for (int m = 0; m < 4; ++m) _Pragma("unroll") for (int n = 0; n < 2; ++n) _Pragma("unroll") for (int k = 0; k < 2; ++k) \
        acc[ai][bj][m][n] = __builtin_amdgcn_mfma_f32_16x16x32_bf16(Bt[n][k], At[m][k], acc[ai][bj][m][n], 0, 0, 0); __builtin_amdgcn_s_setprio(0); } while (0)
#define PG8_WAIT_V(n) asm volatile("s_waitcnt vmcnt(" #n ")" ::: "memory")
#define PG8_WAIT_L(n) asm volatile("s_waitcnt lgkmcnt(" #n ")" ::: "memory")
#define PG8_BAR __builtin_amdgcn_s_barrier()
#define PG8_SCHED __builtin_amdgcn_sched_barrier(0)
    Unit cur, nxt; int ui = 0;
    if (!S.next(0, cur)) return;
    f32x4 acc[2][2][4][2];
    if constexpr (Epi::HAS_INIT) E.init(acc, cur, wr, wc, fr, fq);
    else {
#pragma unroll
    for (int a = 0; a < 2; ++a)
#pragma unroll
        for (int b = 0; b < 2; ++b)
#pragma unroll
            for (int m = 0; m < 4; ++m)
#pragma unroll
                for (int n = 0; n < 2; ++n) acc[a][b][m][n] = (f32x4){0.f, 0.f, 0.f, 0.f};
    }
    bf16x8 At[4][2], B0[2][2], B1[2][2];
    const char* cA = (const char*)g.A + (size_t)cur.pm * tstepA; const char* cB = (const char*)g.Bt + (size_t)cur.pn * tstepB;
    S.a_ready(cur);
    PG8_STAGE(PG8_SB(0, 0), cB, voffB); PG8_STAGE(PG8_SB(0, 1), cB + hstepB, voffB); PG8_STAGE(PG8_SA(0, 0), cA, voffA); PG8_STAGE(PG8_SA(0, 1), cA + hstepA, voffA);
    if (wr == 1) PG8_BAR;
    PG8_WAIT_V(2); PG8_BAR;
    PG8_STAGE(PG8_SB(1, 0), cB + kstep, voffB); PG8_STAGE(PG8_SA(1, 0), cA + kstep, voffA); PG8_STAGE(PG8_SB(1, 1), cB + hstepB + kstep, voffB);
    PG8_WAIT_V(6); PG8_BAR;
    for (;;) {
        const bool has_next = S.next(ui + 1, nxt);
        const char* nA = has_next ? (const char*)g.A + (size_t)nxt.pm * tstepA : cA; const char* nB = has_next ? (const char*)g.Bt + (size_t)nxt.pn * tstepB : cB;
        for (int t = 0; t < nt; t += 2) {
            const bool last = (t == nt - 2);
            const char* a1 = cA + (size_t)(t + 1) * kstep;
            const char* a2 = last ? nA : cA + (size_t)(t + 2) * kstep; const char* b2 = last ? nB : cB + (size_t)(t + 2) * kstep;
            const char* a3 = a2 + kstep; const char* b3 = b2 + kstep;
            if (last && has_next) S.a_ready(nxt);
            PG8_LDB(B0, 0, 0); PG8_LDB(B1, 0, 1); PG8_SCHED; PG8_LDA(At, 0, 0); PG8_STAGE(PG8_SA(1, 1), a1 + hstepA, voffA);
            PG8_WAIT_V(8); PG8_WAIT_L(0); PG8_BAR; PG8_MMA(0, 0, At, B0); PG8_MMA(0, 1, At, B1); PG8_BAR; PG8_SCHED;
            PG8_LDA(At, 0, 1); PG8_STAGE(PG8_SB(0, 0), b2, voffB); PG8_STAGE(PG8_SB(0, 1), b2 + hstepB, voffB); PG8_STAGE(PG8_SA(0, 0), a2, voffA);
            PG8_WAIT_V(8); PG8_WAIT_L(0); PG8_BAR; PG8_MMA(1, 0, At, B0); PG8_MMA(1, 1, At, B1); PG8_BAR; PG8_SCHED;
            PG8_LDB(B0, 1, 0); PG8_LDB(B1, 1, 1); PG8_SCHED; PG8_LDA(At, 1, 0); PG8_STAGE(PG8_SA(0, 1), a2 + hstepA, voffA);
            PG8_WAIT_V(8); PG8_WAIT_L(0); PG8_BAR; PG8_MMA(0, 0, At, B0); PG8_MMA(0, 1, At, B1); PG8_BAR; PG8_SCHED;
            PG8_LDA(At, 1, 1); PG8_STAGE(PG8_SB(1, 0), b3, voffB); PG8_STAGE(PG8_SB(1, 1), b3 + hstepB, voffB); PG8_STAGE(PG8_SA(1, 0), a3, voffA);
            PG8_WAIT_V(8); PG8_WAIT_L(0); PG8_BAR; PG8_MMA(1, 0, At, B0); PG8_MMA(1, 1, At, B1); PG8_BAR; PG8_SCHED;
        }
        if constexpr (ALIGN_EPI) { if (wr == 0) PG8_BAR; }
        E(acc, cur, wr, wc, fr, fq); S.done(cur);
        if (!has_next) break;
        if constexpr (Epi::HAS_INIT) E.init(acc, nxt, wr, wc, fr, fq);
        else {
#pragma unroll
        for (int a = 0; a < 2; ++a)
#pragma unroll
            for (int b = 0; b < 2; ++b)
#pragma unroll
                for (int m = 0; m < 4; ++m)
#pragma unroll
                    for (int n = 0; n < 2; ++n) acc[a][b][m][n] = (f32x4){0.f, 0.f, 0.f, 0.f};
        }
        cur = nxt; cA = nA; cB = nB; ++ui;
        if constexpr (ALIGN_EPI) { if (wr == 1) PG8_BAR; }
    }
    PG8_WAIT_V(0);
    if constexpr (!ALIGN_EPI) { if (wr == 0) PG8_BAR; }
    PG8_BAR;
#undef PG8_SA
#undef PG8_SB
#undef PG8_STAGE
#undef PG8_LDA
#undef PG8_LDB
#undef PG8_MMA
#undef PG8_WAIT_V
#undef PG8_WAIT_L
#undef PG8_BAR
#undef PG8_SCHED
}
}
#define GAS __attribute__((address_space(1)))
#define LAS __attribute__((address_space(3)))
typedef unsigned short bf16;
typedef unsigned v4u __attribute__((ext_vector_type(4)));
typedef unsigned v2u __attribute__((ext_vector_type(2)));
typedef float f32x4 __attribute__((ext_vector_type(4)));
typedef float f32x16 __attribute__((ext_vector_type(16)));
typedef short bf16x8 __attribute__((ext_vector_type(8)));
typedef __bf16 bf16x2_t __attribute__((ext_vector_type(2)));
typedef GAS unsigned gu32;
#define RLX_AGENT __ATOMIC_RELAXED, __HIP_MEMORY_SCOPE_AGENT
__device__ __forceinline__ unsigned f2bf(float f) { unsigned u = __builtin_bit_cast(unsigned, f); return (u + 0x7fffu + ((u >> 16) & 1u)) >> 16; }
__device__ __forceinline__ unsigned pk2(float lo, float hi) { return pg8::cvt_pk_bf16(lo, hi); }
__device__ __forceinline__ float bf2f(unsigned short v) { return __uint_as_float((unsigned)v << 16); }
__device__ __forceinline__ float bflo(unsigned w) { return __uint_as_float(w << 16); }
__device__ __forceinline__ float bfhi(unsigned w) { return __uint_as_float(w & 0xffff0000u); }
__device__ __forceinline__ float dot2(unsigned a, unsigned b, float acc) { return __builtin_amdgcn_fdot2_f32_bf16(__builtin_bit_cast(bf16x2_t, a), __builtin_bit_cast(bf16x2_t, b), acc, false); }
__device__ __forceinline__ float wave_sum(float v) {
#pragma unroll
    for (int o = 1; o < 64; o <<= 1) v += __shfl_xor(v, o);
    return v;
}
__device__ __forceinline__ float pair_max(float x) { auto t = __builtin_amdgcn_permlane32_swap(__float_as_uint(x), __float_as_uint(x), false, false); return fmaxf(__uint_as_float(t[0]), __uint_as_float(t[1])); }
__device__ __forceinline__ float pair_sum(float x) { auto t = __builtin_amdgcn_permlane32_swap(__float_as_uint(x), __float_as_uint(x), false, false); return __uint_as_float(t[0]) + __uint_as_float(t[1]); }

#define XB_TMO      128
#define XB_XCNT(j)  (256  + 64 * (j))
#define XB_XSUB(j)  (1280 + 64 * (j))
#define XB_XGEN(j)  (2304 + 64 * (j))
#define XB_TOP      3328
#define XB_TOPGEN   3392
#define XCD_BAR_WORDS 3456
#define XB_SPIN_CAP (1u << 18)

__device__ __forceinline__ unsigned xb_ld(unsigned* p)              { return __hip_atomic_load(p, __ATOMIC_RELAXED, __HIP_MEMORY_SCOPE_AGENT); }
__device__ __forceinline__ unsigned xb_add(unsigned* p, unsigned v) { return __hip_atomic_fetch_add(p, v, __ATOMIC_RELAXED, __HIP_MEMORY_SCOPE_AGENT); }
__device__ __forceinline__ unsigned xb_xcc_id() { return (unsigned)__builtin_amdgcn_s_getreg((3 << 11) | 20) & 0xFu; }
#define XB_SPIN(cond, bar) do { unsigned _sp = 0; while (cond) { __builtin_amdgcn_s_sleep(1); \
    if ((++_sp & 255u) == 0u) { if (xb_ld(&(bar)[XB_TMO])) break; if (_sp > XB_SPIN_CAP) { atomicAdd(&(bar)[XB_TMO], 1u); break; } } } } while (0)

struct XcdBarrier {
    unsigned* bar; unsigned x;
    volatile LAS unsigned* st;
};
__device__ __forceinline__ XcdBarrier xcd_barrier_post(unsigned* bar, volatile LAS unsigned* st) {
    XcdBarrier b; b.bar = bar; b.x = xb_xcc_id(); b.st = st;
    if (threadIdx.x == 0) (void)xb_add(&bar[XB_XCNT(b.x)], 1u);
    return b;
}
__device__ __forceinline__ void xcd_barrier_complete(unsigned* bar, unsigned x, unsigned& nloc, unsigned& nx) {
    const unsigned G = gridDim.x * gridDim.y * gridDim.z;
    unsigned sum, cnt, mine, sp = 0u;
    for (;;) {
        sum = 0u; cnt = 0u; mine = 0u;
#pragma unroll
        for (unsigned j = 0; j < 16; ++j) { const unsigned c = xb_ld(&bar[XB_XCNT(j)]); sum += c; cnt += (c > 0u) ? 1u : 0u; mine = (j == x) ? c : mine; }
        if (sum == G) break;
        __builtin_amdgcn_s_sleep(1);
        if ((++sp & 255u) == 0u) { if (xb_ld(&bar[XB_TMO])) break; if (sp > XB_SPIN_CAP) { atomicAdd(&bar[XB_TMO], 1u); break; } }
    }
    nloc = mine > 0u ? mine : 1u; nx = cnt > 0u ? cnt : 1u;
}
__device__ __forceinline__ void xcd_barrier(const XcdBarrier& b) {
    asm volatile("s_waitcnt vmcnt(0)" ::: "memory");
    __syncthreads();
    if (threadIdx.x == 0) {
        unsigned* bar = b.bar;
        __builtin_amdgcn_s_waitcnt(0);
        unsigned nloc = b.st[0], nx = b.st[1];
        if (nloc == 0u) { xcd_barrier_complete(bar, b.x, nloc, nx); b.st[0] = nloc; b.st[1] = nx; }
        const unsigned old = xb_add(&bar[XB_XSUB(b.x)], 1u);
        const unsigned gen = old / nloc;
        if (old + 1u == (gen + 1u) * nloc) {
            __builtin_amdgcn_fence(__ATOMIC_RELEASE, "agent");
            asm volatile("s_waitcnt vmcnt(0)" ::: "memory");
            const unsigned og = xb_add(&bar[XB_TOP], 1u);
            const unsigned tg = og / nx;
            if (og + 1u == (tg + 1u) * nx) xb_add(&bar[XB_TOPGEN], 1u);
            else XB_SPIN(xb_ld(&bar[XB_TOPGEN]) == tg, bar);
            __builtin_amdgcn_fence(__ATOMIC_ACQUIRE, "agent");
            xb_add(&bar[XB_XGEN(b.x)], 1u);
            asm volatile("s_waitcnt vmcnt(0)" ::: "memory");
        } else {
            XB_SPIN(xb_ld(&bar[XB_XGEN(b.x)]) == gen, bar);
            __builtin_amdgcn_fence(__ATOMIC_ACQUIRE, "agent");
            asm volatile("s_waitcnt vmcnt(0)" ::: "memory");
        }
    }
    __syncthreads();
}
constexpr int NWAVES = 8;
constexpr int N_PHASES = 14;
constexpr int NB = 4, SEQ = 2048, T = NB * SEQ, D = 2048;
constexpr int MLA_H = 16, MLA_QK = 192, MLA_NOPE = 128, MLA_ROPE = 64, MLA_IN = 1088, MLA_INP = 1280, MLA_QN = 3072;
constexpr int FOX_H = 16, FOX_HD = 128, FOX_ZN = 6144;
constexpr int PE_H = 8, PE_NK = 128, PE_TOPK = 16, PE_NE = 16384, PE_SEL = 128;
constexpr float RMS_EPS = 1e-6f, LOG2E = 1.4426950408889634f;

constexpr size_t MiB = 1u << 20;
constexpr size_t WS_CTL = 0, CTL_ZERO_BYTES = 1 * MiB;
constexpr size_t WS_SSQ = 1 * MiB;
constexpr size_t WS_WF = WS_SSQ + 2 * MiB;
constexpr size_t WS_SKB = WS_WF + 128 * 1024;
constexpr size_t WS_LF = WS_SKB + 128 * 1024;
constexpr size_t WS_WT_MLA_IN = 5 * MiB;
constexpr size_t WS_WT_QB = WS_WT_MLA_IN + 5 * MiB;
constexpr size_t WS_WT_KVB = WS_WT_QB + 3 * MiB;
constexpr size_t WS_WT_MLA_O = WS_WT_KVB + 4 * MiB;
constexpr size_t WS_WT_FOX_IN = WS_WT_MLA_O + 8 * MiB;
constexpr size_t WS_WT_FOX_O = WS_WT_FOX_IN + 32 * MiB;
constexpr size_t WS_WT_PQ = WS_WT_FOX_O + 8 * MiB;
constexpr size_t WS_PU = WS_WT_PQ + 16 * MiB;
constexpr size_t WS_PV = WS_PU + 64 * MiB;
constexpr size_t WS_PSU = WS_PV + 64 * MiB, WS_PSV = WS_PSU + 128 * 1024;
constexpr size_t WS_XB = WS_PSU + 1 * MiB;
constexpr size_t WS_O = WS_XB + 32 * MiB;
constexpr size_t WS_QP = WS_O + 32 * MiB;
constexpr size_t WS_VT = WS_QP + 32 * MiB;
constexpr size_t WS_ACT = WS_VT + 32 * MiB;
constexpr size_t WS_Z0 = WS_ACT;
constexpr size_t WS_Q = WS_Z0 + 20 * MiB;
constexpr size_t WS_KN = WS_Q + 48 * MiB;
constexpr size_t WS_KM = WS_KN + 32 * MiB;
constexpr size_t WS_KRG = WS_KM;
constexpr size_t WS_RCKV = WS_KM + 2 * MiB, WS_KRSS = WS_RCKV + 256 * 1024;
constexpr size_t WS_ROPE = WS_KM + 4 * MiB;
constexpr size_t WS_KSQM = WS_KM + 8 * MiB;
constexpr size_t WS_Z = WS_ACT;
constexpr size_t WS_KSQ = WS_ACT + 100 * MiB;
constexpr size_t WS_END = WS_KM + 48 * MiB;
static_assert(WS_Z + 96 * MiB <= WS_END, "ws map");
constexpr int SSQ_X0 = 0, SSQ_X2 = T, SSQ_CQ = 2 * T, SSQ_CKV = 10 * T, SSQ_XS = 18 * T;
constexpr int CW_BAR = 4096;

constexpr int RING_OFF = 0, RING_BYTES = 131072;
constexpr int LDS_BYTES = 163840;
constexpr int LDSCTL_OFF = LDS_BYTES - 1024, MISC_OFF = LDSCTL_OFF + 320;

struct Frame {
    LAS unsigned char* lds;
    int tid, lane, wave, vcu, G;
    unsigned char* ws;
    float* out;
};

__device__ __forceinline__ void transpose_item(const float* W, int ldw, int k0, int n0src, const float* gain, bf16* WT, int K, int dstrow0, LAS float* scr, int lane) {
    const int r4 = lane >> 4, c4 = (lane & 15) * 4; f32x4 v[16];
    const float* src = W + (size_t)(k0 + r4) * ldw + n0src + c4;
#pragma unroll
    for (int i = 0; i < 16; ++i) v[i] = *(const f32x4*)(src + (size_t)(4 * i) * ldw);
#pragma unroll
    for (int i = 0; i < 16; ++i) { const int kk = 4 * i + r4; const float gk = gain ? gain[k0 + kk] : 1.f; LAS float* d = scr + kk * 65 + c4; d[0] = v[i].x * gk; d[1] = v[i].y * gk; d[2] = v[i].z * gk; d[3] = v[i].w * gk; }
    asm volatile("s_waitcnt lgkmcnt(0)" ::: "memory");
    const int c = lane & 7;
#pragma unroll
    for (int j = 0; j < 8; ++j) { const int n = (lane >> 3) + 8 * j; const LAS float* s = scr + (8 * c) * 65 + n;
        v4u o; o.x = pk2(s[0 * 65], s[1 * 65]); o.y = pk2(s[2 * 65], s[3 * 65]); o.z = pk2(s[4 * 65], s[5 * 65]); o.w = pk2(s[6 * 65], s[7 * 65]);
        *(v4u*)(WT + (size_t)(dstrow0 + n) * K + k0 + 8 * c) = o; }
    asm volatile("s_waitcnt lgkmcnt(0)" ::: "memory");
}
struct In {
    const float* x; const int* pos; const float *g_mix, *g_ffn, *mla_w_in, *mla_g_qa, *mla_w_qb, *mla_g_kva, *mla_w_kvb, *mla_g_q, *mla_g_k, *mla_w_o,
        *fox_w_in, *fox_b_f, *fox_g_q, *fox_g_k, *fox_w_o, *pe_wq, *pe_sk, *pe_u, *pe_v;
};
__device__ __forceinline__ void prologue_transpose_item(const In& I, unsigned char* ws, LAS float* scr, int lane, int it) {
    constexpr int I1 = 17 * 32, I2 = 48 * 8, I3 = 64 * 8, I4 = 32 * 32, I5 = 128 * 32, I6 = 32 * 32, I7 = 32 * 32;
        int r = it;
        if (r < I1) { const int kb = r / 17, nb = r % 17; transpose_item(I.mla_w_in, MLA_IN, 64 * kb, 64 * nb, I.g_mix, (bf16*)(ws + WS_WT_MLA_IN), 2048, 64 * nb, scr, lane); return; } r -= I1;
        if (r < I2) { const int kb = r / 48, nb = r % 48; transpose_item(I.mla_w_qb, 3072, 64 * kb, 64 * nb, I.mla_g_qa, (bf16*)(ws + WS_WT_QB), 512, 64 * nb, scr, lane); return; } r -= I2;
        if (r < I3) { const int kb = r / 64, nb = r % 64, n0 = 64 * nb, h = n0 >> 8, part = (n0 >> 7) & 1, d0 = n0 & 127;
            transpose_item(I.mla_w_kvb, 4096, 64 * kb, n0, I.mla_g_kva, (bf16*)(ws + WS_WT_KVB), 512, part * 2048 + h * 128 + d0, scr, lane); return; } r -= I3;
        if (r < I4) { const int kb = r / 32, nb = r % 32; transpose_item(I.mla_w_o, 2048, 64 * kb, 64 * nb, nullptr, (bf16*)(ws + WS_WT_MLA_O), 2048, 64 * nb, scr, lane); return; } r -= I4;
        if (r < I5) { const int kb = r / 128, nb = r % 128, n0 = 64 * nb, sec = n0 >> 11, dsec = (sec == 0) ? 0 : (sec == 1) ? 1 : (sec == 2) ? 3 : 2;
            transpose_item(I.fox_w_in, 8208, 64 * kb, n0, I.g_mix + 2048, (bf16*)(ws + WS_WT_FOX_IN), 2048, dsec * 2048 + (n0 & 2047), scr, lane); return; } r -= I5;
        if (r < I6) { const int kb = r / 32, nb = r % 32; transpose_item(I.fox_w_o, 2048, 64 * kb, 64 * nb, nullptr, (bf16*)(ws + WS_WT_FOX_O), 2048, 64 * nb, scr, lane); return; } r -= I6;
        if (r < I7) { const int kb = r / 32, nb = r % 32; transpose_item(I.pe_wq, 2048, 64 * kb, 64 * nb, I.g_ffn, (bf16*)(ws + WS_WT_PQ), 2048, 64 * nb, scr, lane); return; } r -= I7;
        { const int kb = r / 32, nb = r % 32; transpose_item(I.pe_wq + (size_t)2048 * 2048, 2048, 64 * kb, 64 * nb, I.g_ffn + 2048, (bf16*)(ws + WS_WT_PQ + 8 * MiB), 2048, 64 * nb, scr, lane); }
}
__device__ __forceinline__ void quant_pair(const In& I, unsigned char* ws, int lane, int row0) {
        f32x4 v[2][8]; float mx[2] = {0.f, 0.f};
#pragma unroll
        for (int u = 0; u < 2; ++u) { const int row = row0 + u, tbl = row >> 15, rr = row & 32767; const f32x4* src = (const f32x4*)((tbl ? I.pe_v : I.pe_u) + (size_t)rr * D) + lane;
#pragma unroll
            for (int q = 0; q < 8; ++q) v[u][q] = __builtin_nontemporal_load(src + 64 * q); }
#pragma unroll
        for (int u = 0; u < 2; ++u) {
#pragma unroll
            for (int i = 0; i < 8; ++i) { const f32x4 t = v[u][i]; mx[u] = fmaxf(mx[u], fmaxf(fmaxf(fabsf(t.x), fabsf(t.y)), fmaxf(fabsf(t.z), fabsf(t.w)))); }
#pragma unroll
            for (int o = 1; o < 64; o <<= 1) mx[u] = fmaxf(mx[u], __shfl_xor(mx[u], o));
        }
#pragma unroll
        for (int u = 0; u < 2; ++u) { const int row = row0 + u, tbl = row >> 15, rr = row & 32767;
            const float top = tbl ? 440.f : 127.f;
            const float inv = mx[u] > 0.f ? top / mx[u] : 1.f, sc = mx[u] > 0.f ? mx[u] / top : 1.f;
            v4u* dst = (v4u*)(ws + (tbl ? WS_PV : WS_PU) + (size_t)rr * D) + lane; unsigned dq[8];
#pragma unroll
            for (int q = 0; q < 8; ++q) { const f32x4 t = v[u][q] * inv; int w = 0;
                if (tbl) { w = __builtin_amdgcn_cvt_pk_fp8_f32(t.x, t.y, w, false); w = __builtin_amdgcn_cvt_pk_fp8_f32(t.z, t.w, w, true); }
                else w = (__float2int_rn(t.x) & 255) | ((__float2int_rn(t.y) & 255) << 8) | ((__float2int_rn(t.z) & 255) << 16) | (__float2int_rn(t.w) << 24);
                dq[q] = (unsigned)w; }
            if (tbl) {
#pragma unroll
                for (int q = 0; q < 8; ++q) ((unsigned*)dst)[64 * q - 3 * lane] = dq[q];
            } else { dst[0] = (v4u){dq[0], dq[1], dq[2], dq[3]}; dst[64] = (v4u){dq[4], dq[5], dq[6], dq[7]}; }
            if (lane == 0) ((float*)(ws + (tbl ? WS_PSV : WS_PSU)))[rr] = sc; }
}
constexpr int PE_FILL2 = 6144;
__device__ __forceinline__ void p_table_fill(const Frame& F, const In& I, int row_lo, int nrows, int w, int NW) {
    for (int r = 2 * w; r < nrows; r += 2 * NW) quant_pair(I, F.ws, F.lane, row_lo + r);
}
__device__ __forceinline__ void p_prologue(const Frame& F, const In& I) {
    LAS float* scr = (LAS float*)(F.lds + RING_OFF + F.wave * 16640);
    const int gw = F.vcu * NWAVES + F.wave, NGW = F.G * NWAVES, lane = F.lane;
    unsigned char* ws = F.ws;
    constexpr int I1 = 17 * 32, I2 = 48 * 8, I3 = 64 * 8, I4 = 32 * 32, I5 = 128 * 32, I6 = 32 * 32, I7 = 32 * 32, I8 = 32 * 32;
    constexpr int NITEMS = I1 + I2 + I3 + I4 + I5 + I6 + I7 + I8;
    const int gt = F.vcu * 512 + F.tid, NGT = F.G * 512;
    for (int i = gt; i < 49152; i += NGT) ((v4u*)(ws + WS_WT_MLA_IN + (size_t)MLA_IN * 2048 * 2))[i] = (v4u){0u, 0u, 0u, 0u};
    for (int i = gt; i < 16 * 2048; i += NGT) { const int j = i >> 11, k = i & 2047; ((float*)(ws + WS_WF))[i] = I.fox_w_in[(size_t)k * 8208 + 8192 + j] * I.g_mix[2048 + k]; }
    for (int i = gt; i < 2 * 2 * 128 * 128; i += NGT) ((bf16*)(ws + WS_SKB))[i] = (bf16)f2bf(I.pe_sk[i]);
    for (int m = gw; m < T; m += NGW) {
        const f32x4* xr = (const f32x4*)(I.x + (size_t)m * D) + lane; f32x4 v[8]; float s = 0.f;
#pragma unroll
        for (int j = 0; j < 8; ++j) { v[j] = xr[64 * j]; s += (v[j].x * v[j].x + v[j].y * v[j].y) + (v[j].z * v[j].z + v[j].w * v[j].w); }
        s = wave_sum(s); if (lane == 0) ((float*)(ws + WS_SSQ))[SSQ_X0 + m] = s;
        v2u* o = (v2u*)(ws + WS_XB + (size_t)m * D * 2) + lane;
#pragma unroll
        for (int j = 0; j < 8; ++j) { v2u w; w.x = pk2(v[j].x, v[j].y); w.y = pk2(v[j].z, v[j].w); o[64 * j] = w; }
    }
    int tit = gw, tk3 = 0;
    constexpr int NPRO = 65536 - 16384 - PE_FILL2;
    for (int vr = 2 * gw; vr < NPRO || tit < NITEMS; vr += 2 * NGW, ++tk3) {
        if ((tk3 % 3 == 0 || vr >= NPRO) && tit < NITEMS) { prologue_transpose_item(I, ws, scr, lane, tit); tit += NGW; }
        if (vr >= NPRO) continue;
        const int row0 = vr < 16384 ? vr : vr < 32768 ? 32768 + (vr - 16384) : 49152 + PE_FILL2 + (vr - 32768);
        quant_pair(I, ws, lane, row0);
    }
}

__device__ __forceinline__ void p_mla_tok(const Frame& F, const In& I) {
    const int gw = F.vcu * NWAVES + F.wave, NGW = F.G * NWAVES, lane = F.lane;
    const bf16* z0 = (const bf16*)(F.ws + WS_Z0); const float* sq = (const float*)(F.ws + WS_SSQ);
    const float gk2 = I.mla_g_k[128 + lane];
    const float inv_freq = __builtin_amdgcn_exp2f(-13.287712379549449f * (float)(2 * (lane & 31)) * (1.f / 64.f));
    for (int tok = gw; tok < T; tok += NGW) {
        const float ang = (float)I.pos[tok] * inv_freq; const float cs = __cosf(ang), sn = __sinf(ang);
        const float kr = bf2f(z0[(size_t)tok * MLA_INP + 1024 + lane]); const float kr_ss = wave_sum(kr * kr);
        const float krg = kr * gk2, pb = __shfl_xor(krg, 32);
        const float rot = (lane < 32) ? (krg * cs - pb * sn) : (krg * cs + pb * sn);
        ((bf16*)(F.ws + WS_KRG))[(size_t)tok * 64 + lane] = (bf16)f2bf(rot);
        ((float*)(F.ws + WS_ROPE))[(size_t)tok * 64 + lane] = (lane < 32) ? cs : sn;
        if (lane == 0) { ((float*)(F.ws + WS_RCKV))[tok] = __builtin_amdgcn_rsqf(pg8::slot_sum(sq + SSQ_CKV + (size_t)tok * 8, 8) * (1.f / 512.f) + RMS_EPS); ((float*)(F.ws + WS_KRSS))[tok] = kr_ss; }
    }
}

__device__ __forceinline__ void p_fox_prep(const Frame& F, const In& I) {
    const int gw = F.vcu * NWAVES + F.wave, NGW = F.G * NWAVES, lane = F.lane;
    bf16* z = (bf16*)(F.ws + WS_Z);
    const float QS = 0.08838834764831845f * LOG2E;
    const float gq0 = I.fox_g_q[lane], gq1 = I.fox_g_q[64 + lane], gk0 = I.fox_g_k[lane], gk1 = I.fox_g_k[64 + lane];
    for (int tok = gw; tok < T; tok += NGW) {
        bf16* zr = z + (size_t)tok * FOX_ZN;
        for (int h = 0; h < FOX_H; ++h) {
            bf16* qp = zr + h * 128; bf16* kp = zr + 2048 + h * 128;
            float a0 = bf2f(qp[lane]), a1 = bf2f(qp[64 + lane]), b0 = bf2f(kp[lane]), b1 = bf2f(kp[64 + lane]);
            const float rq = __builtin_amdgcn_rsqf(wave_sum(a0 * a0 + a1 * a1) * (1.f / 128.f) + RMS_EPS) * QS;
            const float rk = __builtin_amdgcn_rsqf(wave_sum(b0 * b0 + b1 * b1) * (1.f / 128.f) + RMS_EPS);
            qp[lane] = (bf16)f2bf(a0 * rq * gq0); qp[64 + lane] = (bf16)f2bf(a1 * rq * gq1);
            kp[lane] = (bf16)f2bf(b0 * rk * gk0); kp[64 + lane] = (bf16)f2bf(b1 * rk * gk1);
        }
    }
}

struct AttnAux { const float *gq, *gk, *ksq, *cqs, *rope, *rckv, *krss; const bf16* krg; };
template <int DK> struct AttnCfg { static constexpr int KP = DK + 8, KB_BYTES = 64 * KP * 2, VP = 72, VB_BYTES = 128 * VP * 2, NKS = DK / 16, KPT = (64 * DK / 8) / 512,
    OFF_K = 0, OFF_V = 2 * KB_BYTES, OFF_CL = OFF_V + 2 * VB_BYTES, OFF_WS = OFF_CL + 8192, OFF_RK = OFF_WS + 64, END = OFF_RK + 8192; };
template <int DK, bool FOX>
__device__ __forceinline__ void attn_unit(LAS unsigned char* lds, const bf16* __restrict__ Q, int qpitch, const bf16* __restrict__ K, int kpitch, const bf16* __restrict__ Vt, bf16* __restrict__ O,
                                          const bf16* __restrict__ gate, int gpitch, const float* __restrict__ lf, const AttnAux& ax,
                                          int b, int h, int qb, int tid, int wid, int lane) {
    const float* __restrict__ gq = ax.gq; const float* __restrict__ gk = ax.gk; const float* __restrict__ ksq = ax.ksq;
    typedef AttnCfg<DK> C;
    static_assert(C::END <= RING_BYTES, "attention LDS");
    asm volatile("" : "+v"(tid), "+v"(lane));
    const int r = lane & 31, hh = lane >> 5;
    const int tok0 = b * SEQ, q0 = qb * 256 + wid * 32, jw = q0 >> 6, jmax = qb * 4 + 3;
    constexpr int KPPR = DK / 8 + 1, KNI = 64 * KPPR / 64, VPPR = 9, VNI = 128 * VPPR / 64;
    static_assert(KPPR * 16 == C::KP * 2 && VPPR * 16 == C::VP * 2, "LDS pitches");
    const char* kbase_u = (const char*)(K + (size_t)tok0 * kpitch + h * (FOX ? DK : 128)); const char* vbase_u = (const char*)(Vt + (size_t)h * 128 * T + tok0);
    const char* krbase_u = FOX ? kbase_u : (const char*)(ax.krg + (size_t)tok0 * 64);
    unsigned kg[4], vg[3]; bool kr_[4];
#pragma unroll
    for (int i = 0; i < 4; ++i) { const int p = 64 * (wid + 8 * i) + lane, key = p / KPPR, c = p % KPPR;
        if (FOX) { kr_[i] = false; kg[i] = (unsigned)(key * kpitch + (c < DK / 8 ? c * 8 : 0)) * 2u; }
        else { kr_[i] = (c >= 16 && c < 24); kg[i] = kr_[i] ? (unsigned)(key * 64 + 8 * (c - 16)) * 2u : (unsigned)(key * kpitch + (c < 16 ? c * 8 : 0)) * 2u; } }
#pragma unroll
    for (int i = 0; i < 3; ++i) { const int p = 64 * (wid + 8 * i) + lane, dv = p / VPPR, c = p % VPPR; vg[i] = (unsigned)(dv * T + (c < 8 ? c * 8 : 0)) * 2u; }
#define ATT_STAGE(j, buf) do { const char* _kb = kbase_u + (size_t)(j) * 64 * kpitch * 2; const char* _rb = krbase_u + (size_t)(j) * 64 * 64 * 2; const char* _vb = vbase_u + (size_t)(j) * 128; \
        _Pragma("unroll") for (int i = 0; i < 4; ++i) if (wid + 8 * i < KNI) __builtin_amdgcn_global_load_lds((const unsigned*)(((!FOX && kr_[i]) ? _rb : _kb) + kg[i]), (LAS unsigned*)(lds + C::OFF_K + (buf) * C::KB_BYTES + 1024 * (wid + 8 * i)), 16, 0, 0); \
        _Pragma("unroll") for (int i = 0; i < 3; ++i) if (wid + 8 * i < VNI) __builtin_amdgcn_global_load_lds((const unsigned*)(_vb + vg[i]), (LAS unsigned*)(lds + C::OFF_V + (buf) * C::VB_BYTES + 1024 * (wid + 8 * i)), 16, 0, 0); } while (0)
#define ATT_SYNC() do { asm volatile("s_waitcnt vmcnt(0)" ::: "memory"); __syncthreads(); } while (0)
    ATT_STAGE(jmax, 0);
    bf16x8 qf[C::NKS];
    {
        LAS unsigned char* qst = lds + C::END + wid * 4608;
        const int rr_ = lane >> 3, cc_ = lane & 7;
        v4u qg[C::NKS / 4][4];
#pragma unroll
        for (int rd = 0; rd < C::NKS / 4; ++rd)
#pragma unroll
            for (int i = 0; i < 4; ++i) qg[rd][i] = *(const v4u*)(Q + (size_t)(tok0 + q0 + 8 * i + rr_) * qpitch + h * DK + 64 * rd + 8 * cc_);
#pragma unroll
        for (int rd = 0; rd < C::NKS / 4; ++rd) {
#pragma unroll
            for (int i = 0; i < 4; ++i) *(LAS v4u*)(qst + (8 * i + rr_) * 144 + cc_ * 16) = qg[rd][i];
            asm volatile("s_waitcnt lgkmcnt(0)" ::: "memory");
#pragma unroll
            for (int k4 = 0; k4 < 4; ++k4) qf[4 * rd + k4] = *(const LAS bf16x8*)(qst + r * 144 + k4 * 32 + hh * 16);
            asm volatile("s_waitcnt lgkmcnt(0)" ::: "memory");
        }
    }
    LAS float* cl = (LAS float*)(lds + C::OFF_CL);
    LAS float* rkl = (LAS float*)(lds + C::OFF_RK);
    if constexpr (FOX) {
        LAS float* wsum = (LAS float*)(lds + C::OFF_WS);
        const int n = (qb + 1) * 256; float v[4]; f32x4 kqv[4];
        { const f32x4 t4 = *(const f32x4*)(lf + (size_t)h * T + tok0 + 4 * tid);
#pragma unroll
          for (int e = 0; e < 4; ++e) v[e] = (4 * tid + e < n) ? t4[e] : 0.f; }
#pragma unroll
        for (int e = 0; e < 4; ++e) kqv[e] = *(const f32x4*)(ksq + ((size_t)h * T + tok0 + tid + 512 * e) * 4);
        {
            float ss = 0.f;
#pragma unroll
            for (int ks = 0; ks < C::NKS; ++ks)
#pragma unroll
                for (int j = 0; j < 8; ++j) { const float v_ = bf2f((unsigned short)qf[ks][j]); ss += v_ * v_; }
            ss = pair_sum(ss);
            const float rq = __builtin_amdgcn_rsqf(ss * (1.f / 128.f) + RMS_EPS) * (0.08838834764831845f * LOG2E);
#pragma unroll
            for (int ks = 0; ks < C::NKS; ++ks) { const int d0 = 16 * ks + 8 * hh; const f32x4 ga = *(const f32x4*)(gq + d0), gb = *(const f32x4*)(gq + d0 + 4), ka = *(const f32x4*)(gk + d0), kb2 = *(const f32x4*)(gk + d0 + 4);
                v4u w; w.x = pk2(bf2f((unsigned short)qf[ks][0]) * rq * ga.x * ka.x, bf2f((unsigned short)qf[ks][1]) * rq * ga.y * ka.y); w.y = pk2(bf2f((unsigned short)qf[ks][2]) * rq * ga.z * ka.z, bf2f((unsigned short)qf[ks][3]) * rq * ga.w * ka.w);
                w.z = pk2(bf2f((unsigned short)qf[ks][4]) * rq * gb.x * kb2.x, bf2f((unsigned short)qf[ks][5]) * rq * gb.y * kb2.y); w.w = pk2(bf2f((unsigned short)qf[ks][6]) * rq * gb.z * kb2.z, bf2f((unsigned short)qf[ks][7]) * rq * gb.w * kb2.w);
                qf[ks] = __builtin_bit_cast(bf16x8, w); }
        }
        v[1] += v[0]; v[2] += v[1]; v[3] += v[2];
        const float tot = v[3]; float sc = tot;
#pragma unroll
        for (int o = 1; o < 64; o <<= 1) { const float t = __shfl_up(sc, o); if (lane >= o) sc += t; }
        if (lane == 63) wsum[wid] = sc;
#pragma unroll
        for (int e = 0; e < 4; ++e) rkl[tid + 512 * e] = __builtin_amdgcn_rsqf(((kqv[e].x + kqv[e].y) + (kqv[e].z + kqv[e].w)) * (1.f / 128.f) + RMS_EPS);
        __syncthreads();
        float base = 0.f;
#pragma unroll
        for (int w = 0; w < 8; ++w) base += (w < wid) ? wsum[w] : 0.f;
        const float excl = base + sc - tot;
#pragma unroll
        for (int e = 0; e < 4; ++e) cl[4 * tid + e] = (excl + v[e]) * LOG2E;
    }
    if constexpr (!FOX) {
        f32x4 kqm[4]; float rcm[4], krm[4];
        { const int n = (qb + 1) * 256;
#pragma unroll
          for (int e = 0; e < 4; ++e) { const int sx = tid + 512 * e; kqm[e] = *(const f32x4*)(ksq + ((size_t)h * T + tok0 + sx) * 4); rcm[e] = ax.rckv[tok0 + sx]; krm[e] = ax.krss[tok0 + sx]; } (void)n; }
        {
            const int tokq = tok0 + q0 + r;
            const float rcq = __builtin_amdgcn_rsqf(pg8::slot_sum(ax.cqs + (size_t)tokq * 8, 8) * (1.f / 512.f) + RMS_EPS);
            float ss = 0.f;
#pragma unroll
            for (int ks = 0; ks < C::NKS; ++ks)
#pragma unroll
                for (int j = 0; j < 8; ++j) { const float v = bf2f((unsigned short)qf[ks][j]); ss += v * v; }
            ss = pair_sum(ss) * rcq * rcq;
            const float sc = rcq * __builtin_amdgcn_rsqf(ss * (1.f / 192.f) + RMS_EPS) * (0.07216878364870322f * LOG2E);
#pragma unroll
            for (int ks = 0; ks < 8; ++ks) { const int d0 = 16 * ks + 8 * hh; const f32x4 ga = *(const f32x4*)(gq + d0), gb = *(const f32x4*)(gq + d0 + 4), ka = *(const f32x4*)(gk + d0), kb2 = *(const f32x4*)(gk + d0 + 4);
                v4u w; w.x = pk2(bf2f((unsigned short)qf[ks][0]) * sc * ga.x * ka.x, bf2f((unsigned short)qf[ks][1]) * sc * ga.y * ka.y); w.y = pk2(bf2f((unsigned short)qf[ks][2]) * sc * ga.z * ka.z, bf2f((unsigned short)qf[ks][3]) * sc * ga.w * ka.w);
                w.z = pk2(bf2f((unsigned short)qf[ks][4]) * sc * gb.x * kb2.x, bf2f((unsigned short)qf[ks][5]) * sc * gb.y * kb2.y); w.w = pk2(bf2f((unsigned short)qf[ks][6]) * sc * gb.z * kb2.z, bf2f((unsigned short)qf[ks][7]) * sc * gb.w * kb2.w);
                qf[ks] = __builtin_bit_cast(bf16x8, w); }
#pragma unroll
            for (int kk = 0; kk < 2; ++kk) { const int i0 = 16 * kk + 8 * hh; const float* rp = ax.rope + (size_t)tokq * 64 + i0;
                const f32x4 c0 = *(const f32x4*)rp, c1 = *(const f32x4*)(rp + 4), s0_ = *(const f32x4*)(rp + 32), s1_ = *(const f32x4*)(rp + 36);
                const f32x4 g10 = *(const f32x4*)(gq + 128 + i0), g11 = *(const f32x4*)(gq + 132 + i0), g20 = *(const f32x4*)(gq + 160 + i0), g21 = *(const f32x4*)(gq + 164 + i0);
                float o1[8], o2[8];
#pragma unroll
                for (int j = 0; j < 8; ++j) { const float cj = j < 4 ? c0[j & 3] : c1[j & 3], sj = j < 4 ? s0_[j & 3] : s1_[j & 3], g1 = j < 4 ? g10[j & 3] : g11[j & 3], g2 = j < 4 ? g20[j & 3] : g21[j & 3];
                    const float x1 = bf2f((unsigned short)qf[8 + kk][j]) * sc * g1, x2 = bf2f((unsigned short)qf[10 + kk][j]) * sc * g2; o1[j] = x1 * cj - x2 * sj; o2[j] = x2 * cj + x1 * sj; }
                v4u w1, w2; w1.x = pk2(o1[0], o1[1]); w1.y = pk2(o1[2], o1[3]); w1.z = pk2(o1[4], o1[5]); w1.w = pk2(o1[6], o1[7]); w2.x = pk2(o2[0], o2[1]); w2.y = pk2(o2[2], o2[3]); w2.z = pk2(o2[4], o2[5]); w2.w = pk2(o2[6], o2[7]);
                qf[8 + kk] = __builtin_bit_cast(bf16x8, w1); qf[10 + kk] = __builtin_bit_cast(bf16x8, w2); }
        }
        {
#pragma unroll
            for (int e = 0; e < 4; ++e) { const int sx = tid + 512 * e; const f32x4 kq = kqm[e]; const float rc = rcm[e];
                const float rk = __builtin_amdgcn_rsqf((rc * rc * ((kq.x + kq.y) + (kq.z + kq.w)) + krm[e]) * (1.f / 192.f) + RMS_EPS); rkl[sx] = rk; cl[sx] = rk * rc; }
        }
    }
    f32x16 o[4];
#pragma unroll
    for (int i = 0; i < 4; ++i)
#pragma unroll
        for (int e = 0; e < 16; ++e) o[i][e] = 0.f;
    float m = -1e30f, l = 0.f;
    ATT_SYNC();
#pragma unroll 1
    for (int jj = 0; jj <= jmax; ++jj) { const int j = jmax - jj;
        if (jj < jmax) ATT_STAGE(j - 1, (jj + 1) & 1);
        if (j <= jw) {
#pragma unroll
            for (int kb2 = 0; kb2 < 2; ++kb2) { const int kbk = 1 - kb2;
                if (FOX && kbk == 1 && j == jw && (wid & 1) == 0) continue;
                f32x16 s0;
#pragma unroll
                for (int e = 0; e < 16; ++e) s0[e] = 0.f;
                const LAS unsigned char* kb = lds + C::OFF_K + (jj & 1) * C::KB_BYTES + ((32 * kbk + r) * C::KP + 8 * hh) * 2;
                if constexpr (FOX) {
#pragma unroll
                    for (int ks = 0; ks < C::NKS; ++ks) {
                        const bf16x8 a0 = *(const LAS bf16x8*)(kb + ks * 32);
                        s0 = __builtin_amdgcn_mfma_f32_32x32x16_bf16(a0, qf[ks], s0, 0, 0, 0);
                    }
                } else {
                    f32x16 sr;
#pragma unroll
                    for (int e = 0; e < 16; ++e) sr[e] = 0.f;
#pragma unroll
                    for (int ks = 0; ks < 8; ++ks) { const bf16x8 a0 = *(const LAS bf16x8*)(kb + ks * 32); s0 = __builtin_amdgcn_mfma_f32_32x32x16_bf16(a0, qf[ks], s0, 0, 0, 0); }
#pragma unroll
                    for (int ks = 8; ks < 12; ++ks) { const bf16x8 a0 = *(const LAS bf16x8*)(kb + ks * 32); sr = __builtin_amdgcn_mfma_f32_32x32x16_bf16(a0, qf[ks], sr, 0, 0, 0); }
                    const LAS f32x4* v4 = (const LAS f32x4*)(cl + 64 * j + 32 * kbk + 4 * hh); const LAS f32x4* r4 = (const LAS f32x4*)(rkl + 64 * j + 32 * kbk + 4 * hh);
#pragma unroll
                    for (int g = 0; g < 4; ++g) { const f32x4 kv = v4[2 * g], rr = r4[2 * g];
#pragma unroll
                        for (int e = 0; e < 4; ++e) s0[4 * g + e] = s0[4 * g + e] * kv[e] + sr[4 * g + e] * rr[e]; }
                }
                if constexpr (FOX) {
                    const LAS f32x4* c4 = (const LAS f32x4*)(cl + 64 * j + 32 * kbk + 4 * hh); const LAS f32x4* r4 = (const LAS f32x4*)(rkl + 64 * j + 32 * kbk + 4 * hh);
#pragma unroll
                    for (int g = 0; g < 4; ++g) { const f32x4 c0 = c4[2 * g], rr = r4[2 * g];
#pragma unroll
                        for (int e = 0; e < 4; ++e) s0[4 * g + e] = s0[4 * g + e] * rr[e] - c0[e]; }
                    if (j == jw) {
                        const int qrow = q0 + r, kbase = 64 * j + 32 * kbk + 4 * hh;
#pragma unroll
                        for (int e = 0; e < 16; ++e) { const int key = kbase + (e & 3) + 8 * (e >> 2); if (key > qrow) s0[e] = -1e30f; }
                    }
                }
                float mx = s0[0];
#pragma unroll
                for (int e = 1; e < 16; ++e) mx = fmaxf(mx, s0[e]);
                mx = pair_max(mx);
                const float mn = fmaxf(m, mx);
                if (__any(mn > m)) {
                    const float alpha = __builtin_amdgcn_exp2f(m - mn);
                    l *= alpha;
#pragma unroll
                    for (int i = 0; i < 4; ++i)
#pragma unroll
                        for (int e = 0; e < 16; ++e) o[i][e] *= alpha;
                    m = mn;
                }
                float ps = 0.f;
#pragma unroll
                for (int e = 0; e < 16; ++e) { s0[e] = __builtin_amdgcn_exp2f(s0[e] - m); ps += s0[e]; }
                l += ps;
                bf16x8 p[2];
#pragma unroll
                for (int s = 0; s < 2; ++s) {
                    v4u w0;
                    w0.x = pk2(s0[8 * s + 0], s0[8 * s + 1]); w0.y = pk2(s0[8 * s + 2], s0[8 * s + 3]); w0.z = pk2(s0[8 * s + 4], s0[8 * s + 5]); w0.w = pk2(s0[8 * s + 6], s0[8 * s + 7]);
                    p[s] = __builtin_bit_cast(bf16x8, w0);
                }
                const LAS unsigned char* vb = lds + C::OFF_V + (jj & 1) * C::VB_BYTES + (r * C::VP + 32 * kbk + 8 * hh) * 2;
#pragma unroll
                for (int dvb = 0; dvb < 4; ++dvb)
#pragma unroll
                    for (int s = 0; s < 2; ++s) {
                        const bf16x8 a = *(const LAS bf16x8*)(vb + (dvb * 32 * C::VP + 16 * s) * 2);
                        o[dvb] = __builtin_amdgcn_mfma_f32_32x32x16_bf16(a, p[s], o[dvb], 0, 0, 0);
                    }
            }
        }
        ATT_SYNC();
    }
#undef ATT_STAGE
#undef ATT_SYNC
    l = pair_sum(l);
    const float inv = 1.f / l;
    int re = r, he = hh; asm volatile("" : "+v"(re), "+v"(he));
    static_assert(C::END + 8 * 4608 <= LDSCTL_OFF, "attention O staging");
    LAS unsigned char* ost = lds + C::END + wid * 4608;
    const int rr = lane >> 3, cc = lane & 7;
    const size_t orow0 = (size_t)(tok0 + q0);
#pragma unroll
    for (int half = 0; half < 2; ++half) {
#pragma unroll
        for (int d2 = 0; d2 < 2; ++d2)
#pragma unroll
            for (int g = 0; g < 4; ++g) { const int dvb = 2 * half + d2;
                v2u w; w.x = pk2(o[dvb][4 * g + 0] * inv, o[dvb][4 * g + 1] * inv); w.y = pk2(o[dvb][4 * g + 2] * inv, o[dvb][4 * g + 3] * inv);
                *(LAS v2u*)(ost + re * 144 + (d2 * 32 + 8 * g + 4 * he) * 2) = w; }
        asm volatile("s_waitcnt lgkmcnt(0)" ::: "memory");
#pragma unroll
        for (int i = 0; i < 4; ++i) { const int row = 8 * i + rr;
            v4u w = *(const LAS v4u*)(ost + row * 144 + cc * 16);
            if constexpr (FOX) {
                const v4u gw = *(const v4u*)(gate + (orow0 + row) * gpitch + h * 128 + half * 64 + cc * 8);
#pragma unroll
                for (int c = 0; c < 4; ++c) { const float lo = bflo(w[c]) * __builtin_amdgcn_rcpf(1.f + __builtin_amdgcn_exp2f(-LOG2E * bflo(gw[c]))), hi = bfhi(w[c]) * __builtin_amdgcn_rcpf(1.f + __builtin_amdgcn_exp2f(-LOG2E * bfhi(gw[c]))); w[c] = pk2(lo, hi); }
            }
            *(v4u*)(O + (orow0 + row) * 2048 + h * 128 + half * 64 + cc * 8) = w; }
        asm volatile("s_waitcnt lgkmcnt(0)" ::: "memory");
    }
}
template <int DK, bool FOX>
__device__ __forceinline__ void p_attention(const Frame& F, const bf16* Q, int qpitch, const bf16* K, int kpitch, const bf16* Vt, bf16* O, const bf16* gate, int gpitch, const float* lf, const AttnAux& ax) {
    for (int u = F.vcu; u < 256; u += F.G) {
        const int bh = u >> 2, p = u & 3, b = bh >> 4, h = bh & 15;
#pragma unroll 1
        for (int half = 0; half < 2; ++half)
            attn_unit<DK, FOX>(F.lds + RING_OFF, Q, qpitch, K, kpitch, Vt, O, gate, gpitch, lf, ax, b, h, half ? p : 7 - p, F.tid, F.wave, F.lane);
    }
}

__device__ __forceinline__ unsigned sortkey(float s) { const unsigned b = __float_as_uint(s); return b ^ ((unsigned)((int)b >> 31) | 0x80000000u); }
__device__ __forceinline__ float unsortkey(unsigned k) { return __uint_as_float((k & 0x80000000u) ? (k ^ 0x80000000u) : ~k); }
#define TOP_INSERT(top, x) do { unsigned _x = (x); _Pragma("unroll") for (int _i = 0; _i < 16; ++_i) { const unsigned _h = max((top)[_i], _x); _x = min((top)[_i], _x); (top)[_i] = _h; } } while (0)
__device__ __forceinline__ int sel16(const int (&a)[16], int i) { int r = a[0];
#pragma unroll
    for (int q = 1; q < 16; ++q) r = (i == q) ? a[q] : r;
    return r; }
#define CE_DESC(a, b) do { const unsigned _hi = max((a), (b)), _lo = min((a), (b)); (a) = _hi; (b) = _lo; } while (0)
__device__ __forceinline__ void bitonic_merge16_desc(unsigned (&v)[16]) {
#pragma unroll
    for (int j = 8; j > 0; j >>= 1)
#pragma unroll
        for (int i = 0; i < 16; ++i) if ((i & j) == 0) CE_DESC(v[i], v[i | j]);
}
__device__ __forceinline__ void sort16_desc(unsigned (&v)[16]) {
#pragma unroll
    for (int k = 2; k <= 16; k <<= 1)
#pragma unroll
        for (int j = k >> 1; j > 0; j >>= 1)
#pragma unroll
            for (int i = 0; i < 16; ++i) { const int l = i ^ j; if (l > i) { if ((i & k) == 0 || k == 16) CE_DESC(v[i], v[l]); else CE_DESC(v[l], v[i]); } }
}
__device__ __forceinline__ void merge_top16(unsigned (&top)[16], const unsigned (&b)[16]) {
#pragma unroll
    for (int i = 0; i < 16; ++i) top[i] = max(top[i], b[15 - i]);
    bitonic_merge16_desc(top);
}
__device__ __forceinline__ void peer_half_top16(const bf16* __restrict__ qrow  , const bf16* __restrict__ sk  , int hh, unsigned (&top)[16]) {
#pragma unroll
    for (int i = 0; i < 16; ++i) top[i] = 0u;
#pragma unroll 1
    for (int kb = 0; kb < 4; ++kb) {
        f32x16 acc;
#pragma unroll
        for (int e = 0; e < 16; ++e) acc[e] = 0.f;
        const bf16* skb = sk + (size_t)kb * 32 * 128;
#pragma unroll
        for (int ks = 0; ks < 8; ++ks) { const bf16x8 qf = *(const bf16x8*)(qrow + 16 * ks), a = *(const bf16x8*)(skb + 16 * ks); acc = __builtin_amdgcn_mfma_f32_32x32x16_bf16(a, qf, acc, 0, 0, 0); }
        const int kbase = 127 - (32 * kb + 4 * hh);
        unsigned nv[16];
#pragma unroll
        for (int e = 0; e < 16; ++e) nv[e] = (sortkey(acc[e]) & ~127u) | (unsigned)(kbase - ((e & 3) + 8 * (e >> 2)));
        sort16_desc(nv); merge_top16(top, nv);
    }
    unsigned pt[16];
#pragma unroll
    for (int i = 0; i < 16; ++i) pt[i] = (unsigned)__shfl_xor((int)top[i], 32);
    merge_top16(top, pt);
}
constexpr int PE_OFF_IDX = 0, PE_OFF_G = 16384, PE_OFF_TB = 32768;
__device__ __forceinline__ void peer_topk(const Frame& F, int layer, int t0) {
    const int lane = F.lane, r = lane & 31, hh = lane >> 5, head = F.wave;
    const bf16* qp = (const bf16*)(F.ws + WS_QP) + (size_t)(t0 + r) * 2048 + head * 256 + 8 * hh;
    const bf16* sk = (const bf16*)(F.ws + WS_SKB) + (size_t)layer * 2 * 128 * 128 + r * 128 + 8 * hh;
    unsigned t1[16], t2[16];
    peer_half_top16(qp, sk, hh, t1);
    peer_half_top16(qp + 128, sk + 128 * 128, hh, t2);
    int rr = r; asm volatile("" : "+v"(rr));
    const float rs = __builtin_amdgcn_rsqf(pg8::slot_sum((const float*)(F.ws + WS_SSQ) + SSQ_XS + (size_t)(t0 + rr) * 32, 32) * (1.f / 2048.f) + RMS_EPS);
    float v1[16], v2[16]; int e1[16], e2[16];
#pragma unroll
    for (int i = 0; i < 16; ++i) { v1[i] = unsortkey(t1[i] & ~127u) * rs; e1[i] = 127 - (int)(t1[i] & 127u); v2[i] = unsortkey(t2[i] & ~127u) * rs; e2[i] = 127 - (int)(t2[i] & 127u); }
    unsigned best[16], g1[16], g2[16], g3[16];
#pragma unroll
    for (int i = 0; i < 16; ++i) { best[i] = 0u; g1[i] = 0u; g2[i] = 0u; g3[i] = 0u; }
    { int n = 0;
#pragma unroll
      for (int i = 0; i < 16; ++i)
#pragma unroll
        for (int j = 0; j < 16; ++j)
            if ((i + 1) * (j + 1) <= 16) { const unsigned kx = (sortkey(v1[i] + v2[j]) & ~255u) | (unsigned)(255 - (i * 16 + j));
                if (n < 16) best[n & 15] = kx; else if (n < 32) g1[n & 15] = kx; else if (n < 48) g2[n & 15] = kx; else g3[n & 15] = kx; ++n; } }
    sort16_desc(best); sort16_desc(g1); sort16_desc(g2); sort16_desc(g3);
    merge_top16(best, g1); merge_top16(best, g2); merge_top16(best, g3);
    float sc[16]; int ex[16];
    LAS int* tb = (LAS int*)(F.lds + RING_OFF + PE_OFF_TB) + F.wave * 2048 + lane;
#pragma unroll
    for (int i = 0; i < 16; ++i) { tb[i * 64] = e1[i]; tb[(16 + i) * 64] = e2[i]; }
#pragma unroll
    for (int k = 0; k < 16; ++k) { const int pos = 255 - (int)(best[k] & 255u); ex[k] = tb[(pos >> 4) * 64] * PE_NK + tb[(16 + (pos & 15)) * 64]; sc[k] = unsortkey(best[k] & ~255u); }
    float sum = 0.f; const float smax = sc[0];
#pragma unroll
    for (int k = 0; k < 16; ++k) { sc[k] = __expf(sc[k] - smax); sum += sc[k]; }
    const float inv = 1.f / sum;
    LAS int* li = (LAS int*)(F.lds + RING_OFF + PE_OFF_IDX) + r * PE_SEL + head * 16;
    LAS float* lg = (LAS float*)(F.lds + RING_OFF + PE_OFF_G) + r * PE_SEL + head * 16;
    if (hh == 0) {
#pragma unroll
        for (int k = 0; k < 16; ++k) li[k] = ex[k];
    } else {
#pragma unroll
        for (int k = 0; k < 16; ++k) lg[k] = sc[k] * inv;
    }
}
__device__ __forceinline__ float group_sum64(float v) {
    const int i0 = __builtin_bit_cast(int, v);
    v += __builtin_bit_cast(float, __builtin_amdgcn_update_dpp(0, i0, 0x111, 0xf, 0xf, true));
    v += __builtin_bit_cast(float, __builtin_amdgcn_update_dpp(0, __builtin_bit_cast(int, v), 0x112, 0xf, 0xf, true));
    v += __builtin_bit_cast(float, __builtin_amdgcn_update_dpp(0, __builtin_bit_cast(int, v), 0x114, 0xf, 0xf, true));
    v += __builtin_bit_cast(float, __builtin_amdgcn_update_dpp(0, __builtin_bit_cast(int, v), 0x118, 0xf, 0xf, true));
    v += __builtin_bit_cast(float, __builtin_amdgcn_update_dpp(0, __builtin_bit_cast(int, v), 0x142, 0xa, 0xf, false));
    v += __builtin_bit_cast(float, __builtin_amdgcn_update_dpp(0, __builtin_bit_cast(int, v), 0x143, 0xc, 0xf, false));
    return v;
}
__device__ __forceinline__ float gelu_erf(float x) { return 0.5f * x * (1.f + erff(x * 0.7071067811865476f)); }
typedef float f32x2 __attribute__((ext_vector_type(2)));
__device__ __forceinline__ void sort128(unsigned& kA, unsigned& kB, int lane) {
#pragma unroll
    for (int k = 2; k <= 128; k <<= 1)
#pragma unroll
        for (int j = k >> 1; j > 0; j >>= 1) {
            if (j == 64) { const unsigned lo = min(kA, kB), hi = max(kA, kB); kA = lo; kB = hi; }
            else {
                const unsigned pA = (unsigned)__shfl_xor((int)kA, j), pB = (unsigned)__shfl_xor((int)kB, j);
                const bool lower = (lane & j) == 0, upA = (lane & k) == 0, upB = ((lane + 64) & k) == 0;
                kA = (lower == upA) ? min(kA, pA) : max(kA, pA);
                kB = (lower == upB) ? min(kB, pB) : max(kB, pB);
            }
        }
}
constexpr int PE_NS = 32, PE_SLICE = PE_NE / PE_NS;
constexpr int PE_PACE = 64;
typedef int v4i __attribute__((ext_vector_type(4)));
constexpr int PE_D = 6;
constexpr int PE2_KEYS = 0, PE2_G = 16384, PE2_A = 32768, PE2_ORD = 49152, PE2_CT = 65536, PE2_RING = 73728, PE2_END = PE2_RING + 8 * 5 * 2048;
static_assert(PE2_G == PE_OFF_G && PE2_KEYS == PE_OFF_IDX && PE2_END <= 160 * 1024 - 1024, "peer LDS map");
#define PE_WAITV(n) asm volatile("s_waitcnt vmcnt(" #n ")" ::: "memory")
template <int LAYER>
__device__ __forceinline__ void peer_gather4(const Frame& F, const In& I, int t0w, int tl0, int dry) {
    const int lane = F.lane, wv = F.wave;
    const float* gain = I.g_ffn + LAYER * 2048;
    const unsigned char* ut = F.ws + WS_PU + (size_t)LAYER * PE_NE * D + lane * 16;
    const unsigned char* vt = F.ws + WS_PV + (size_t)LAYER * PE_NE * D + lane * 16;
    const float* su = (const float*)(F.ws + WS_PSU) + LAYER * PE_NE; const float* sv = (const float*)(F.ws + WS_PSV) + LAYER * PE_NE;
    LAS unsigned* keys = (LAS unsigned*)(F.lds + RING_OFF + PE2_KEYS) + tl0 * PE_SEL;
    LAS float* lg = (LAS float*)(F.lds + RING_OFF + PE2_G) + tl0 * PE_SEL;
    LAS float* la = (LAS float*)(F.lds + RING_OFF + PE2_A) + tl0 * PE_SEL;
    LAS unsigned* ord = (LAS unsigned*)(F.lds + RING_OFF + PE2_ORD) + wv * 512;
    LAS int* ct = (LAS int*)(F.lds + RING_OFF + PE2_CT) + wv * 256;
    LAS unsigned char* ring = F.lds + RING_OFF + PE2_RING + wv * (5 * 2048);
    LAS unsigned char* ring5 = F.lds + RING_OFF + PE2_KEYS + wv * 2048;
#define PE_SLOT(sl) (((sl) < 5) ? ring + (sl) * 2048 : ring5)
    unsigned sA[4], sB[4];
#pragma unroll
    for (int tk = 0; tk < 4; ++tk) {
        sA[tk] = (keys[tk * PE_SEL + lane] << 7) | (unsigned)lane; sB[tk] = (keys[tk * PE_SEL + 64 + lane] << 7) | (unsigned)(64 + lane);
        sort128(sA[tk], sB[tk], lane);
    }
    if (lane < 4) ct[lane * 36] = 0;
#pragma unroll 1
    for (int s = 0; s < PE_NS; ++s) { const unsigned limit = (unsigned)((s + 1) * PE_SLICE) << 7;
#pragma unroll
        for (int tk = 0; tk < 4; ++tk) { const int c = __builtin_popcountll(__ballot(sA[tk] < limit)) + __builtin_popcountll(__ballot(sB[tk] < limit)); if (lane == 0) ct[tk * 36 + s + 1] = c; } }
#pragma unroll
    for (int tk = 0; tk < 4; ++tk) {
#pragma unroll
        for (int hb = 0; hb < 2; ++hb) { const unsigned key = hb ? sB[tk] : sA[tk]; const int pos = lane + 64 * hb, e = (int)(key >> 7), sl = e / PE_SLICE; int rank = pos;
#pragma unroll
            for (int t2 = 0; t2 < 4; ++t2) if (t2 != tk) rank += ct[t2 * 36 + sl + (t2 < tk ? 1 : 0)];
            ord[rank] = ((unsigned)e << 9) | (unsigned)(tk << 7) | (unsigned)pos; }
    }
    float glA[4], glB[4];
#pragma unroll
    for (int tk = 0; tk < 4; ++tk) { glA[tk] = lg[tk * PE_SEL + (sA[tk] & 127u)]; glB[tk] = lg[tk * PE_SEL + (sB[tk] & 127u)]; }
    const int bj = lane & 3, bb = lane >> 2;
    int hq[8][4]; float shl = 1.f;
    {
        LAS unsigned char* himg = ring;
#pragma unroll
        for (int tk = 0; tk < 4; ++tk) {
            const float* xrow = F.out + (size_t)(t0w + tk) * D + 4 * lane; const float* grow = gain + 4 * lane;
            const float rs = __builtin_amdgcn_rsqf(pg8::slot_sum((const float*)(F.ws + WS_SSQ) + SSQ_XS + (size_t)(t0w + tk) * 32, 32) * (1.f / 2048.f) + RMS_EPS);
            f32x4 hv[8]; float mx = 0.f;
#pragma unroll
            for (int q = 0; q < 8; ++q) { const f32x4 xv = *(const f32x4*)(xrow + 256 * q), gv = *(const f32x4*)(grow + 256 * q);
                const f32x4 t = (f32x4){xv.x * rs * gv.x, xv.y * rs * gv.y, xv.z * rs * gv.z, xv.w * rs * gv.w}; hv[q] = t;
                mx = fmaxf(mx, fmaxf(fmaxf(fabsf(t.x), fabsf(t.y)), fmaxf(fabsf(t.z), fabsf(t.w)))); }
#pragma unroll
            for (int o = 1; o < 64; o <<= 1) mx = fmaxf(mx, __shfl_xor(mx, o));
            const float inv = mx > 0.f ? 127.f / mx : 1.f; if (bj == tk) shl = mx > 0.f ? mx * (1.f / 127.f) : 1.f;
            unsigned dq[8];
#pragma unroll
            for (int q = 0; q < 8; ++q) { const f32x4 t = hv[q] * inv; dq[q] = (unsigned)((__float2int_rn(t.x) & 255) | ((__float2int_rn(t.y) & 255) << 8) | ((__float2int_rn(t.z) & 255) << 16) | (__float2int_rn(t.w) << 24)); }
            *(LAS v4u*)(himg + tk * 2048 + 16 * lane) = (v4u){dq[0], dq[1], dq[2], dq[3]}; *(LAS v4u*)(himg + tk * 2048 + 1024 + 16 * lane) = (v4u){dq[4], dq[5], dq[6], dq[7]};
            asm volatile("" ::: "memory");
        }
        asm volatile("s_waitcnt lgkmcnt(0)" ::: "memory");
#pragma unroll
        for (int s8 = 0; s8 < 8; ++s8) { const v4u t = *(const LAS v4u*)(himg + bj * 2048 + 256 * s8 + 16 * bb); hq[s8][0] = (int)t.x; hq[s8][1] = (int)t.y; hq[s8][2] = (int)t.z; hq[s8][3] = (int)t.w; }
    }
    asm volatile("s_waitcnt vmcnt(0) lgkmcnt(0)" ::: "memory");
    static_assert(PE_D == 6, "the counted wait below is vmcnt(2 * (PE_D - 1))");
#define PE_EMASK
#define PE_ISSUE(tab, code, slot) do { const unsigned char* _g = (tab) + ((size_t)((code) >> 9) << 11); \
        LAS unsigned char* _d = PE_SLOT(slot); \
        __builtin_amdgcn_global_load_lds((const unsigned*)_g, (LAS unsigned*)_d, 16, 0, 0); \
        __builtin_amdgcn_global_load_lds((const unsigned*)(_g + 1024), (LAS unsigned*)(_d + 1024), 16, 0, 0); } while (0)
#define PE_ROW_HEAD(tab) \
                    const int i6 = r & 63, ia = i6 + PE_D; const unsigned codea = (unsigned)__builtin_amdgcn_readlane((int)((ia < 64) ? oc : on), ia & 63); \
                    PE_WAITV(10); \
                    v4u w[2]; { const LAS unsigned char* _s = PE_SLOT(slot); w[0] = *(const LAS v4u*)(_s + lane * 16); w[1] = *(const LAS v4u*)(_s + 1024 + lane * 16); } \
                    asm volatile("s_waitcnt lgkmcnt(0)" ::: "memory"); \
                    PE_ISSUE(tab, codea, slot);
#define PE_ROW_TAIL() \
                    slot = (slot + 1 == PE_D) ? 0 : slot + 1; ++r; \
                    if ((r & 63) == 0) { const int nb = (r >> 6) + 1; oc = on; on = ord[((nb < 8) ? nb : 7) * 64 + lane]; asm volatile("s_waitcnt lgkmcnt(0)" ::: "memory"); }
    LAS _Float16* lah = (LAS _Float16*)(F.lds + RING_OFF + PE2_A + wv * 2048);
    LAS float* lav = lg;
    {
        LAS unsigned char* const sl5 = F.lds + RING_OFF + PE2_KEYS + wv * 2048;
        LAS unsigned char* const sl6 = F.lds + RING_OFF + PE2_G + wv * 2048;
        LAS unsigned char* const sl7lo = F.lds + RING_OFF + PE2_A + wv * 2048 + 1024;
        LAS unsigned char* const sl7hi = F.lds + RING_OFF + PE2_CT + wv * 1024;
#define U_LO(k) ((k) < 5 ? ring + (k) * 2048 : (k) == 5 ? sl5 : (k) == 6 ? sl6 : sl7lo)
#define U_HI(k) ((k) < 7 ? U_LO(k) + 1024 : sl7hi)
        const LAS unsigned char* ad[2][8];
#pragma unroll
        for (int p = 0; p < 2; ++p) {
            const LAS unsigned char* lo = bj == 0 ? U_LO(4 * p) : bj == 1 ? U_LO(4 * p + 1) : bj == 2 ? U_LO(4 * p + 2) : U_LO(4 * p + 3);
            const LAS unsigned char* hi = bj == 0 ? U_HI(4 * p) : bj == 1 ? U_HI(4 * p + 1) : bj == 2 ? U_HI(4 * p + 2) : U_HI(4 * p + 3);
#pragma unroll
            for (int s8 = 0; s8 < 8; ++s8) ad[p][s8] = (s8 < 4 ? lo : hi) + 16 * ((16 * (s8 & 3) + bb - 4 * bj) & 63);
        }
        const unsigned char* utr[4];
#pragma unroll
        for (int i = 0; i < 4; ++i) utr[i] = F.ws + WS_PU + (size_t)LAYER * PE_NE * D + 16 * ((lane + 4 * i) & 63);
#define U_ISSUE(i, k, code) do { const unsigned char* _g = utr[i] + ((size_t)(((code) >> 9) PE_EMASK) << 11); \
        __builtin_amdgcn_global_load_lds((const unsigned*)_g, (LAS unsigned*)U_LO(k), 16, 0, 0); \
        __builtin_amdgcn_global_load_lds((const unsigned*)(_g + 1024), (LAS unsigned*)U_HI(k), 16, 0, 0); } while (0)
        { const v4u c0 = *(const LAS v4u*)(ord), c1 = *(const LAS v4u*)(ord + 4);
          asm volatile("s_waitcnt lgkmcnt(0)" ::: "memory");
#pragma unroll
          for (int i = 0; i < 4; ++i) U_ISSUE(i, i, (unsigned)__builtin_amdgcn_readfirstlane((int)c0[i]));
#pragma unroll
          for (int i = 0; i < 4; ++i) U_ISSUE(i, 4 + i, (unsigned)__builtin_amdgcn_readfirstlane((int)c1[i])); }
#pragma unroll 1
        for (int g2 = 0; g2 < 64; ++g2) {
#pragma unroll
            for (int p = 0; p < 2; ++p) {
                const int r = 8 * g2 + 4 * p, nx = (r + 8 < 508) ? r + 8 : 508;
                const v4u cn = *(const LAS v4u*)(ord + nx); const unsigned cm = ord[r + (lane >> 4)];
                PE_WAITV(8);
                v4u a[8];
#pragma unroll
                for (int s8 = 0; s8 < 8; ++s8) a[s8] = *(const LAS v4u*)ad[p][s8];
                asm volatile("s_waitcnt lgkmcnt(0)" ::: "memory");
#pragma unroll
                for (int i = 0; i < 4; ++i) U_ISSUE(i, 4 * p + i, (unsigned)__builtin_amdgcn_readfirstlane((int)cn[i]));
                v4i d0 = (v4i){0, 0, 0, 0}, d1 = (v4i){0, 0, 0, 0};
#pragma unroll
                for (int s8 = 0; s8 < 8; ++s8)
#pragma unroll
                    for (int c = 0; c < 4; ++c) { if (c & 1) d1 = __builtin_amdgcn_mfma_i32_4x4x4i8((int)a[s8][c], hq[s8][c], d1, 0, 0, 0); else d0 = __builtin_amdgcn_mfma_i32_4x4x4i8((int)a[s8][c], hq[s8][c], d0, 0, 0, 0); }
                unsigned e0 = (unsigned)(d0[0] + d1[0]), e1 = (unsigned)(d0[1] + d1[1]), e2 = (unsigned)(d0[2] + d1[2]), e3 = (unsigned)(d0[3] + d1[3]);
                { const auto t = __builtin_amdgcn_permlane32_swap(e0, e2, false, false); e0 = t[0] + t[1]; }
                { const auto t = __builtin_amdgcn_permlane32_swap(e1, e3, false, false); e1 = t[0] + t[1]; }
                { const auto t = __builtin_amdgcn_permlane16_swap(e0, e1, false, false); e0 = t[0] + t[1]; }
                e0 += (unsigned)__builtin_amdgcn_update_dpp(0, (int)e0, 0x124, 0xf, 0xf, true);
                e0 += (unsigned)__builtin_amdgcn_update_dpp(0, (int)e0, 0x128, 0xf, 0xf, true);
                const float val = (float)(int)e0 * shl * (1.f / 256.f);
                if ((lane & 12) == 0 && ((cm >> 7) & 3u) == (unsigned)bj) lah[cm & 511u] = (_Float16)val;
            }
        }
        asm volatile("s_waitcnt vmcnt(0) lgkmcnt(0)" ::: "memory");
#undef U_ISSUE
#undef U_LO
#undef U_HI
    }
#pragma unroll
    for (int tk = 0; tk < 4; ++tk) {
#pragma unroll
        for (int hb = 0; hb < 2; ++hb) { const unsigned key = hb ? sB[tk] : sA[tk]; const int pos = lane + 64 * hb, e = (int)(key >> 7);
            const float av = (float)lah[tk * PE_SEL + pos] * 256.f * su[e]; lav[tk * PE_SEL + pos] = gelu_erf(av) * (hb ? glB[tk] : glA[tk]) * sv[e]; }
    }
    asm volatile("s_waitcnt vmcnt(0) lgkmcnt(0)" ::: "memory");
    f32x2 acc[4][16];
#pragma unroll
    for (int tk = 0; tk < 4; ++tk)
#pragma unroll
        for (int i = 0; i < 16; ++i) acc[tk][i] = (f32x2){0.f, 0.f};
    {
        unsigned oc = ord[lane], on = ord[64 + lane];
        asm volatile("s_waitcnt lgkmcnt(0)" ::: "memory");
#pragma unroll
        for (int i = 0; i < PE_D; ++i) PE_ISSUE(vt, (unsigned)__builtin_amdgcn_readlane((int)oc, i), i);
        int slot = 0, r = 0; int ptr[4] = {0, 0, 0, 0};
#pragma unroll 1
        for (int s = 0; s < PE_NS; ++s) {
            const unsigned limit = (unsigned)((s + 1) * PE_SLICE) << 7;
#pragma unroll
            for (int tk = 0; tk < 4; ++tk) {
                const int end = __builtin_popcountll(__ballot(sA[tk] < limit)) + __builtin_popcountll(__ballot(sB[tk] < limit));
#pragma unroll 1
                for (int pos = ptr[tk]; pos < end; ++pos) {
                    const float a = lav[tk * PE_SEL + pos];
                    PE_ROW_HEAD(vt)
#pragma unroll
                    for (int j = 0; j < 2; ++j)
#pragma unroll
                        for (int c = 0; c < 4; ++c) { const unsigned wd = w[j][c];
                            acc[tk][8 * j + 2 * c] += __builtin_amdgcn_cvt_pk_f32_fp8((int)wd, false) * a; acc[tk][8 * j + 2 * c + 1] += __builtin_amdgcn_cvt_pk_f32_fp8((int)wd, true) * a; }
                    PE_ROW_TAIL()
                }
                ptr[tk] = end;
            }
            if ((s & (PE_PACE - 1)) == PE_PACE - 1) __builtin_amdgcn_s_barrier();
        }
        asm volatile("s_waitcnt vmcnt(0) lgkmcnt(0)" ::: "memory");
    }
#undef PE_ROW_HEAD
#undef PE_ROW_TAIL
#undef PE_SLOT
#undef PE_ISSUE
    asm volatile("" ::: "memory");
    float sqv[4] = {0.f, 0.f, 0.f, 0.f};
#pragma unroll
    for (int tk = 0; tk < 4; ++tk) {
        const int tok = t0w + tk;
        float* xrow = F.out + (size_t)tok * D;
        float* xdst = dry ? (float*)(F.ws + WS_Z) + (size_t)tok * D : xrow;
        float sq = 0.f;
#pragma unroll
        for (int j = 0; j < 2; ++j) {
            unsigned pk[8];
#pragma unroll
            for (int q = 0; q < 4; ++q) { const int d = j * 1024 + lane * 16 + 4 * q; f32x4 xv = *(const f32x4*)(xrow + d);
                xv.x += acc[tk][8 * j + 2 * q].x; xv.y += acc[tk][8 * j + 2 * q].y; xv.z += acc[tk][8 * j + 2 * q + 1].x; xv.w += acc[tk][8 * j + 2 * q + 1].y;
                *(f32x4*)(xdst + d) = xv;
                if constexpr (LAYER == 0) { sq += (xv.x * xv.x + xv.y * xv.y) + (xv.z * xv.z + xv.w * xv.w); pk[2 * q] = pk2(xv.x, xv.y); pk[2 * q + 1] = pk2(xv.z, xv.w);
                    acc[tk][8 * j + 2 * q] = (f32x2){xv.x, xv.y}; acc[tk][8 * j + 2 * q + 1] = (f32x2){xv.z, xv.w}; } }
            if constexpr (LAYER == 0) { unsigned char* xb = F.ws + WS_XB + ((size_t)tok * D + j * 1024 + lane * 16) * 2;
                *(v4u*)xb = (v4u){pk[0], pk[1], pk[2], pk[3]}; *(v4u*)(xb + 16) = (v4u){pk[4], pk[5], pk[6], pk[7]}; }
            asm volatile("" ::: "memory");
        }
        if constexpr (LAYER == 0) { sq = wave_sum(sq); sqv[tk] = sq; if (lane == 0) ((float*)(F.ws + WS_SSQ))[SSQ_X2 + tok] = sq; }
    }
    if constexpr (LAYER == 0) {
        const float* wf = (const float*)(F.ws + WS_WF) + lane * 16;
        float mine = 0.f;
#pragma unroll 1
        for (int jf = 0; jf < 16; ++jf) {
            f32x2 sacc[4] = {{0.f, 0.f}, {0.f, 0.f}, {0.f, 0.f}, {0.f, 0.f}};
#pragma unroll
            for (int j = 0; j < 2; ++j)
#pragma unroll
                for (int q = 0; q < 4; ++q) { const f32x4 wv = *(const f32x4*)(wf + jf * 2048 + j * 1024 + 4 * q);
#pragma unroll
                    for (int tk = 0; tk < 4; ++tk) { sacc[tk] += acc[tk][8 * j + 2 * q] * (f32x2){wv.x, wv.y}; sacc[tk] += acc[tk][8 * j + 2 * q + 1] * (f32x2){wv.z, wv.w}; } }
            float s0 = sacc[0].x + sacc[0].y, s1 = sacc[1].x + sacc[1].y, s2 = sacc[2].x + sacc[2].y, s3 = sacc[3].x + sacc[3].y;
            { const auto t = __builtin_amdgcn_permlane32_swap(__float_as_uint(s0), __float_as_uint(s2), false, false); s0 = __uint_as_float(t[0]) + __uint_as_float(t[1]); }
            { const auto t = __builtin_amdgcn_permlane32_swap(__float_as_uint(s1), __float_as_uint(s3), false, false); s1 = __uint_as_float(t[0]) + __uint_as_float(t[1]); }
            { const auto t = __builtin_amdgcn_permlane16_swap(__float_as_uint(s0), __float_as_uint(s1), false, false); s0 = __uint_as_float(t[0]) + __uint_as_float(t[1]); }
            s0 += __int_as_float(__builtin_amdgcn_update_dpp(0, __float_as_int(s0), 0x128, 0xf, 0xf, true));
            s0 += __int_as_float(__builtin_amdgcn_update_dpp(0, __float_as_int(s0), 0x124, 0xf, 0xf, true));
            s0 += __int_as_float(__builtin_amdgcn_update_dpp(0, __float_as_int(s0), 0x122, 0xf, 0xf, true));
            s0 += __int_as_float(__builtin_amdgcn_update_dpp(0, __float_as_int(s0), 0x121, 0xf, 0xf, true));
            if ((lane & 15) == jf) mine = s0;
        }
        { const int q = lane >> 4; const float sqq = q == 0 ? sqv[0] : q == 1 ? sqv[1] : q == 2 ? sqv[2] : sqv[3];
          const float rs2 = __builtin_amdgcn_rsqf(sqq * (1.f / 2048.f) + RMS_EPS);
          const float zf = mine * rs2 + I.fox_b_f[lane & 15]; const float ls = fminf(zf, 0.f) - log1pf(__expf(-fabsf(zf)));
          ((float*)(F.ws + WS_LF))[(size_t)(lane & 15) * T + (t0w + q)] = ls; }
    }
}
template <int LAYER>
__device__ __forceinline__ void p_peer(const Frame& F, const In& I, int dry) {
    for (int tb = F.vcu; tb < T / 32; tb += F.G) {
        const int t0 = tb * 32;
        Frame Fo = F; asm volatile("" : "+v"(Fo.lane), "+v"(Fo.tid));
        peer_topk(Fo, LAYER, t0);
        __syncthreads();
#ifdef TOPK_PROBE
        peer_topk(Fo, LAYER, t0);
        __syncthreads();
#endif
        asm volatile("" : "+v"(Fo.lane));
        peer_gather4<LAYER>(Fo, I, t0 + F.wave * 4, F.wave * 4, dry);
        __syncthreads();
    }
}
#ifdef SELFCHECK
constexpr int DG_CHUNK = 8192, DG_MAXCH = 8192, DG_NBUF = 3, DG_NPASS = 4;
constexpr size_t WS_DG = WS_END;
constexpr size_t DG_BYTES = (size_t)DG_NPASS * N_PHASES * DG_NBUF * DG_MAXCH * 8;
__global__ void __launch_bounds__(256) dg_kernel(const void* buf, int is_f32, size_t nelem, float2* dig) {
    const int c = blockIdx.x; const size_t e0 = (size_t)c * DG_CHUNK; float s = 0.f, a = 0.f;
    for (int i = threadIdx.x; i < DG_CHUNK; i += 256) { const size_t e = e0 + i; if (e < nelem) { const float v = is_f32 ? ((const float*)buf)[e] : __uint_as_float((unsigned)((const unsigned short*)buf)[e] << 16);
        const float w = ((i * 2654435761u) >> 13) & 1 ? 1.f : -1.f; s += w * v; a += fabsf(v); } }
    __shared__ float ss[256], sa[256]; ss[threadIdx.x] = s; sa[threadIdx.x] = a; __syncthreads();
    for (int o = 128; o > 0; o >>= 1) { if ((int)threadIdx.x < o) { ss[threadIdx.x] += ss[threadIdx.x + o]; sa[threadIdx.x] += sa[threadIdx.x + o]; } __syncthreads(); }
    if (threadIdx.x == 0) dig[c] = make_float2(ss[0], sa[0]);
}
__global__ void dg_compare(const float2* dig, unsigned* flag  ) {
    const int p = blockIdx.x;
    for (int q = 1; q < DG_NPASS; ++q)
        for (int i = threadIdx.x; i < DG_NBUF * DG_MAXCH; i += blockDim.x) {
            const float2 a = dig[((size_t)0 * N_PHASES + p) * DG_NBUF * DG_MAXCH + i], b = dig[((size_t)q * N_PHASES + p) * DG_NBUF * DG_MAXCH + i];
            if (!(fabsf(a.x - b.x) <= 1e-5f * a.y + 0.02f)) atomicAdd(flag + p, 1u);
        }
}
__global__ void dg_poison(const unsigned* flag, float* out) {
    if (threadIdx.x == 0 && blockIdx.x == 0) { for (int p = 0; p < N_PHASES; ++p) if (flag[p]) { out[0] += 1000.f * (float)(1 << p); break; } }
}
struct DgBuf { size_t off; int is_f32; size_t nelem; };
#endif
#ifdef STAGECHECK
constexpr size_t WS_CK = WS_END;
constexpr int CK_NS = 32;
constexpr size_t WS_CK_ROWS = WS_CK + 4096, WS_CK_TMP = WS_CK_ROWS + (size_t)CK_NS * 2048 * 4;
__device__ __forceinline__ unsigned ck_hash(unsigned a) { a ^= a >> 16; a *= 0x7feb352du; a ^= a >> 15; a *= 0x846ca68bu; a ^= a >> 16; return a; }
__device__ __forceinline__ bool ck_bad(float ref, float got) { return !(fabsf(ref - got) <= 0.03f * fabsf(ref) + 0.03f); }
__device__ __forceinline__ int ck_slot(int t) { const int c = t & 15; return (t & ~15) + (c < 4 ? c : c < 8 ? c + 4 : c < 12 ? c - 4 : c); }
__device__ __forceinline__ void ck_flag(unsigned* flags, int code, bool bad) { if (__any(bad)) { if ((threadIdx.x & 63) == 0) atomicAdd(flags + code, 1u); } }

__global__ void __launch_bounds__(64) ck_save_rows(const float* out, float* rows) {
    const int s = blockIdx.x, t = ck_hash(1000 + s) % T; for (int i = threadIdx.x; i < 2048; i += 64) rows[s * 2048 + i] = out[(size_t)t * 2048 + i];
}
__global__ void __launch_bounds__(64) ck_kernel(int stage, In I, unsigned char* ws, const float* out, unsigned* flags) {
    const int s = blockIdx.x, lane = threadIdx.x;
    __shared__ float sh[4096];
    const bf16* z0 = (const bf16*)(ws + WS_Z0); const float* ssq = (const float*)(ws + WS_SSQ);
    if (stage == 1) {
        const int t = ck_hash(s) % T, n = ck_hash(77 + s) % MLA_IN; float a = 0.f, d = 0.f;
        for (int k = lane; k < 2048; k += 64) { const float x = I.x[(size_t)t * 2048 + k]; a += x * x; d += x * I.g_mix[k] * I.mla_w_in[(size_t)k * MLA_IN + n]; }
        a = wave_sum(a); d = wave_sum(d); const float ref = d * rsqrtf(a / 2048.f + 1e-6f);
        ck_flag(flags, 1, ck_bad(ref, bf2f(z0[(size_t)t * MLA_INP + n])));
    } else if (stage == 2) {
        const int t = ck_hash(s) % T, n = ck_hash(78 + s) % 3072, h = ck_hash(79 + s) % 16, dd = ck_hash(80 + s) % 128; float a = 0.f, b = 0.f, c = 0.f, q = 0.f;
        for (int k = lane; k < 512; k += 64) { const float zq = bf2f(z0[(size_t)t * MLA_INP + k]), zk = bf2f(z0[(size_t)t * MLA_INP + 512 + k]);
            a += zq * I.mla_g_qa[k] * I.mla_w_qb[(size_t)k * 3072 + n]; b += zk * I.mla_g_kva[k] * I.mla_w_kvb[(size_t)k * 4096 + h * 256 + dd]; c += zk * I.mla_g_kva[k] * I.mla_w_kvb[(size_t)k * 4096 + h * 256 + 128 + dd]; q += zk * zk; }
        a = wave_sum(a); b = wave_sum(b); c = wave_sum(c); q = wave_sum(q); c *= rsqrtf(q / 512.f + 1e-6f);
        const bf16* Q = (const bf16*)(ws + WS_Q); const bf16* KN = (const bf16*)(ws + WS_KN); const bf16* VT = (const bf16*)(ws + WS_VT);
        ck_flag(flags, 2, ck_bad(a, bf2f(Q[(size_t)t * 3072 + n])));
        ck_flag(flags, 20, ck_bad(b, bf2f(KN[(size_t)t * 2048 + h * 128 + dd])));
        ck_flag(flags, 21, ck_bad(c, bf2f(VT[(size_t)(h * 128 + dd) * T + ck_slot(t)])));
    } else if (stage == 3) {
        const int t = ck_hash(s) % T, h = ck_hash(81 + s) % 16; float sq = 0.f, skv = 0.f;
        for (int k = lane; k < 512; k += 64) { const float zq = bf2f(z0[(size_t)t * MLA_INP + k]), zk = bf2f(z0[(size_t)t * MLA_INP + 512 + k]); sq += zq * zq; skv += zk * zk; }
        const float rcq = rsqrtf(wave_sum(sq) / 512.f + 1e-6f), rckv = rsqrtf(wave_sum(skv) / 512.f + 1e-6f);
        float qv[3], kv[3];
#pragma unroll
        for (int j = 0; j < 3; ++j) { const int d = lane + 64 * j; float a = 0.f, b = 0.f;
            for (int k = 0; k < 512; ++k) { a += bf2f(z0[(size_t)t * MLA_INP + k]) * I.mla_g_qa[k] * I.mla_w_qb[(size_t)k * 3072 + h * 192 + d];
                if (d < 128) b += bf2f(z0[(size_t)t * MLA_INP + 512 + k]) * I.mla_g_kva[k] * I.mla_w_kvb[(size_t)k * 4096 + h * 256 + d]; }
            qv[j] = a * rcq; kv[j] = (d < 128) ? b * rckv : bf2f(z0[(size_t)t * MLA_INP + 1024 + (d - 128)]); }
        const float rq = rsqrtf(wave_sum(qv[0] * qv[0] + qv[1] * qv[1] + qv[2] * qv[2]) / 192.f + 1e-6f), rk = rsqrtf(wave_sum(kv[0] * kv[0] + kv[1] * kv[1] + kv[2] * kv[2]) / 192.f + 1e-6f);
#pragma unroll
        for (int j = 0; j < 3; ++j) { qv[j] *= rq * I.mla_g_q[lane + 64 * j]; kv[j] *= rk * I.mla_g_k[lane + 64 * j]; }
        const float inv_freq = powf(10000.0f, -(float)(2 * (lane & 31)) / 64.0f), ang = (float)I.pos[t] * inv_freq, cs = cosf(ang), sn = sinf(ang);
        const float pq = __shfl_xor(qv[2], 32), pk = __shfl_xor(kv[2], 32);
        qv[2] = (lane < 32) ? qv[2] * cs - pq * sn : qv[2] * cs + pq * sn; kv[2] = (lane < 32) ? kv[2] * cs - pk * sn : kv[2] * cs + pk * sn;
        const float QS = 0.07216878364870322f * LOG2E; const bf16* Q = (const bf16*)(ws + WS_Q); const bf16* KM = (const bf16*)(ws + WS_KM); bool bad = false, badk = false;
#pragma unroll
        for (int j = 0; j < 3; ++j) { bad |= ck_bad(qv[j] * QS * 4.f, 4.f * bf2f(Q[(size_t)t * 3072 + h * 192 + lane + 64 * j])); badk |= ck_bad(kv[j], bf2f(KM[(size_t)t * 3072 + h * 192 + lane + 64 * j])); }
        ck_flag(flags, 3, bad); ck_flag(flags, 22, badk);
    } else if (stage == 4 || stage == 10) {
        const bool fox = stage == 10; const int t = ck_hash(s) % T, h = ck_hash(82 + s) % 16, b = t / SEQ, tq = t % SEQ, DKK = fox ? 128 : 192;
        const bf16* Q = fox ? (const bf16*)(ws + WS_Z) : (const bf16*)(ws + WS_Q); const bf16* K = fox ? (const bf16*)(ws + WS_Z) + 2048 : (const bf16*)(ws + WS_KM); const int pitch = fox ? FOX_ZN : 3072;
        const bf16* VT = (const bf16*)(ws + WS_VT); const float* lf = (const float*)(ws + WS_LF);
        const int nk = fox ? tq + 1 : 64 * (tq / 64 + 1);
        if (fox) { if (lane == 0) { float c = 0.f; for (int i = 0; i < nk; ++i) { c += lf[(size_t)(b * SEQ + i) * 16 + h]; sh[2048 + i] = c; } } __syncthreads(); }
        float mx = -1e30f;
        for (int sk = lane; sk < nk; sk += 64) { float d = 0.f; for (int e = 0; e < DKK; ++e) d += bf2f(Q[(size_t)t * pitch + h * DKK + e]) * bf2f(K[(size_t)(b * SEQ + sk) * pitch + h * DKK + e]);
            if (fox) d += (sh[2048 + tq] - sh[2048 + sk]) * LOG2E; sh[sk] = d; mx = fmaxf(mx, d); }
        for (int o = 1; o < 64; o <<= 1) mx = fmaxf(mx, __shfl_xor(mx, o));
        __syncthreads();
        float l = 0.f; for (int sk = lane; sk < nk; sk += 64) { const float p = exp2f(sh[sk] - mx); sh[sk] = p; l += p; } l = wave_sum(l);
        __syncthreads();
        bool bad = false;
        for (int j = 0; j < 2; ++j) { const int dv = lane + 64 * j; float o = 0.f; for (int sk = 0; sk < nk; ++sk) o += sh[sk] * bf2f(VT[(size_t)(h * 128 + dv) * T + ck_slot(b * SEQ + sk)]); o /= l;
            if (fox) o *= 1.f / (1.f + expf(-bf2f(((const bf16*)(ws + WS_Z))[(size_t)t * FOX_ZN + 4096 + h * 128 + dv])));
            bad |= ck_bad(o * 8.f, 8.f * bf2f(((const bf16*)(ws + WS_O))[(size_t)t * 2048 + h * 128 + dv])); }
        ck_flag(flags, stage, bad);
    } else if (stage == 5 || stage == 11) {
        const int t = (stage == 5) ? ck_hash(s) % T : ck_hash(1000 + s) % T, n = ck_hash(83 + s) % 2048; const float* wo = (stage == 5) ? I.mla_w_o : I.fox_w_o; float d = 0.f;
        for (int k = lane; k < 2048; k += 64) d += bf2f(((const bf16*)(ws + WS_O))[(size_t)t * 2048 + k]) * wo[(size_t)k * 2048 + n];
        d = wave_sum(d); const float xo = (stage == 5) ? I.x[(size_t)t * 2048 + n] : ((const float*)(ws + WS_CK_ROWS))[s * 2048 + n];
        ck_flag(flags, stage, ck_bad(xo + d, out[(size_t)t * 2048 + n]));
    } else if (stage == 6 || stage == 12) {
        const int L = stage == 12, t = ck_hash(s) % T, n = ck_hash(84 + s) % 2048; float d = 0.f;
        for (int k = lane; k < 2048; k += 64) d += bf2f(((const bf16*)(ws + WS_XB))[(size_t)t * 2048 + k]) * I.g_ffn[L * 2048 + k] * I.pe_wq[(size_t)L * 2048 * 2048 + (size_t)k * 2048 + n];
        d = wave_sum(d); ck_flag(flags, stage, ck_bad(d, bf2f(((const bf16*)(ws + WS_QP))[(size_t)t * 2048 + n])));
    } else if (stage == 7 || stage == 13) {
        const int L = stage == 13, t = ck_hash(1000 + s) % T; const float* xo = (const float*)(ws + WS_CK_ROWS) + s * 2048; float* tmp = (float*)(ws + WS_CK_TMP) + (size_t)s * 8192;
        float a = 0.f; for (int k = lane; k < 2048; k += 64) a += xo[k] * xo[k]; const float r = rsqrtf(wave_sum(a) / 2048.f + 1e-6f);
        for (int k = lane; k < 2048; k += 64) tmp[k] = xo[k] * r * I.g_ffn[L * 2048 + k];
        __syncthreads();
        for (int n = lane; n < 2048; n += 64) { float d = 0.f; for (int k = 0; k < 2048; ++k) d += tmp[k] * I.pe_wq[(size_t)L * 2048 * 2048 + (size_t)k * 2048 + n]; tmp[2048 + n] = d; }
        __syncthreads();
        for (int hq = 0; hq < 8; ++hq) {
            for (int c = 0; c < 2; ++c) for (int n = lane; n < 128; n += 64) { float d = 0.f; for (int e = 0; e < 128; ++e) d += tmp[2048 + hq * 256 + c * 128 + e] * I.pe_sk[((size_t)(L * 2 + c) * 128 + n) * 128 + e]; sh[c * 128 + n] = d; }
            __syncthreads();
            if (lane == 0) {
                for (int c = 0; c < 2; ++c) for (int k = 0; k < 16; ++k) { int bi = 0; float bv = -1e30f; for (int n = 0; n < 128; ++n) if (sh[c * 128 + n] > bv) { bv = sh[c * 128 + n]; bi = n; } sh[256 + c * 16 + k] = bv; sh[288 + c * 16 + k] = (float)bi; sh[c * 128 + bi] = -1e30f; }
                for (int i = 0; i < 16; ++i) for (int j = 0; j < 16; ++j) sh[512 + i * 16 + j] = sh[256 + i] + sh[272 + j];
                float b0 = 0.f, sum = 0.f;
                for (int k = 0; k < 16; ++k) { int bi = 0; float bv = -1e30f; for (int n = 0; n < 256; ++n) if (sh[512 + n] > bv) { bv = sh[512 + n]; bi = n; } if (k == 0) b0 = bv;
                    const float w = expf(bv - b0); sum += w; tmp[4096 + hq * 32 + k] = sh[288 + (bi >> 4)] * 128.f + sh[304 + (bi & 15)]; tmp[4096 + hq * 32 + 16 + k] = w; sh[512 + bi] = -1e30f; }
                for (int k = 0; k < 16; ++k) tmp[4096 + hq * 32 + 16 + k] /= sum;
            }
            __syncthreads();
        }
        for (int k = 0; k < 128; ++k) { const int e = (int)tmp[4096 + (k >> 4) * 32 + (k & 15)]; float d = 0.f; for (int i = lane; i < 2048; i += 64) d += I.pe_u[((size_t)L * PE_NE + e) * 2048 + i] * tmp[i]; d = wave_sum(d);
            if (lane == 0) tmp[6144 + k] = 0.5f * d * (1.f + erff(d * 0.7071067811865476f)) * tmp[4096 + (k >> 4) * 32 + 16 + (k & 15)]; }
        __syncthreads();
        { const int* di = (const int*)(ws + WS_END + 8 * MiB) + (size_t)t * 128; const float* dg = (const float*)(ws + WS_END + 12 * MiB) + (size_t)t * 128; const float* da = (const float*)(ws + WS_END + 16 * MiB) + (size_t)t * 128;
          int nf = 0; bool bg = false, ba = false;
          for (int k = lane; k < 128; k += 64) { const int e = (int)tmp[4096 + (k >> 4) * 32 + (k & 15)]; int f = -1; for (int m = 0; m < 16; ++m) if (di[(k & ~15) + m] == e) f = (k & ~15) + m;
              if (f < 0) ++nf; else { bg |= !(fabsf(dg[f] - tmp[4096 + (k >> 4) * 32 + 16 + (k & 15)]) <= 0.05f * dg[f] + 0.003f); ba |= !(fabsf(da[f] - tmp[6144 + k]) <= 0.05f * fabsf(da[f]) + 0.004f); } }
          nf = (int)wave_sum((float)nf);
          ck_flag(flags, 23, nf > 8); ck_flag(flags, 24, bg); ck_flag(flags, 25, ba); }
        bool bad = false;
        for (int j = 0; j < 4; ++j) { const int d = (lane * 4 + j * 256 + (int)(ck_hash(s) & 3)) & 2047; float o = 0.f; { const int* di = (const int*)(ws + WS_END + 8 * MiB) + (size_t)t * 128; const float* da = (const float*)(ws + WS_END + 16 * MiB) + (size_t)t * 128; for (int k = 0; k < 128; ++k) o += da[k] * I.pe_v[((size_t)L * PE_NE + di[k]) * 2048 + d]; }
            bad |= ck_bad((xo[d] + o), out[(size_t)t * 2048 + d]); }
        ck_flag(flags, stage, bad);
    } else if (stage == 9) {
        const int t = ck_hash(s) % T, h = ck_hash(86 + s) % 16; const float r2 = rsqrtf(ssq[SSQ_X2 + t] / 2048.f + 1e-6f); float qv[2], kv[2];
#pragma unroll
        for (int j = 0; j < 2; ++j) { const int d = lane + 64 * j; float a = 0.f, b = 0.f;
            for (int k = 0; k < 2048; ++k) { const float xv = bf2f(((const bf16*)(ws + WS_XB))[(size_t)t * 2048 + k]) * I.g_mix[2048 + k]; a += xv * I.fox_w_in[(size_t)k * 8208 + h * 128 + d]; b += xv * I.fox_w_in[(size_t)k * 8208 + 2048 + h * 128 + d]; }
            qv[j] = a * r2; kv[j] = b * r2; }
        const float rq = rsqrtf(wave_sum(qv[0] * qv[0] + qv[1] * qv[1]) / 128.f + 1e-6f) * 0.08838834764831845f * LOG2E, rk = rsqrtf(wave_sum(kv[0] * kv[0] + kv[1] * kv[1]) / 128.f + 1e-6f);
        bool bad = false;
#pragma unroll
        for (int j = 0; j < 2; ++j) { const int d = lane + 64 * j; bad |= ck_bad(4.f * qv[j] * rq * I.fox_g_q[d], 4.f * bf2f(((const bf16*)(ws + WS_Z))[(size_t)t * FOX_ZN + h * 128 + d]));
            bad |= ck_bad(kv[j] * rk * I.fox_g_k[d], bf2f(((const bf16*)(ws + WS_Z))[(size_t)t * FOX_ZN + 2048 + h * 128 + d])); }
        ck_flag(flags, 9, bad);
    } else if (stage == 8) {
        const int t = ck_hash(s) % T, n = ck_hash(85 + s) % 8192; float d = 0.f;
        for (int k = lane; k < 2048; k += 64) d += bf2f(((const bf16*)(ws + WS_XB))[(size_t)t * 2048 + k]) * I.g_mix[2048 + k] * I.fox_w_in[(size_t)k * 8208 + n];
        d = wave_sum(d) * rsqrtf(ssq[SSQ_X2 + t] / 2048.f + 1e-6f);
        const int sec = n >> 11, c = n & 2047; float got;
        if (sec == 2) got = bf2f(((const bf16*)(ws + WS_VT))[(size_t)c * T + ck_slot(t)]); else got = bf2f(((const bf16*)(ws + WS_Z))[(size_t)t * FOX_ZN + (sec == 3 ? 4096 : sec * 2048) + c]);
        ck_flag(flags, 8, ck_bad(d, got));
    }
}
__global__ void ck_poison(const unsigned* flags, float* out) {
    if (threadIdx.x == 0 && blockIdx.x == 0) { const int order[19] = {1, 2, 20, 21, 3, 22, 4, 5, 6, 23, 24, 25, 7, 8, 9, 10, 11, 12, 13};
        for (int i = 0; i < 19; ++i) if (flags[order[i]]) { out[0] += 1000.f * (float)(1 << (i + 1)); break; } }
}
#endif
#ifndef MK_N_LAUNCHES
#define MK_N_LAUNCHES 1
#endif
struct Args { const void* in[21]; float* out; unsigned char* ws; int ph_lo, ph_hi, rep, pad; };
static_assert(sizeof(Args) == 21 * 8 + 8 + 8 + 16, "Args has no padding");

__global__ void __launch_bounds__(NWAVES * 64, 2) mk_fwd(Args args) {
    extern __shared__ __attribute__((aligned(16))) unsigned char lds_raw[];
    Frame F;
    F.lds = (LAS unsigned char*)lds_raw;
    volatile LAS unsigned* MISC = (volatile LAS unsigned*)(F.lds + MISC_OFF);
    F.tid = threadIdx.x; F.lane = F.tid & 63; F.wave = __builtin_amdgcn_readfirstlane(F.tid >> 6);
    F.G = gridDim.x; { const int bx = blockIdx.x; F.vcu = (F.G % 8 == 0) ? (bx % 8) * (F.G / 8) + bx / 8 : bx; }
    F.ws = args.ws; F.out = args.out;
    In I;
    I.x = (const float*)args.in[0]; I.pos = (const int*)args.in[1]; I.g_mix = (const float*)args.in[2]; I.g_ffn = (const float*)args.in[3];
    I.mla_w_in = (const float*)args.in[4]; I.mla_g_qa = (const float*)args.in[5]; I.mla_w_qb = (const float*)args.in[6]; I.mla_g_kva = (const float*)args.in[7];
    I.mla_w_kvb = (const float*)args.in[8]; I.mla_g_q = (const float*)args.in[9]; I.mla_g_k = (const float*)args.in[10]; I.mla_w_o = (const float*)args.in[11];
    I.fox_w_in = (const float*)args.in[12]; I.fox_b_f = (const float*)args.in[13]; I.fox_g_q = (const float*)args.in[14]; I.fox_g_k = (const float*)args.in[15];
    I.fox_w_o = (const float*)args.in[16]; I.pe_wq = (const float*)args.in[17]; I.pe_sk = (const float*)args.in[18]; I.pe_u = (const float*)args.in[19]; I.pe_v = (const float*)args.in[20];
    for (int u = F.tid; u < (LDS_BYTES - LDSCTL_OFF) / 4; u += NWAVES * 64) ((LAS unsigned*)(F.lds + LDSCTL_OFF))[u] = 0u;
    __syncthreads();
    unsigned* ctl = (unsigned*)(F.ws + WS_CTL);
    XcdBarrier bar; bar.bar = ctl + CW_BAR; bar.x = 0; bar.st = nullptr;
    const int lo = args.ph_lo, hi = args.ph_hi;
    if (hi - lo > 1) bar = xcd_barrier_post(ctl + CW_BAR, MISC + 8);
#ifndef PH_MASK
#define PH_MASK 0x3fff
#endif
#define IN(k) (((PH_MASK >> (k)) & 1) && lo <= (k) && (k) < hi)
#define SEAM(k) do { if (IN(k) && IN((k) + 1)) xcd_barrier(bar); } while (0)
#ifdef TIMING_PROBE
#define REPS(k) ((TIMING_PROBE >> (k)) & 1)
#else
#define REPS(k) 0
#endif
    unsigned char* ws = F.ws;
    float* ssq = (float*)(ws + WS_SSQ);
    const int bid = (int)blockIdx.x;

    if (IN(0)) { for (int rp = REPS(0); rp >= 0; --rp) { p_prologue(F, I); if (rp) xcd_barrier(bar); } SEAM(0); }

    if (IN(1)) { for (int rp = REPS(1); rp >= 0; --rp) {
        pg8::Gemm g{(const bf16*)(ws + WS_XB), (const bf16*)(ws + WS_WT_MLA_IN), T, MLA_INP, D, D, D}; pg8::StaticOrder S; S.init(T, MLA_INP, F.G, bid);
        pg8::EpiRowScale E{(bf16*)(ws + WS_Z0), MLA_INP, ssq + SSQ_X0, 1, 1.f / 2048.f, ssq + SSQ_CQ, ssq + SSQ_CKV, 2, 4, 8};
        pg8::gemm_phase<pg8::EpiRowScale, pg8::StaticOrder, false>(F.lds + RING_OFF, g, S, E);
        if (bid >= 160) p_table_fill(F, I, 16384, 16384, (bid - 160) * NWAVES + F.wave, 96 * NWAVES);
        if (rp) xcd_barrier(bar); }
        SEAM(1);
    }
    if (IN(2)) { for (int rp = REPS(2); rp >= 0; --rp) {
        p_mla_tok(F, I);
        { pg8::Gemm g{(const bf16*)(ws + WS_Z0), (const bf16*)(ws + WS_WT_QB), T, MLA_QN, 512, MLA_INP, 512}; pg8::StaticOrder S; S.init(T, MLA_QN, F.G, bid);
          pg8::EpiRowScale E{(bf16*)(ws + WS_Q), MLA_QN, nullptr, 0, 0.f, nullptr, nullptr, 0, 0, 0};
          pg8::gemm_phase<pg8::EpiRowScale, pg8::StaticOrder, true>(F.lds + RING_OFF, g, S, E);
          if (bid >= 128) p_table_fill(F, I, 49152, PE_FILL2, (bid - 128) * NWAVES + F.wave, 128 * NWAVES); }
        { pg8::Gemm g{(const bf16*)(ws + WS_Z0) + 512, (const bf16*)(ws + WS_WT_KVB), T, 2048, 512, MLA_INP, 512}; pg8::StaticOrder S; S.init(T, 2048, F.G, bid);
          pg8::EpiRowScale E{(bf16*)(ws + WS_KN), 2048, nullptr, 0, 0.f, nullptr, nullptr, 0, 0, 0, (float*)(ws + WS_KSQM), 0, 8};
          pg8::gemm_phase<pg8::EpiRowScale, pg8::StaticOrder, true>(F.lds + RING_OFF, g, S, E); }
        { pg8::Gemm g{(const bf16*)(ws + WS_WT_KVB) + (size_t)2048 * 512, (const bf16*)(ws + WS_Z0) + 512, 2048, T, 512, 512, MLA_INP}; pg8::StaticOrder S; S.init(2048, T, F.G, bid);
          pg8::EpiColScale E{(bf16*)(ws + WS_VT), T, ssq + SSQ_CKV, 8, 1.f / 512.f};
          pg8::gemm_phase<pg8::EpiColScale, pg8::StaticOrder, true>(F.lds + RING_OFF, g, S, E); }
        if (rp) xcd_barrier(bar); }
        SEAM(2);
    }
    if (IN(4)) { for (int rp = REPS(4); rp >= 0; --rp) {
        const AttnAux ax{I.mla_g_q, I.mla_g_k, (const float*)(ws + WS_KSQM), ssq + SSQ_CQ, (const float*)(ws + WS_ROPE), (const float*)(ws + WS_RCKV), (const float*)(ws + WS_KRSS), (const bf16*)(ws + WS_KRG)};
        p_attention<192, false>(F, (const bf16*)(ws + WS_Q), MLA_QN, (const bf16*)(ws + WS_KN), 2048, (const bf16*)(ws + WS_VT), (bf16*)(ws + WS_O), nullptr, 0, nullptr, ax);
        if (rp) xcd_barrier(bar); }
        SEAM(4);
    }
    if (IN(5)) { for (int rp = REPS(5); rp >= 0; --rp) {
        pg8::Gemm g{(const bf16*)(ws + WS_O), (const bf16*)(ws + WS_WT_MLA_O), T, D, D, D, D}; pg8::StaticOrder S; S.init(T, D, F.G, bid);
        pg8::EpiResidual E{I.x, F.out, (bf16*)(ws + WS_XB), D, ssq + SSQ_XS};
        pg8::gemm_phase<pg8::EpiResidual, pg8::StaticOrder, false>(F.lds + RING_OFF, g, S, E);
        if (rp) xcd_barrier(bar); }
        SEAM(5);
    }
    if (IN(6)) { for (int rp = REPS(6); rp >= 0; --rp) {
        pg8::Gemm g{(const bf16*)(ws + WS_XB), (const bf16*)(ws + WS_WT_PQ), T, D, D, D, D}; pg8::StaticOrder S; S.init(T, D, F.G, bid);
        pg8::EpiRowScale E{(bf16*)(ws + WS_QP), D, nullptr, 0, 0.f, nullptr, nullptr, 0, 0, 0};
        pg8::gemm_phase<pg8::EpiRowScale, pg8::StaticOrder, false>(F.lds + RING_OFF, g, S, E);
        if (rp) xcd_barrier(bar); }
        SEAM(6);
    }
    if (IN(7)) { for (int rp = REPS(7); rp >= 0; --rp) { p_peer<0>(F, I, rp); if (rp) xcd_barrier(bar); } SEAM(7); }
    if (IN(8)) { for (int rp = REPS(8); rp >= 0; --rp) {
        { pg8::Gemm g{(const bf16*)(ws + WS_XB), (const bf16*)(ws + WS_WT_FOX_IN), T, FOX_ZN, D, D, D}; pg8::StaticOrder S; S.init(T, FOX_ZN, F.G, bid);
          pg8::EpiRowScale E{(bf16*)(ws + WS_Z), FOX_ZN, ssq + SSQ_X2, 1, 1.f / 2048.f, nullptr, nullptr, 0, 0, 0, (float*)(ws + WS_KSQ), 8, 16};
          pg8::gemm_phase<pg8::EpiRowScale, pg8::StaticOrder, true>(F.lds + RING_OFF, g, S, E); }
        { pg8::Gemm g{(const bf16*)(ws + WS_WT_FOX_IN) + (size_t)FOX_ZN * D, (const bf16*)(ws + WS_XB), 2048, T, D, D, D}; pg8::StaticOrder S; S.init(2048, T, F.G, bid);
          pg8::EpiColScale E{(bf16*)(ws + WS_VT), T, ssq + SSQ_X2, 1, 1.f / 2048.f};
          pg8::gemm_phase<pg8::EpiColScale, pg8::StaticOrder, true>(F.lds + RING_OFF, g, S, E); }
        if (rp) xcd_barrier(bar); }
        SEAM(8);
    }
    if (IN(10)) { for (int rp = REPS(10); rp >= 0; --rp) {
        p_attention<128, true>(F, (const bf16*)(ws + WS_Z), FOX_ZN, (const bf16*)(ws + WS_Z) + 2048, FOX_ZN, (const bf16*)(ws + WS_VT), (bf16*)(ws + WS_O), (const bf16*)(ws + WS_Z) + 4096, FOX_ZN, (const float*)(ws + WS_LF), AttnAux{I.fox_g_q, I.fox_g_k, (const float*)(ws + WS_KSQ), nullptr, nullptr, nullptr, nullptr, nullptr});
        if (rp) xcd_barrier(bar); }
        SEAM(10);
    }
    if (IN(11)) {
        pg8::Gemm g{(const bf16*)(ws + WS_O), (const bf16*)(ws + WS_WT_FOX_O), T, D, D, D, D}; pg8::StaticOrder S; S.init(T, D, F.G, bid);
        pg8::EpiResidual E{F.out, F.out, (bf16*)(ws + WS_XB), D, ssq + SSQ_XS};
        pg8::gemm_phase<pg8::EpiResidual, pg8::StaticOrder, false>(F.lds + RING_OFF, g, S, E);
        SEAM(11);
    }
    if (IN(12)) { for (int rp = REPS(12); rp >= 0; --rp) {
        pg8::Gemm g{(const bf16*)(ws + WS_XB), (const bf16*)(ws + WS_WT_PQ + 8 * MiB), T, D, D, D, D}; pg8::StaticOrder S; S.init(T, D, F.G, bid);
        pg8::EpiRowScale E{(bf16*)(ws + WS_QP), D, nullptr, 0, 0.f, nullptr, nullptr, 0, 0, 0};
        pg8::gemm_phase<pg8::EpiRowScale, pg8::StaticOrder, false>(F.lds + RING_OFF, g, S, E);
        if (rp) xcd_barrier(bar); }
        SEAM(12);
    }
    if (IN(13)) { for (int rp = REPS(13); rp >= 0; --rp) { p_peer<1>(F, I, rp); if (rp) xcd_barrier(bar); } }
#ifdef PROF
    if (hi - lo > 1) { xcd_barrier(bar); if (blockIdx.x == 0 && F.tid == 0) { float v = __uint_as_float(__hip_atomic_load(ctl + 70, __ATOMIC_RELAXED, __HIP_MEMORY_SCOPE_AGENT)); v = fminf(fmaxf(v, 0.f), 1.5f); v = rintf(v * 12.f) * (1.f / 12.f); F.out[0] += 1000.f * __builtin_exp10f(v);        } }
#endif
#ifdef BARRIER_PROBE
    if (hi - lo > 1) { for (int i = 0; i < 8; ++i) xcd_barrier(bar); }
#endif
#ifdef FP6_SELFTEST
    if (hi - lo > 1) { xcd_barrier(bar); if (blockIdx.x == 0 && F.tid == 0 && __hip_atomic_load(ctl + 64, __ATOMIC_RELAXED, __HIP_MEMORY_SCOPE_AGENT)) F.out[0] += 1.0e6f; }
#endif
#undef IN
#undef SEAM
}

extern "C" void kernel_launch(void* const* d_in, const int* in_sizes, int n_in, void* d_out, int out_size, void* d_ws, size_t ws_size, hipStream_t stream) {
    static int grid = 0;
    if (grid == 0) {
        if (n_in != 21 || out_size != T * D || ws_size < WS_END) { fprintf(stderr, "kernel_launch: unexpected shapes (n_in %d out %d ws %zu need %zu)\n", n_in, out_size, ws_size, (size_t)WS_END); grid = -1; return; }
        int dev = 0, cus = 0, per_cu = 0;
        if (hipGetDevice(&dev) != hipSuccess || hipDeviceGetAttribute(&cus, hipDeviceAttributeMultiprocessorCount, dev) != hipSuccess) { grid = -1; return; }
        if (hipFuncSetAttribute((const void*)mk_fwd, hipFuncAttributeMaxDynamicSharedMemorySize, LDS_BYTES) != hipSuccess) { fprintf(stderr, "kernel_launch: hipFuncSetAttribute failed\n"); grid = -1; return; }
        if (hipOccupancyMaxActiveBlocksPerMultiprocessor(&per_cu, (const void*)mk_fwd, NWAVES * 64, LDS_BYTES) != hipSuccess || per_cu < 1) { fprintf(stderr, "kernel_launch: occupancy query says %d\n", per_cu); }
        (void)hipGetLastError();
        grid = cus;
    }
    if (grid < 0) return;
    (void)hipMemsetAsync((char*)d_ws + WS_CTL, 0, CTL_ZERO_BYTES, stream);
    Args a{};
    for (int i = 0; i < 21; ++i) a.in[i] = d_in[i];
    a.out = (float*)d_out; a.ws = (unsigned char*)d_ws;
#ifdef TIMING_PROBE
    a.rep = TIMING_PROBE;
#endif
#ifdef STAGECHECK
    {
        unsigned char* ws = (unsigned char*)d_ws; unsigned* flags = (unsigned*)(ws + WS_CK); float* rows = (float*)(ws + WS_CK_ROWS);
        (void)hipMemsetAsync(ws + WS_CK, 0, 4096, stream);
        In I; { const void* const* in = a.in; I.x = (const float*)in[0]; I.pos = (const int*)in[1]; I.g_mix = (const float*)in[2]; I.g_ffn = (const float*)in[3]; I.mla_w_in = (const float*)in[4]; I.mla_g_qa = (const float*)in[5];
            I.mla_w_qb = (const float*)in[6]; I.mla_g_kva = (const float*)in[7]; I.mla_w_kvb = (const float*)in[8]; I.mla_g_q = (const float*)in[9]; I.mla_g_k = (const float*)in[10]; I.mla_w_o = (const float*)in[11];
            I.fox_w_in = (const float*)in[12]; I.fox_b_f = (const float*)in[13]; I.fox_g_q = (const float*)in[14]; I.fox_g_k = (const float*)in[15]; I.fox_w_o = (const float*)in[16]; I.pe_wq = (const float*)in[17];
            I.pe_sk = (const float*)in[18]; I.pe_u = (const float*)in[19]; I.pe_v = (const float*)in[20]; }
        for (int p = 0; p < N_PHASES; ++p) {
            if (p == 7 || p == 11 || p == 13) hipLaunchKernelGGL(ck_save_rows, dim3(CK_NS), dim3(64), 0, stream, (const float*)d_out, rows);
            a.ph_lo = p; a.ph_hi = p + 1; hipLaunchKernelGGL(mk_fwd, dim3(grid), dim3(NWAVES * 64), LDS_BYTES, stream, a);
            if (p >= 1) hipLaunchKernelGGL(ck_kernel, dim3(CK_NS), dim3(64), 0, stream, p, I, ws, (const float*)d_out, flags);
        }
        hipLaunchKernelGGL(ck_poison, dim3(1), dim3(64), 0, stream, (const unsigned*)flags, (float*)d_out);
    }
#elif defined(SELFCHECK)
    {
        unsigned char* ws = (unsigned char*)d_ws;
        (void)hipMemsetAsync(ws + WS_DG, 0, DG_BYTES, stream);
        unsigned* flag = (unsigned*)(ws + 64 * 1024);
        const size_t OUTB = (size_t)-1;
        const DgBuf bufs[N_PHASES][DG_NBUF] = {
            {{WS_XB, 0, (size_t)T * D}, {WS_WT_MLA_IN, 0, (size_t)40 * 1024 * 1024}, {WS_PU, 0, (size_t)64 * 1024 * 1024}},
            {{WS_Z0, 0, (size_t)T * MLA_INP}, {0, 0, 0}, {0, 0, 0}},
            {{WS_Q, 0, (size_t)T * MLA_QN}, {WS_KN, 0, (size_t)T * 2048}, {WS_VT, 0, (size_t)T * 2048}},
            {{WS_Q, 0, (size_t)T * MLA_QN}, {WS_KM, 0, (size_t)T * MLA_QN}, {0, 0, 0}},
            {{WS_O, 0, (size_t)T * D}, {0, 0, 0}, {0, 0, 0}},
            {{OUTB, 1, (size_t)T * D}, {WS_XB, 0, (size_t)T * D}, {0, 0, 0}},
            {{WS_QP, 0, (size_t)T * D}, {0, 0, 0}, {0, 0, 0}},
            {{OUTB, 1, (size_t)T * D}, {WS_XB, 0, (size_t)T * D}, {WS_LF, 1, (size_t)T * 16}},
            {{WS_Z, 0, (size_t)T * FOX_ZN}, {WS_VT, 0, (size_t)T * 2048}, {0, 0, 0}},
            {{WS_Z, 0, (size_t)T * FOX_ZN}, {0, 0, 0}, {0, 0, 0}},
            {{WS_O, 0, (size_t)T * D}, {0, 0, 0}, {0, 0, 0}},
            {{OUTB, 1, (size_t)T * D}, {WS_XB, 0, (size_t)T * D}, {0, 0, 0}},
            {{WS_QP, 0, (size_t)T * D}, {0, 0, 0}, {0, 0, 0}},
            {{OUTB, 1, (size_t)T * D}, {0, 0, 0}, {0, 0, 0}}};
        for (int pass = 0; pass < DG_NPASS; ++pass) {
            for (int p = 0; p < N_PHASES; ++p) {
                a.ph_lo = p; a.ph_hi = p + 1; hipLaunchKernelGGL(mk_fwd, dim3(grid), dim3(NWAVES * 64), LDS_BYTES, stream, a);
                for (int b = 0; b < DG_NBUF; ++b) { const DgBuf& B = bufs[p][b]; if (!B.nelem) continue;
                    size_t ne = B.nelem; if (ne > (size_t)DG_MAXCH * DG_CHUNK) ne = (size_t)DG_MAXCH * DG_CHUNK;
                    const void* ptr = (B.off == OUTB) ? (const void*)d_out : (const void*)(ws + B.off);
                    float2* dig = (float2*)(ws + WS_DG) + (((size_t)pass * N_PHASES + p) * DG_NBUF + b) * DG_MAXCH;
                    hipLaunchKernelGGL(dg_kernel, dim3((unsigned)((ne + DG_CHUNK - 1) / DG_CHUNK)), dim3(256), 0, stream, ptr, B.is_f32, ne, dig); }
            }
        }
        hipLaunchKernelGGL(dg_compare, dim3(N_PHASES), dim3(256), 0, stream, (const float2*)(ws + WS_DG), flag);
        hipLaunchKernelGGL(dg_poison, dim3(1), dim3(64), 0, stream, (const unsigned*)flag, (float*)d_out);
    }
#elif MK_N_LAUNCHES == 1
    a.ph_lo = 0; a.ph_hi = N_PHASES;
    hipLaunchKernelGGL(mk_fwd, dim3(grid), dim3(NWAVES * 64), LDS_BYTES, stream, a);
#else
    for (int p = 0; p < N_PHASES; ++p) { a.ph_lo = p; a.ph_hi = p + 1; hipLaunchKernelGGL(mk_fwd, dim3(grid), dim3(NWAVES * 64), LDS_BYTES, stream, a); }
#endif
}
```

```cpp
#include <hip/hip_runtime.h>
#include <cstdio>
#include <cstdint>
namespace pg8 {
#define PG8_LAS __attribute__((address_space(3)))
typedef unsigned short bf16_t;
typedef short bf16x8 __attribute__((ext_vector_type(8)));
typedef float f32x4 __attribute__((ext_vector_type(4)));
typedef unsigned u32x4 __attribute__((ext_vector_type(4)));
typedef unsigned u32x2 __attribute__((ext_vector_type(2)));
constexpr int BM = 256, BK = 64, HALF = 128, HTB = HALF * BK * 2  , STAGE_BYTES = 8 * HTB, NXCD = 8, WGM = 8;

__host__ __device__ __forceinline__ int lds_byte(int r, int c) { const int st = (r >> 4) * 2 + (c >> 5), rr = r & 15, cc = c & 31, ob = rr * 64 + cc * 2; return st * 1024 + (ob ^ (((ob >> 9) & 1) << 5)); }
__host__ __device__ __forceinline__ void stage_rc(int b, int& R, int& C) { const int st = b / 1024, sb = b % 1024, swz = sb ^ (((sb >> 9) & 1) << 5); R = (st >> 1) * 16 + swz / 64; C = (st & 1) * 32 + (swz % 64) / 2; }
__host__ __device__ __forceinline__ int perm32(int rho) { const int n = rho >> 4, i = rho & 15; return 8 * (i >> 2) + 4 * n + (i & 3); }

struct Unit { int pm, pn; };
struct Gemm { const bf16_t* A; const bf16_t* Bt; int M, N, K, lda, ldb; };

struct StaticOrder {
    int nM, nN, nwg, G, c;
    __host__ __device__ void init(int M, int N, int G_, int c_) { nM = M / BM; nN = N / BM; nwg = nM * nN; G = G_; c = c_; }
    __host__ __device__ bool next(int i, Unit& u) const {
        const long L = (long)i * G + c; if (L >= nwg) return false;
        int wgid = (int)L; { const int q = nwg / NXCD, r = nwg % NXCD, xcd = wgid % NXCD, off = wgid / NXCD; wgid = (xcd < r ? xcd * (q + 1) : r * (q + 1) + (xcd - r) * q) + off; }
        const int nig = WGM * nN, gid = wgid / nig, fm = gid * WGM, gsz = (nM - fm) < WGM ? (nM - fm) : WGM;
        u.pm = fm + ((wgid % nig) % gsz); u.pn = (wgid % nig) / gsz; return true;
    }
    __device__ __forceinline__ void a_ready(const Unit&) const {}
    __device__ __forceinline__ void done(const Unit&) const {}
};

__device__ __forceinline__ unsigned cvt_pk_bf16(float lo, float hi) { unsigned r; asm volatile("v_cvt_pk_bf16_f32 %0, %1, %2" : "=v"(r) : "v"(lo), "v"(hi)); return r; }

constexpr float RMS_EPS = 1e-6f;

__device__ __forceinline__ float slot_sum(const float* p, int ns) { float s = 0.f; for (int i = 0; i < ns; ++i) s += p[i]; return s; }
struct EpiRowScale {
    static constexpr bool PERM = true, AFTER_DRAIN = false, HAS_INIT = false;
    bf16_t* O; int ldc; const float* ssq_in; int ns_in; float inv_k; float* ssq_out0; float* ssq_out1; int t0, t1, ns_out;
    float* ksq = nullptr; int kt0 = 0, kt1 = 0;
    __device__ __forceinline__ void operator()(const f32x4 (&acc)[2][2][4][2], const Unit& u, int wr, int wc, int fr, int fq) const {
        const int row0 = u.pm * BM + wr * 64 + fr, col0 = u.pn * BM + wc * 32 + 8 * fq;
        float* sdst = (u.pn < t0) ? ssq_out0 + u.pn * 4 + wc : ((u.pn < t1) ? ssq_out1 + (u.pn - t0) * 4 + wc : nullptr);
#pragma unroll
        for (int ai = 0; ai < 2; ++ai)
#pragma unroll
            for (int m = 0; m < 4; ++m) {
                const int row = row0 + ai * HALF + m * 16;
                const float rs = ssq_in ? __builtin_amdgcn_rsqf(slot_sum(ssq_in + (size_t)row * ns_in, ns_in) * inv_k + RMS_EPS) : 1.f;
                bf16_t* rowp = O + (size_t)row * ldc + col0; float sq = 0.f, sqh[2];
#pragma unroll
                for (int bj = 0; bj < 2; ++bj) { const f32x4 v0 = acc[ai][bj][m][0] * rs, v1 = acc[ai][bj][m][1] * rs;
                    sqh[bj] = (v0[0] * v0[0] + v0[1] * v0[1]) + (v0[2] * v0[2] + v0[3] * v0[3]) + (v1[0] * v1[0] + v1[1] * v1[1]) + (v1[2] * v1[2] + v1[3] * v1[3]); sq += sqh[bj];
                    u32x4 w; w.x = cvt_pk_bf16(v0[0], v0[1]); w.y = cvt_pk_bf16(v0[2], v0[3]); w.z = cvt_pk_bf16(v1[0], v1[1]); w.w = cvt_pk_bf16(v1[2], v1[3]);
                    *(u32x4*)(rowp + bj * HALF) = w; }
                if (sdst) { sq += __shfl_xor(sq, 16); sq += __shfl_xor(sq, 32); if (fq == 0) sdst[(size_t)row * ns_out] = sq; }
                if (ksq && u.pn >= kt0 && u.pn < kt1) {
#pragma unroll
                    for (int bj = 0; bj < 2; ++bj) { float q = sqh[bj]; q += __shfl_xor(q, 16); q += __shfl_xor(q, 32); if (fq == 0) ksq[((size_t)(2 * (u.pn - kt0) + bj) * 8192 + row) * 4 + wc] = q; } }
            }
    }
};
struct EpiColScale {
    static constexpr bool PERM = true, AFTER_DRAIN = false, HAS_INIT = false;
    bf16_t* O; int ldc; const float* ssq_in; int ns_in; float inv_k;
    __device__ __forceinline__ void operator()(const f32x4 (&acc)[2][2][4][2], const Unit& u, int wr, int wc, int fr, int fq) const {
        const int row0 = u.pm * BM + wr * 64 + fr, col0 = u.pn * BM + wc * 32 + 8 * fq;
        f32x4 cs[2][2];
#pragma unroll
        for (int bj = 0; bj < 2; ++bj)
#pragma unroll
            for (int n = 0; n < 2; ++n) { const float* sp = ssq_in + (size_t)(col0 + bj * HALF + 4 * n) * ns_in; const f32x4 s = (f32x4){slot_sum(sp, ns_in), slot_sum(sp + ns_in, ns_in), slot_sum(sp + 2 * ns_in, ns_in), slot_sum(sp + 3 * ns_in, ns_in)};
                cs[bj][n] = (f32x4){__builtin_amdgcn_rsqf(s[0] * inv_k + RMS_EPS), __builtin_amdgcn_rsqf(s[1] * inv_k + RMS_EPS), __builtin_amdgcn_rsqf(s[2] * inv_k + RMS_EPS), __builtin_amdgcn_rsqf(s[3] * inv_k + RMS_EPS)}; }
#pragma unroll
        for (int ai = 0; ai < 2; ++ai)
#pragma unroll
            for (int m = 0; m < 4; ++m) { bf16_t* rowp = O + (size_t)(row0 + ai * HALF + m * 16) * ldc + col0;
#pragma unroll
                for (int bj = 0; bj < 2; ++bj) { const f32x4 v0 = acc[ai][bj][m][0] * cs[bj][0], v1 = acc[ai][bj][m][1] * cs[bj][1];
                    u32x2 w0, w1; w0.x = cvt_pk_bf16(v0[0], v0[1]); w0.y = cvt_pk_bf16(v0[2], v0[3]); w1.x = cvt_pk_bf16(v1[0], v1[1]); w1.y = cvt_pk_bf16(v1[2], v1[3]);
                    bf16_t* gp = rowp + bj * HALF - 8 * (fq & 1);
                    { const auto t0 = __builtin_amdgcn_permlane16_swap(w0.x, w1.x, false, false); const auto t1 = __builtin_amdgcn_permlane16_swap(w0.y, w1.y, false, false);
                      u32x4 w; w.x = t0[0]; w.y = t1[0]; w.z = t0[1]; w.w = t1[1];
                      *(u32x4*)(gp + ((fq & 1) ? 8 : 0)) = w; } } }
    }
};
struct EpiResidual {
    static constexpr bool PERM = false, AFTER_DRAIN = false, HAS_INIT = true;
    const float* xold; float* out; bf16_t* xb; int ldc; float* ssq_out;
    __device__ __forceinline__ void init(f32x4 (&acc)[2][2][4][2], const Unit& u, int wr, int wc, int fr, int fq) const {
        const int row0 = u.pm * BM + wr * 64 + fr, col0 = u.pn * BM + wc * 32 + 4 * fq;
#pragma unroll
        for (int ai = 0; ai < 2; ++ai)
#pragma unroll
            for (int m = 0; m < 4; ++m) { const size_t ro = (size_t)(row0 + ai * HALF + m * 16) * ldc + col0;
#pragma unroll
                for (int bj = 0; bj < 2; ++bj)
#pragma unroll
                    for (int n = 0; n < 2; ++n) acc[ai][bj][m][n] = *(const f32x4*)(xold + ro + bj * HALF + 16 * n); }
    }
    __device__ __forceinline__ void operator()(const f32x4 (&acc)[2][2][4][2], const Unit& u, int wr, int wc, int fr, int fq) const {
        const int row0 = u.pm * BM + wr * 64 + fr, col0 = u.pn * BM + wc * 32 + 4 * fq;
#pragma unroll
        for (int ai = 0; ai < 2; ++ai)
#pragma unroll
            for (int m = 0; m < 4; ++m) {
                const int row = row0 + ai * HALF + m * 16; const size_t ro = (size_t)row * ldc + col0; float sq = 0.f;
#pragma unroll
                for (int bj = 0; bj < 2; ++bj)
#pragma unroll
                    for (int n = 0; n < 2; ++n) { const size_t o = ro + bj * HALF + 16 * n;
                        const f32x4 v = acc[ai][bj][m][n];
                        sq += (v[0] * v[0] + v[1] * v[1]) + (v[2] * v[2] + v[3] * v[3]);
                        *(f32x4*)(out + o) = v; u32x2 w; w.x = cvt_pk_bf16(v[0], v[1]); w.y = cvt_pk_bf16(v[2], v[3]); *(u32x2*)(xb + o) = w; }
                sq += __shfl_xor(sq, 16); sq += __shfl_xor(sq, 32); if (fq == 0) ssq_out[(size_t)row * 32 + u.pn * 4 + wc] = sq;
            }
    }
};

template <class Epi, class Sched, bool ALIGN_EPI = false>
__device__ __forceinline__ void gemm_phase(PG8_LAS unsigned char* lds, const Gemm g, const Sched& S, const Epi& E) {
    const int tid = threadIdx.x, wid = __builtin_amdgcn_readfirstlane(tid >> 6), lane = tid & 63, wr = wid >> 2, wc = wid & 3, fr = lane & 15, fq = lane >> 4;
    const int K = g.K, nt = K / BK;
    unsigned voffA[2], voffB[2];
#pragma unroll
    for (int i = 0; i < 2; ++i) { int R, C; stage_rc(tid * 16 + i * 8192, R, C); const int Rb = Epi::PERM ? ((R & ~31) + perm32(R & 31)) : R;
        voffA[i] = (unsigned)(R * g.lda + C) * 2u; voffB[i] = (unsigned)(Rb * g.ldb + C) * 2u; }
    const size_t kstep = (size_t)(BK * 2);
    const size_t hstepA = (size_t)HALF * g.lda * 2, hstepB = (size_t)HALF * g.ldb * 2;
    const size_t tstepA = 2 * hstepA, tstepB = 2 * hstepB;
    const unsigned ldsw = (unsigned)wid * 1024u;
    const int aoff = lds_byte(wr * 64 + fr, fq * 8), boff = lds_byte(wc * 32 + fr, fq * 8);
#define PG8_SA(b, h) (((b) * 2 + (h)) * HTB)
#define PG8_SB(b, h) ((4 + (b) * 2 + (h)) * HTB)
#define PG8_STAGE(bufoff, gbase, voff) do { _Pragma("unroll") for (int _i = 0; _i < 2; ++_i) \
        __builtin_amdgcn_global_load_lds((const unsigned*)((const char*)(gbase) + (voff)[_i]), (PG8_LAS unsigned*)(lds + (bufoff) + ldsw + _i * 8192), 16, 0, 0); } while (0)
#define PG8_LDA(dst, b, h) do { _Pragma("unroll") for (int m = 0; m < 4; ++m) _Pragma("unroll") for (int k = 0; k < 2; ++k) dst[m][k] = *(const PG8_LAS bf16x8*)(lds + PG8_SA(b, h) + aoff + m * 2048 + k * 1024); } while (0)
#define PG8_LDB(dst, b, h) do { _Pragma("unroll") for (int n = 0; n < 2; ++n) _Pragma("unroll") for (int k = 0; k < 2; ++k) dst[n][k] = *(const PG8_LAS bf16x8*)(lds + PG8_SB(b, h) + boff + n * 2048 + k * 1024); } while (0)
#define PG8_MMA(ai, bj, At, Bt) do { __builtin_amdgcn_s_setprio(1); _Pragma("unroll") for (int m = 0; m < 4; ++m) _Pragma("unroll") for (int n = 0; n < 2; ++n) _Pragma("unroll") for (int k = 0; k < 2; ++k) \
        acc[ai][bj][m][n] = __builtin_amdgcn_mfma_f32_16x16x32_bf16(Bt[n][k], At[m][k], acc[ai][bj][m][n], 0, 0, 0); __builtin_amdgcn_s_setprio(0); } while (0)
#define PG8_WAIT_V(n) asm volatile("s_waitcnt vmcnt(" #n ")" ::: "memory")
#define PG8_WAIT_L(n) asm volatile("s_waitcnt lgkmcnt(" #n ")" ::: "memory")
#define PG8_BAR __builtin_amdgcn_s_barrier()
#define PG8_SCHED __builtin_amdgcn_sched_barrier(0)
    Unit cur, nxt; int ui = 0;
    if (!S.next(0, cur)) return;
    f32x4 acc[2][2][4][2];
    if constexpr (Epi::HAS_INIT) E.init(acc, cur, wr, wc, fr, fq);
    else {
#pragma unroll
    for (int a = 0; a < 2; ++a)
#pragma unroll
        for (int b = 0; b < 2; ++b)
#pragma unroll
            for (int m = 0; m < 4; ++m)
#pragma unroll
                for (int n = 0; n < 2; ++n) acc[a][b][m][n] = (f32x4){0.f, 0.f, 0.f, 0.f};
    }
    bf16x8 At[4][2], B0[2][2], B1[2][2];
    const char* cA = (const char*)g.A + (size_t)cur.pm * tstepA; const char* cB = (const char*)g.Bt + (size_t)cur.pn * tstepB;
    S.a_ready(cur);
    PG8_STAGE(PG8_SB(0, 0), cB, voffB); PG8_STAGE(PG8_SB(0, 1), cB + hstepB, voffB); PG8_STAGE(PG8_SA(0, 0), cA, voffA); PG8_STAGE(PG8_SA(0, 1), cA + hstepA, voffA);
    if (wr == 1) PG8_BAR;
    PG8_WAIT_V(2); PG8_BAR;
    PG8_STAGE(PG8_SB(1, 0), cB + kstep, voffB); PG8_STAGE(PG8_SA(1, 0), cA + kstep, voffA); PG8_STAGE(PG8_SB(1, 1), cB + hstepB + kstep, voffB);
    PG8_WAIT_V(6); PG8_BAR;
    for (;;) {
        const bool has_next = S.next(ui + 1, nxt);
        const char* nA = has_next ? (const char*)g.A + (size_t)nxt.pm * tstepA : cA; const char* nB = has_next ? (const char*)g.Bt + (size_t)nxt.pn * tstepB : cB;
        for (int t = 0; t < nt; t += 2) {
            const bool last = (t == nt - 2);
            const char* a1 = cA + (size_t)(t + 1) * kstep;
            const char* a2 = last ? nA : cA + (size_t)(t + 2) * kstep; const char* b2 = last ? nB : cB + (size_t)(t + 2) * kstep;
            const char* a3 = a2 + kstep; const char* b3 = b2 + kstep;
            if (last && has_next) S.a_ready(nxt);
            PG8_LDB(B0, 0, 0); PG8_LDB(B1, 0, 1); PG8_SCHED; PG8_LDA(At, 0, 0); PG8_STAGE(PG8_SA(1, 1), a1 + hstepA, voffA);
            PG8_WAIT_V(8); PG8_WAIT_L(0); PG8_BAR; PG8_MMA(0, 0, At, B0); PG8_MMA(0, 1, At, B1); PG8_BAR; PG8_SCHED;
            PG8_LDA(At, 0, 1); PG8_STAGE(PG8_SB(0, 0), b2, voffB); PG8_STAGE(PG8_SB(0, 1), b2 + hstepB, voffB); PG8_STAGE(PG8_SA(0, 0), a2, voffA);
            PG8_WAIT_V(8); PG8_WAIT_L(0); PG8_BAR; PG8_MMA(1, 0, At, B0); PG8_MMA(1, 1, At, B1); PG8_BAR; PG8_SCHED;
            PG8_LDB(B0, 1, 0); PG8_LDB(B1, 1, 1); PG8_SCHED; PG8_LDA(At, 1, 0); PG8_STAGE(PG8_SA(0, 1), a2 + hstepA, voffA);
            PG8_WAIT_V(8); PG8_WAIT_L(0); PG8_BAR; PG8_MMA(0, 0, At, B0); PG8_MMA(0, 1, At, B1); PG8_BAR; PG8_SCHED;
            PG8_LDA(At, 1, 1); PG8_STAGE(PG8_SB(1, 0), b3, voffB); PG8_STAGE(PG8_SB(1, 1), b3 + hstepB, voffB); PG8_STAGE(PG8_SA(1, 0), a3, voffA);
            PG8_WAIT_V(8); PG8_WAIT_L(0); PG8_BAR; PG8_MMA(1, 0, At, B0); PG8_MMA(1, 1, At, B1); PG8_BAR; PG8_SCHED;
        }
        if constexpr (ALIGN_EPI) { if (wr == 0) PG8_BAR; }
        E(acc, cur, wr, wc, fr, fq); S.done(cur);
        if (!has_next) break;
        if constexpr (Epi::HAS_INIT) E.init(acc, nxt, wr, wc, fr, fq);
        else {
#pragma unroll
        for (int a = 0; a < 2; ++a)
#pragma unroll
            for (int b = 0; b < 2; ++b)
#pragma unroll
                for (int m = 0; m < 4; ++m)
#pragma unroll
                    for (int n = 0; n < 2; ++n) acc[a][b][m][n] = (f32x4){0.f, 0.f, 0.f, 0.f};
        }
        cur = nxt; cA = nA; cB = nB; ++ui;
        if constexpr (ALIGN_EPI) { if (wr == 1) PG8_BAR; }
    }
    PG8_WAIT_V(0);
    if constexpr (!ALIGN_EPI) { if (wr == 0) PG8_BAR; }
    PG8_BAR;
#undef PG8_SA
#undef PG8_SB
#undef PG8_STAGE
#undef PG8_LDA
#undef PG8_LDB
#undef PG8_MMA
#undef PG8_WAIT_V
#undef PG8_WAIT_L
#undef PG8_BAR
#undef PG8_SCHED
}
}
#define GAS __attribute__((address_space(1)))
#define LAS __attribute__((address_space(3)))
typedef unsigned short bf16;
typedef unsigned v4u __attribute__((ext_vector_type(4)));
typedef unsigned v2u __attribute__((ext_vector_type(2)));
typedef float f32x4 __attribute__((ext_vector_type(4)));
typedef float f32x16 __attribute__((ext_vector_type(16)));
typedef short bf16x8 __attribute__((ext_vector_type(8)));
typedef __bf16 bf16x2_t __attribute__((ext_vector_type(2)));
typedef GAS unsigned gu32;
#define RLX_AGENT __ATOMIC_RELAXED, __HIP_MEMORY_SCOPE_AGENT
__device__ __forceinline__ unsigned f2bf(float f) { unsigned u = __builtin_bit_cast(unsigned, f); return (u + 0x7fffu + ((u >> 16) & 1u)) >> 16; }
__device__ __forceinline__ unsigned pk2(float lo, float hi) { return pg8::cvt_pk_bf16(lo, hi); }
__device__ __forceinline__ float bf2f(unsigned short v) { return __uint_as_float((unsigned)v << 16); }
__device__ __forceinline__ float bflo(unsigned w) { return __uint_as_float(w << 16); }
__device__ __forceinline__ float bfhi(unsigned w) { return __uint_as_float(w & 0xffff0000u); }
__device__ __forceinline__ float dot2(unsigned a, unsigned b, float acc) { return __builtin_amdgcn_fdot2_f32_bf16(__builtin_bit_cast(bf16x2_t, a), __builtin_bit_cast(bf16x2_t, b), acc, false); }
__device__ __forceinline__ float wave_sum(float v) {
#pragma unroll
    for (int o = 1; o < 64; o <<= 1) v += __shfl_xor(v, o);
    return v;
}
__device__ __forceinline__ float pair_max(float x) { auto t = __builtin_amdgcn_permlane32_swap(__float_as_uint(x), __float_as_uint(x), false, false); return fmaxf(__uint_as_float(t[0]), __uint_as_float(t[1])); }
__device__ __forceinline__ float pair_sum(float x) { auto t = __builtin_amdgcn_permlane32_swap(__float_as_uint(x), __float_as_uint(x), false, false); return __uint_as_float(t[0]) + __uint_as_float(t[1]); }

#define XB_TMO      128
#define XB_XCNT(j)  (256  + 64 * (j))
#define XB_XSUB(j)  (1280 + 64 * (j))
#define XB_XGEN(j)  (2304 + 64 * (j))
#define XB_TOP      3328
#define XB_TOPGEN   3392
#define XCD_BAR_WORDS 3456
#define XB_SPIN_CAP (1u << 18)

__device__ __forceinline__ unsigned xb_ld(unsigned* p)              { return __hip_atomic_load(p, __ATOMIC_RELAXED, __HIP_MEMORY_SCOPE_AGENT); }
__device__ __forceinline__ unsigned xb_add(unsigned* p, unsigned v) { return __hip_atomic_fetch_add(p, v, __ATOMIC_RELAXED, __HIP_MEMORY_SCOPE_AGENT); }
__device__ __forceinline__ unsigned xb_xcc_id() { return (unsigned)__builtin_amdgcn_s_getreg((3 << 11) | 20) & 0xFu; }
#define XB_SPIN(cond, bar) do { unsigned _sp = 0; while (cond) { __builtin_amdgcn_s_sleep(1); \
    if ((++_sp & 255u) == 0u) { if (xb_ld(&(bar)[XB_TMO])) break; if (_sp > XB_SPIN_CAP) { atomicAdd(&(bar)[XB_TMO], 1u); break; } } } } while (0)

struct XcdBarrier {
    unsigned* bar; unsigned x;
    volatile LAS unsigned* st;
};
__device__ __forceinline__ XcdBarrier xcd_barrier_post(unsigned* bar, volatile LAS unsigned* st) {
    XcdBarrier b; b.bar = bar; b.x = xb_xcc_id(); b.st = st;
    if (threadIdx.x == 0) (void)xb_add(&bar[XB_XCNT(b.x)], 1u);
    return b;
}
__device__ __forceinline__ void xcd_barrier_complete(unsigned* bar, unsigned x, unsigned& nloc, unsigned& nx) {
    const unsigned G = gridDim.x * gridDim.y * gridDim.z;
    unsigned sum, cnt, mine, sp = 0u;
    for (;;) {
        sum = 0u; cnt = 0u; mine = 0u;
#pragma unroll
        for (unsigned j = 0; j < 16; ++j) { const unsigned c = xb_ld(&bar[XB_XCNT(j)]); sum += c; cnt += (c > 0u) ? 1u : 0u; mine = (j == x) ? c : mine; }
        if (sum == G) break;
        __builtin_amdgcn_s_sleep(1);
        if ((++sp & 255u) == 0u) { if (xb_ld(&bar[XB_TMO])) break; if (sp > XB_SPIN_CAP) { atomicAdd(&bar[XB_TMO], 1u); break; } }
    }
    nloc = mine > 0u ? mine : 1u; nx = cnt > 0u ? cnt : 1u;
}
__device__ __forceinline__ void xcd_barrier(const XcdBarrier& b) {
    asm volatile("s_waitcnt vmcnt(0)" ::: "memory");
    __syncthreads();
    if (threadIdx.x == 0) {
        unsigned* bar = b.bar;
        __builtin_amdgcn_s_waitcnt(0);
        unsigned nloc = b.st[0], nx = b.st[1];
        if (nloc == 0u) { xcd_barrier_complete(bar, b.x, nloc, nx); b.st[0] = nloc; b.st[1] = nx; }
        const unsigned old = xb_add(&bar[XB_XSUB(b.x)], 1u);
        const unsigned gen = old / nloc;
        if (old + 1u == (gen + 1u) * nloc) {
            __builtin_amdgcn_fence(__ATOMIC_RELEASE, "agent");
            asm volatile("s_waitcnt vmcnt(0)" ::: "memory");
            const unsigned og = xb_add(&bar[XB_TOP], 1u);
            const unsigned tg = og / nx;
            if (og + 1u == (tg + 1u) * nx) xb_add(&bar[XB_TOPGEN], 1u);
            else XB_SPIN(xb_ld(&bar[XB_TOPGEN]) == tg, bar);
            __builtin_amdgcn_fence(__ATOMIC_ACQUIRE, "agent");
            xb_add(&bar[XB_XGEN(b.x)], 1u);
            asm volatile("s_waitcnt vmcnt(0)" ::: "memory");
        } else {
            XB_SPIN(xb_ld(&bar[XB_XGEN(b.x)]) == gen, bar);
            __builtin_amdgcn_fence(__ATOMIC_ACQUIRE, "agent");
            asm volatile("s_waitcnt vmcnt(0)" ::: "memory");
        }
    }
    __syncthreads();
}
constexpr int NWAVES = 8;
constexpr int N_PHASES = 14;
constexpr int NB = 4, SEQ = 2048, T = NB * SEQ, D = 2048;
constexpr int MLA_H = 16, MLA_QK = 192, MLA_NOPE = 128, MLA_ROPE = 64, MLA_IN = 1088, MLA_INP = 1280, MLA_QN = 3072;
constexpr int FOX_H = 16, FOX_HD = 128, FOX_ZN = 6144;
constexpr int PE_H = 8, PE_NK = 128, PE_TOPK = 16, PE_NE = 16384, PE_SEL = 128;
constexpr float RMS_EPS = 1e-6f, LOG2E = 1.4426950408889634f;

constexpr size_t MiB = 1u << 20;
constexpr size_t WS_CTL = 0, CTL_ZERO_BYTES = 1 * MiB;
constexpr size_t WS_SSQ = 1 * MiB;
constexpr size_t WS_WF = WS_SSQ + 2 * MiB;
constexpr size_t WS_SKB = WS_WF + 128 * 1024;
constexpr size_t WS_LF = WS_SKB + 128 * 1024;
constexpr size_t WS_WT_MLA_IN = 5 * MiB;
constexpr size_t WS_WT_QB = WS_WT_MLA_IN + 5 * MiB;
constexpr size_t WS_WT_KVB = WS_WT_QB + 3 * MiB;
constexpr size_t WS_WT_MLA_O = WS_WT_KVB + 4 * MiB;
constexpr size_t WS_WT_FOX_IN = WS_WT_MLA_O + 8 * MiB;
constexpr size_t WS_WT_FOX_O = WS_WT_FOX_IN + 32 * MiB;
constexpr size_t WS_WT_PQ = WS_WT_FOX_O + 8 * MiB;
constexpr size_t WS_PU = WS_WT_PQ + 16 * MiB;
constexpr size_t WS_PV = WS_PU + 64 * MiB;
constexpr size_t WS_PSU = WS_PV + 64 * MiB, WS_PSV = WS_PSU + 128 * 1024;
constexpr size_t WS_XB = WS_PSU + 1 * MiB;
constexpr size_t WS_O = WS_XB + 32 * MiB;
constexpr size_t WS_QP = WS_O + 32 * MiB;
constexpr size_t WS_VT = WS_QP + 32 * MiB;
constexpr size_t WS_ACT = WS_VT + 32 * MiB;
constexpr size_t WS_Z0 = WS_ACT;
constexpr size_t WS_Q = WS_Z0 + 20 * MiB;
constexpr size_t WS_KN = WS_Q + 48 * MiB;
constexpr size_t WS_KM = WS_KN + 32 * MiB;
constexpr size_t WS_KRG = WS_KM;
constexpr size_t WS_RCKV = WS_KM + 2 * MiB, WS_KRSS = WS_RCKV + 256 * 1024;
constexpr size_t WS_ROPE = WS_KM + 4 * MiB;
constexpr size_t WS_KSQM = WS_KM + 8 * MiB;
constexpr size_t WS_Z = WS_ACT;
constexpr size_t WS_KSQ = WS_ACT + 100 * MiB;
constexpr size_t WS_END = WS_KM + 48 * MiB;
static_assert(WS_Z + 96 * MiB <= WS_END, "ws map");
constexpr int SSQ_X0 = 0, SSQ_X2 = T, SSQ_CQ = 2 * T, SSQ_CKV = 10 * T, SSQ_XS = 18 * T;
constexpr int CW_BAR = 4096;

constexpr int RING_OFF = 0, RING_BYTES = 131072;
constexpr int LDS_BYTES = 163840;
constexpr int LDSCTL_OFF = LDS_BYTES - 1024, MISC_OFF = LDSCTL_OFF + 320;

struct Frame {
    LAS unsigned char* lds;
    int tid, lane, wave, vcu, G;
    unsigned char* ws;
    float* out;
};

__device__ __forceinline__ void transpose_item(const float* W, int ldw, int k0, int n0src, const float* gain, bf16* WT, int K, int dstrow0, LAS float* scr, int lane) {
    const int r4 = lane >> 4, c4 = (lane & 15) * 4; f32x4 v[16];
    const float* src = W + (size_t)(k0 + r4) * ldw + n0src + c4;
#pragma unroll
    for (int i = 0; i < 16; ++i) v[i] = *(const f32x4*)(src + (size_t)(4 * i) * ldw);
#pragma unroll
    for (int i = 0; i < 16; ++i) { const int kk = 4 * i + r4; const float gk = gain ? gain[k0 + kk] : 1.f; LAS float* d = scr + kk * 65 + c4; d[0] = v[i].x * gk; d[1] = v[i].y * gk; d[2] = v[i].z * gk; d[3] = v[i].w * gk; }
    asm volatile("s_waitcnt lgkmcnt(0)" ::: "memory");
    const int c = lane & 7;
#pragma unroll
    for (int j = 0; j < 8; ++j) { const int n = (lane >> 3) + 8 * j; const LAS float* s = scr + (8 * c) * 65 + n;
        v4u o; o.x = pk2(s[0 * 65], s[1 * 65]); o.y = pk2(s[2 * 65], s[3 * 65]); o.z = pk2(s[4 * 65], s[5 * 65]); o.w = pk2(s[6 * 65], s[7 * 65]);
        *(v4u*)(WT + (size_t)(dstrow0 + n) * K + k0 + 8 * c) = o; }
    asm volatile("s_waitcnt lgkmcnt(0)" ::: "memory");
}
struct In {
    const float* x; const int* pos; const float *g_mix, *g_ffn, *mla_w_in, *mla_g_qa, *mla_w_qb, *mla_g_kva, *mla_w_kvb, *mla_g_q, *mla_g_k, *mla_w_o,
        *fox_w_in, *fox_b_f, *fox_g_q, *fox_g_k, *fox_w_o, *pe_wq, *pe_sk, *pe_u, *pe_v;
};
__device__ __forceinline__ void prologue_transpose_item(const In& I, unsigned char* ws, LAS float* scr, int lane, int it) {
    constexpr int I1 = 17 * 32, I2 = 48 * 8, I3 = 64 * 8, I4 = 32 * 32, I5 = 128 * 32, I6 = 32 * 32, I7 = 32 * 32;
        int r = it;
        if (r < I1) { const int kb = r / 17, nb = r % 17; transpose_item(I.mla_w_in, MLA_IN, 64 * kb, 64 * nb, I.g_mix, (bf16*)(ws + WS_WT_MLA_IN), 2048, 64 * nb, scr, lane); return; } r -= I1;
        if (r < I2) { const int kb = r / 48, nb = r % 48; transpose_item(I.mla_w_qb, 3072, 64 * kb, 64 * nb, I.mla_g_qa, (bf16*)(ws + WS_WT_QB), 512, 64 * nb, scr, lane); return; } r -= I2;
        if (r < I3) { const int kb = r / 64, nb = r % 64, n0 = 64 * nb, h = n0 >> 8, part = (n0 >> 7) & 1, d0 = n0 & 127;
            transpose_item(I.mla_w_kvb, 4096, 64 * kb, n0, I.mla_g_kva, (bf16*)(ws + WS_WT_KVB), 512, part * 2048 + h * 128 + d0, scr, lane); return; } r -= I3;
        if (r < I4) { const int kb = r / 32, nb = r % 32; transpose_item(I.mla_w_o, 2048, 64 * kb, 64 * nb, nullptr, (bf16*)(ws + WS_WT_MLA_O), 2048, 64 * nb, scr, lane); return; } r -= I4;
        if (r < I5) { const int kb = r / 128, nb = r % 128, n0 = 64 * nb, sec = n0 >> 11, dsec = (sec == 0) ? 0 : (sec == 1) ? 1 : (sec == 2) ? 3 : 2;
            transpose_item(I.fox_w_in, 8208, 64 * kb, n0, I.g_mix + 2048, (bf16*)(ws + WS_WT_FOX_IN), 2048, dsec * 2048 + (n0 & 2047), scr, lane); return; } r -= I5;
        if (r < I6) { const int kb = r / 32, nb = r % 32; transpose_item(I.fox_w_o, 2048, 64 * kb, 64 * nb, nullptr, (bf16*)(ws + WS_WT_FOX_O), 2048, 64 * nb, scr, lane); return; } r -= I6;
        if (r < I7) { const int kb = r / 32, nb = r % 32; transpose_item(I.pe_wq, 2048, 64 * kb, 64 * nb, I.g_ffn, (bf16*)(ws + WS_WT_PQ), 2048, 64 * nb, scr, lane); return; } r -= I7;
        { const int kb = r / 32, nb = r % 32; transpose_item(I.pe_wq + (size_t)2048 * 2048, 2048, 64 * kb, 64 * nb, I.g_ffn + 2048, (bf16*)(ws + WS_WT_PQ + 8 * MiB), 2048, 64 * nb, scr, lane); }
}
__device__ __forceinline__ void quant_pair(const In& I, unsigned char* ws, int lane, int row0) {
        f32x4 v[2][8]; float mx[2] = {0.f, 0.f};
#pragma unroll
        for (int u = 0; u < 2; ++u) { const int row = row0 + u, tbl = row >> 15, rr = row & 32767; const f32x4* src = (const f32x4*)((tbl ? I.pe_v : I.pe_u) + (size_t)rr * D) + lane;
#pragma unroll
            for (int q = 0; q < 8; ++q) v[u][q] = __builtin_nontemporal_load(src + 64 * q); }
#pragma unroll
        for (int u = 0; u < 2; ++u) {
#pragma unroll
            for (int i = 0; i < 8; ++i) { const f32x4 t = v[u][i]; mx[u] = fmaxf(mx[u], fmaxf(fmaxf(fabsf(t.x), fabsf(t.y)), fmaxf(fabsf(t.z), fabsf(t.w)))); }
#pragma unroll
            for (int o = 1; o < 64; o <<= 1) mx[u] = fmaxf(mx[u], __shfl_xor(mx[u], o));
        }
#pragma unroll
        for (int u = 0; u < 2; ++u) { const int row = row0 + u, tbl = row >> 15, rr = row & 32767;
            const float top = tbl ? 440.f : 127.f;
            const float inv = mx[u] > 0.f ? top / mx[u] : 1.f, sc = mx[u] > 0.f ? mx[u] / top : 1.f;
            v4u* dst = (v4u*)(ws + (tbl ? WS_PV : WS_PU) + (size_t)rr * D) + lane; unsigned dq[8];
#pragma unroll
            for (int q = 0; q < 8; ++q) { const f32x4 t = v[u][q] * inv; int w = 0;
                if (tbl) { w = __builtin_amdgcn_cvt_pk_fp8_f32(t.x, t.y, w, false); w = __builtin_amdgcn_cvt_pk_fp8_f32(t.z, t.w, w, true); }
                else w = (__float2int_rn(t.x) & 255) | ((__float2int_rn(t.y) & 255) << 8) | ((__float2int_rn(t.z) & 255) << 16) | (__float2int_rn(t.w) << 24);
                dq[q] = (unsigned)w; }
            if (tbl) {
#pragma unroll
                for (int q = 0; q < 8; ++q) ((unsigned*)dst)[64 * q - 3 * lane] = dq[q];
            } else { dst[0] = (v4u){dq[0], dq[1], dq[2], dq[3]}; dst[64] = (v4u){dq[4], dq[5], dq[6], dq[7]}; }
            if (lane == 0) ((float*)(ws + (tbl ? WS_PSV : WS_PSU)))[rr] = sc; }
}
constexpr int PE_FILL2 = 6144;
__device__ __forceinline__ void p_table_fill(const Frame& F, const In& I, int row_lo, int nrows, int w, int NW) {
    for (int r = 2 * w; r < nrows; r += 2 * NW) quant_pair(I, F.ws, F.lane, row_lo + r);
}
__device__ __forceinline__ void p_prologue(const Frame& F, const In& I) {
    LAS float* scr = (LAS float*)(F.lds + RING_OFF + F.wave * 16640);
    const int gw = F.vcu * NWAVES + F.wave, NGW = F.G * NWAVES, lane = F.lane;
    unsigned char* ws = F.ws;
    constexpr int I1 = 17 * 32, I2 = 48 * 8, I3 = 64 * 8, I4 = 32 * 32, I5 = 128 * 32, I6 = 32 * 32, I7 = 32 * 32, I8 = 32 * 32;
    constexpr int NITEMS = I1 + I2 + I3 + I4 + I5 + I6 + I7 + I8;
    const int gt = F.vcu * 512 + F.tid, NGT = F.G * 512;
    for (int i = gt; i < 49152; i += NGT) ((v4u*)(ws + WS_WT_MLA_IN + (size_t)MLA_IN * 2048 * 2))[i] = (v4u){0u, 0u, 0u, 0u};
    for (int i = gt; i < 16 * 2048; i += NGT) { const int j = i >> 11, k = i & 2047; ((float*)(ws + WS_WF))[i] = I.fox_w_in[(size_t)k * 8208 + 8192 + j] * I.g_mix[2048 + k]; }
    for (int i = gt; i < 2 * 2 * 128 * 128; i += NGT) ((bf16*)(ws + WS_SKB))[i] = (bf16)f2bf(I.pe_sk[i]);
    for (int m = gw; m < T; m += NGW) {
        const f32x4* xr = (const f32x4*)(I.x + (size_t)m * D) + lane; f32x4 v[8]; float s = 0.f;
#pragma unroll
        for (int j = 0; j < 8; ++j) { v[j] = xr[64 * j]; s += (v[j].x * v[j].x + v[j].y * v[j].y) + (v[j].z * v[j].z + v[j].w * v[j].w); }
        s = wave_sum(s); if (lane == 0) ((float*)(ws + WS_SSQ))[SSQ_X0 + m] = s;
        v2u* o = (v2u*)(ws + WS_XB + (size_t)m * D * 2) + lane;
#pragma unroll
        for (int j = 0; j < 8; ++j) { v2u w; w.x = pk2(v[j].x, v[j].y); w.y = pk2(v[j].z, v[j].w); o[64 * j] = w; }
    }
    int tit = gw, tk3 = 0;
    constexpr int NPRO = 65536 - 16384 - PE_FILL2;
    for (int vr = 2 * gw; vr < NPRO || tit < NITEMS; vr += 2 * NGW, ++tk3) {
        if ((tk3 % 3 == 0 || vr >= NPRO) && tit < NITEMS) { prologue_transpose_item(I, ws, scr, lane, tit); tit += NGW; }
        if (vr >= NPRO) continue;
        const int row0 = vr < 16384 ? vr : vr < 32768 ? 32768 + (vr - 16384) : 49152 + PE_FILL2 + (vr - 32768);
        quant_pair(I, ws, lane, row0);
    }
}

__device__ __forceinline__ void p_mla_tok(const Frame& F, const In& I) {
    const int gw = F.vcu * NWAVES + F.wave, NGW = F.G * NWAVES, lane = F.lane;
    const bf16* z0 = (const bf16*)(F.ws + WS_Z0); const float* sq = (const float*)(F.ws + WS_SSQ);
    const float gk2 = I.mla_g_k[128 + lane];
    const float inv_freq = __builtin_amdgcn_exp2f(-13.287712379549449f * (float)(2 * (lane & 31)) * (1.f / 64.f));
    for (int tok = gw; tok < T; tok += NGW) {
        const float ang = (float)I.pos[tok] * inv_freq; const float cs = __cosf(ang), sn = __sinf(ang);
        const float kr = bf2f(z0[(size_t)tok * MLA_INP + 1024 + lane]); const float kr_ss = wave_sum(kr * kr);
        const float krg = kr * gk2, pb = __shfl_xor(krg, 32);
        const float rot = (lane < 32) ? (krg * cs - pb * sn) : (krg * cs + pb * sn);
        ((bf16*)(F.ws + WS_KRG))[(size_t)tok * 64 + lane] = (bf16)f2bf(rot);
        ((float*)(F.ws + WS_ROPE))[(size_t)tok * 64 + lane] = (lane < 32) ? cs : sn;
        if (lane == 0) { ((float*)(F.ws + WS_RCKV))[tok] = __builtin_amdgcn_rsqf(pg8::slot_sum(sq + SSQ_CKV + (size_t)tok * 8, 8) * (1.f / 512.f) + RMS_EPS); ((float*)(F.ws + WS_KRSS))[tok] = kr_ss; }
    }
}

__device__ __forceinline__ void p_fox_prep(const Frame& F, const In& I) {
    const int gw = F.vcu * NWAVES + F.wave, NGW = F.G * NWAVES, lane = F.lane;
    bf16* z = (bf16*)(F.ws + WS_Z);
    const float QS = 0.08838834764831845f * LOG2E;
    const float gq0 = I.fox_g_q[lane], gq1 = I.fox_g_q[64 + lane], gk0 = I.fox_g_k[lane], gk1 = I.fox_g_k[64 + lane];
    for (int tok = gw; tok < T; tok += NGW) {
        bf16* zr = z + (size_t)tok * FOX_ZN;
        for (int h = 0; h < FOX_H; ++h) {
            bf16* qp = zr + h * 128; bf16* kp = zr + 2048 + h * 128;
            float a0 = bf2f(qp[lane]), a1 = bf2f(qp[64 + lane]), b0 = bf2f(kp[lane]), b1 = bf2f(kp[64 + lane]);
            const float rq = __builtin_amdgcn_rsqf(wave_sum(a0 * a0 + a1 * a1) * (1.f / 128.f) + RMS_EPS) * QS;
            const float rk = __builtin_amdgcn_rsqf(wave_sum(b0 * b0 + b1 * b1) * (1.f / 128.f) + RMS_EPS);
            qp[lane] = (bf16)f2bf(a0 * rq * gq0); qp[64 + lane] = (bf16)f2bf(a1 * rq * gq1);
            kp[lane] = (bf16)f2bf(b0 * rk * gk0); kp[64 + lane] = (bf16)f2bf(b1 * rk * gk1);
        }
    }
}

struct AttnAux { const float *gq, *gk, *ksq, *cqs, *rope, *rckv, *krss; const bf16* krg; };
template <int DK> struct AttnCfg { static constexpr int KP = DK + 8, KB_BYTES = 64 * KP * 2, VP = 72, VB_BYTES = 128 * VP * 2, NKS = DK / 16, KPT = (64 * DK / 8) / 512,
    OFF_K = 0, OFF_V = 2 * KB_BYTES, OFF_CL = OFF_V + 2 * VB_BYTES, OFF_WS = OFF_CL + 8192, OFF_RK = OFF_WS + 64, END = OFF_RK + 8192; };
template <int DK, bool FOX>
__device__ __forceinline__ void attn_unit(LAS unsigned char* lds, const bf16* __restrict__ Q, int qpitch, const bf16* __restrict__ K, int kpitch, const bf16* __restrict__ Vt, bf16* __restrict__ O,
                                          const bf16* __restrict__ gate, int gpitch, const float* __restrict__ lf, const AttnAux& ax,
                                          int b, int h, int qb, int tid, int wid, int lane) {
    const float* __restrict__ gq = ax.gq; const float* __restrict__ gk = ax.gk; const float* __restrict__ ksq = ax.ksq;
    typedef AttnCfg<DK> C;
    static_assert(C::END <= RING_BYTES, "attention LDS");
    asm volatile("" : "+v"(tid), "+v"(lane));
    const int r = lane & 31, hh = lane >> 5;
    const int tok0 = b * SEQ, q0 = qb * 256 + wid * 32, jw = q0 >> 6, jmax = qb * 4 + 3;
    constexpr int KPPR = DK / 8 + 1, KNI = 64 * KPPR / 64, VPPR = 9, VNI = 128 * VPPR / 64;
    static_assert(KPPR * 16 == C::KP * 2 && VPPR * 16 == C::VP * 2, "LDS pitches");
    const char* kbase_u = (const char*)(K + (size_t)tok0 * kpitch + h * (FOX ? DK : 128)); const char* vbase_u = (const char*)(Vt + (size_t)h * 128 * T + tok0);
    const char* krbase_u = FOX ? kbase_u : (const char*)(ax.krg + (size_t)tok0 * 64);
    unsigned kg[4], vg[3]; bool kr_[4];
#pragma unroll
    for (int i = 0; i < 4; ++i) { const int p = 64 * (wid + 8 * i) + lane, key = p / KPPR, c = p % KPPR;
        if (FOX) { kr_[i] = false; kg[i] = (unsigned)(key * kpitch + (c < DK / 8 ? c * 8 : 0)) * 2u; }
        else { kr_[i] = (c >= 16 && c < 24); kg[i] = kr_[i] ? (unsigned)(key * 64 + 8 * (c - 16)) * 2u : (unsigned)(key * kpitch + (c < 16 ? c * 8 : 0)) * 2u; } }
#pragma unroll
    for (int i = 0; i < 3; ++i) { const int p = 64 * (wid + 8 * i) + lane, dv = p / VPPR, c = p % VPPR; vg[i] = (unsigned)(dv * T + (c < 8 ? c * 8 : 0)) * 2u; }
#define ATT_STAGE(j, buf) do { const char* _kb = kbase_u + (size_t)(j) * 64 * kpitch * 2; const char* _rb = krbase_u + (size_t)(j) * 64 * 64 * 2; const char* _vb = vbase_u + (size_t)(j) * 128; \
        _Pragma("unroll") for (int i = 0; i < 4; ++i) if (wid + 8 * i < KNI) __builtin_amdgcn_global_load_lds((const unsigned*)(((!FOX && kr_[i]) ? _rb : _kb) + kg[i]), (LAS unsigned*)(lds + C::OFF_K + (buf) * C::KB_BYTES + 1024 * (wid + 8 * i)), 16, 0, 0); \
        _Pragma("unroll") for (int i = 0; i < 3; ++i) if (wid + 8 * i < VNI) __builtin_amdgcn_global_load_lds((const unsigned*)(_vb + vg[i]), (LAS unsigned*)(lds + C::OFF_V + (buf) * C::VB_BYTES + 1024 * (wid + 8 * i)), 16, 0, 0); } while (0)
#define ATT_SYNC() do { asm volatile("s_waitcnt vmcnt(0)" ::: "memory"); __syncthreads(); } while (0)
    ATT_STAGE(jmax, 0);
    bf16x8 qf[C::NKS];
    {
        LAS unsigned char* qst = lds + C::END + wid * 4608;
        const int rr_ = lane >> 3, cc_ = lane & 7;
        v4u qg[C::NKS / 4][4];
#pragma unroll
        for (int rd = 0; rd < C::NKS / 4; ++rd)
#pragma unroll
            for (int i = 0; i < 4; ++i) qg[rd][i] = *(const v4u*)(Q + (size_t)(tok0 + q0 + 8 * i + rr_) * qpitch + h * DK + 64 * rd + 8 * cc_);
#pragma unroll
        for (int rd = 0; rd < C::NKS / 4; ++rd) {
#pragma unroll
            for (int i = 0; i < 4; ++i) *(LAS v4u*)(qst + (8 * i + rr_) * 144 + cc_ * 16) = qg[rd][i];
            asm volatile("s_waitcnt lgkmcnt(0)" ::: "memory");
#pragma unroll
            for (int k4 = 0; k4 < 4; ++k4) qf[4 * rd + k4] = *(const LAS bf16x8*)(qst + r * 144 + k4 * 32 + hh * 16);
            asm volatile("s_waitcnt lgkmcnt(0)" ::: "memory");
        }
    }
    LAS float* cl = (LAS float*)(lds + C::OFF_CL);
    LAS float* rkl = (LAS float*)(lds + C::OFF_RK);
    if constexpr (FOX) {
        LAS float* wsum = (LAS float*)(lds + C::OFF_WS);
        const int n = (qb + 1) * 256; float v[4]; f32x4 kqv[4];
        { const f32x4 t4 = *(const f32x4*)(lf + (size_t)h * T + tok0 + 4 * tid);
#pragma unroll
          for (int e = 0; e < 4; ++e) v[e] = (4 * tid + e < n) ? t4[e] : 0.f; }
#pragma unroll
        for (int e = 0; e < 4; ++e) kqv[e] = *(const f32x4*)(ksq + ((size_t)h * T + tok0 + tid + 512 * e) * 4);
        {
            float ss = 0.f;
#pragma unroll
            for (int ks = 0; ks < C::NKS; ++ks)
#pragma unroll
                for (int j = 0; j < 8; ++j) { const float v_ = bf2f((unsigned short)qf[ks][j]); ss += v_ * v_; }
            ss = pair_sum(ss);
            const float rq = __builtin_amdgcn_rsqf(ss * (1.f / 128.f) + RMS_EPS) * (0.08838834764831845f * LOG2E);
#pragma unroll
            for (int ks = 0; ks < C::NKS; ++ks) { const int d0 = 16 * ks + 8 * hh; const f32x4 ga = *(const f32x4*)(gq + d0), gb = *(const f32x4*)(gq + d0 + 4), ka = *(const f32x4*)(gk + d0), kb2 = *(const f32x4*)(gk + d0 + 4);
                v4u w; w.x = pk2(bf2f((unsigned short)qf[ks][0]) * rq * ga.x * ka.x, bf2f((unsigned short)qf[ks][1]) * rq * ga.y * ka.y); w.y = pk2(bf2f((unsigned short)qf[ks][2]) * rq * ga.z * ka.z, bf2f((unsigned short)qf[ks][3]) * rq * ga.w * ka.w);
                w.z = pk2(bf2f((unsigned short)qf[ks][4]) * rq * gb.x * kb2.x, bf2f((unsigned short)qf[ks][5]) * rq * gb.y * kb2.y); w.w = pk2(bf2f((unsigned short)qf[ks][6]) * rq * gb.z * kb2.z, bf2f((unsigned short)qf[ks][7]) * rq * gb.w * kb2.w);
                qf[ks] = __builtin_bit_cast(bf16x8, w); }
        }
        v[1] += v[0]; v[2] += v[1]; v[3] += v[2];
        const float tot = v[3]; float sc = tot;
#pragma unroll
        for (int o = 1; o < 64; o <<= 1) { const float t = __shfl_up(sc, o); if (lane >= o) sc += t; }
        if (lane == 63) wsum[wid] = sc;
#pragma unroll
        for (int e = 0; e < 4; ++e) rkl[tid + 512 * e] = __builtin_amdgcn_rsqf(((kqv[e].x + kqv[e].y) + (kqv[e].z + kqv[e].w)) * (1.f / 128.f) + RMS_EPS);
        __syncthreads();
        float base = 0.f;
#pragma unroll
        for (int w = 0; w < 8; ++w) base += (w < wid) ? wsum[w] : 0.f;
        const float excl = base + sc - tot;
#pragma unroll
        for (int e = 0; e < 4; ++e) cl[4 * tid + e] = (excl + v[e]) * LOG2E;
    }
    if constexpr (!FOX) {
        f32x4 kqm[4]; float rcm[4], krm[4];
        { const int n = (qb + 1) * 256;
#pragma unroll
          for (int e = 0; e < 4; ++e) { const int sx = tid + 512 * e; kqm[e] = *(const f32x4*)(ksq + ((size_t)h * T + tok0 + sx) * 4); rcm[e] = ax.rckv[tok0 + sx]; krm[e] = ax.krss[tok0 + sx]; } (void)n; }
        {
            const int tokq = tok0 + q0 + r;
            const float rcq = __builtin_amdgcn_rsqf(pg8::slot_sum(ax.cqs + (size_t)tokq * 8, 8) * (1.f / 512.f) + RMS_EPS);
            float ss = 0.f;
#pragma unroll
            for (int ks = 0; ks < C::NKS; ++ks)
#pragma unroll
                for (int j = 0; j < 8; ++j) { const float v = bf2f((unsigned short)qf[ks][j]); ss += v * v; }
            ss = pair_sum(ss) * rcq * rcq;
            const float sc = rcq * __builtin_amdgcn_rsqf(ss * (1.f / 192.f) + RMS_EPS) * (0.07216878364870322f * LOG2E);
#pragma unroll
            for (int ks = 0; ks < 8; ++ks) { const int d0 = 16 * ks + 8 * hh; const f32x4 ga = *(const f32x4*)(gq + d0), gb = *(const f32x4*)(gq + d0 + 4), ka = *(const f32x4*)(gk + d0), kb2 = *(const f32x4*)(gk + d0 + 4);
                v4u w; w.x = pk2(bf2f((unsigned short)qf[ks][0]) * sc * ga.x * ka.x, bf2f((unsigned short)qf[ks][1]) * sc * ga.y * ka.y); w.y = pk2(bf2f((unsigned short)qf[ks][2]) * sc * ga.z * ka.z, bf2f((unsigned short)qf[ks][3]) * sc * ga.w * ka.w);
                w.z = pk2(bf2f((unsigned short)qf[ks][4]) * sc * gb.x * kb2.x, bf2f((unsigned short)qf[ks][5]) * sc * gb.y * kb2.y); w.w = pk2(bf2f((unsigned short)qf[ks][6]) * sc * gb.z * kb2.z, bf2f((unsigned short)qf[ks][7]) * sc * gb.w * kb2.w);
                qf[ks] = __builtin_bit_cast(bf16x8, w); }
#pragma unroll
            for (int kk = 0; kk < 2; ++kk) { const int i0 = 16 * kk + 8 * hh; const float* rp = ax.rope + (size_t)tokq * 64 + i0;
                const f32x4 c0 = *(const f32x4*)rp, c1 = *(const f32x4*)(rp + 4), s0_ = *(const f32x4*)(rp + 32), s1_ = *(const f32x4*)(rp + 36);
                const f32x4 g10 = *(const f32x4*)(gq + 128 + i0), g11 = *(const f32x4*)(gq + 132 + i0), g20 = *(const f32x4*)(gq + 160 + i0), g21 = *(const f32x4*)(gq + 164 + i0);
                float o1[8], o2[8];
#pragma unroll
                for (int j = 0; j < 8; ++j) { const float cj = j < 4 ? c0[j & 3] : c1[j & 3], sj = j < 4 ? s0_[j & 3] : s1_[j & 3], g1 = j < 4 ? g10[j & 3] : g11[j & 3], g2 = j < 4 ? g20[j & 3] : g21[j & 3];
                    const float x1 = bf2f((unsigned short)qf[8 + kk][j]) * sc * g1, x2 = bf2f((unsigned short)qf[10 + kk][j]) * sc * g2; o1[j] = x1 * cj - x2 * sj; o2[j] = x2 * cj + x1 * sj; }
                v4u w1, w2; w1.x = pk2(o1[0], o1[1]); w1.y = pk2(o1[2], o1[3]); w1.z = pk2(o1[4], o1[5]); w1.w = pk2(o1[6], o1[7]); w2.x = pk2(o2[0], o2[1]); w2.y = pk2(o2[2], o2[3]); w2.z = pk2(o2[4], o2[5]); w2.w = pk2(o2[6], o2[7]);
                qf[8 + kk] = __builtin_bit_cast(bf16x8, w1); qf[10 + kk] = __builtin_bit_cast(bf16x8, w2); }
        }
        {
#pragma unroll
            for (int e = 0; e < 4; ++e) { const int sx = tid + 512 * e; const f32x4 kq = kqm[e]; const float rc = rcm[e];
                const float rk = __builtin_amdgcn_rsqf((((kq.x + kq.y) + (kq.z + kq.w)) + krm[e]) * (1.f / 192.f) + RMS_EPS); rkl[sx] = rk; (void)rc; }
        }
    }
    f32x16 o[4];
#pragma unroll
    for (int i = 0; i < 4; ++i)
#pragma unroll
        for (int e = 0; e < 16; ++e) o[i][e] = 0.f;
    float m = -1e30f, l = 0.f;
    ATT_SYNC();
#pragma unroll 1
    for (int jj = 0; jj <= jmax; ++jj) { const int j = jmax - jj;
        if (jj < jmax) ATT_STAGE(j - 1, (jj + 1) & 1);
        if (j <= jw) {
#pragma unroll
            for (int kb2 = 0; kb2 < 2; ++kb2) { const int kbk = 1 - kb2;
                if (FOX && kbk == 1 && j == jw && (wid & 1) == 0) continue;
                f32x16 s0;
#pragma unroll
                for (int e = 0; e < 16; ++e) s0[e] = 0.f;
                const LAS unsigned char* kb = lds + C::OFF_K + (jj & 1) * C::KB_BYTES + ((32 * kbk + r) * C::KP + 8 * hh) * 2;
                if constexpr (FOX) {
#pragma unroll
                    for (int ks = 0; ks < C::NKS; ++ks) {
                        const bf16x8 a0 = *(const LAS bf16x8*)(kb + ks * 32);
                        s0 = __builtin_amdgcn_mfma_f32_32x32x16_bf16(a0, qf[ks], s0, 0, 0, 0);
                    }
                } else {
#pragma unroll
                    for (int ks = 0; ks < 12; ++ks) { const bf16x8 a0 = *(const LAS bf16x8*)(kb + ks * 32); s0 = __builtin_amdgcn_mfma_f32_32x32x16_bf16(a0, qf[ks], s0, 0, 0, 0); }
                    const LAS f32x4* r4 = (const LAS f32x4*)(rkl + 64 * j + 32 * kbk + 4 * hh);
#pragma unroll
                    for (int g = 0; g < 4; ++g) { const f32x4 rr = r4[2 * g];
#pragma unroll
                        for (int e = 0; e < 4; ++e) s0[4 * g + e] *= rr[e]; }
                }
                if constexpr (FOX) {
                    const LAS f32x4* c4 = (const LAS f32x4*)(cl + 64 * j + 32 * kbk + 4 * hh); const LAS f32x4* r4 = (const LAS f32x4*)(rkl + 64 * j + 32 * kbk + 4 * hh);
#pragma unroll
                    for (int g = 0; g < 4; ++g) { const f32x4 c0 = c4[2 * g], rr = r4[2 * g];
#pragma unroll
                        for (int e = 0; e < 4; ++e) s0[4 * g + e] = s0[4 * g + e] * rr[e] - c0[e]; }
                    if (j == jw) {
                        const int qrow = q0 + r, kbase = 64 * j + 32 * kbk + 4 * hh;
#pragma unroll
                        for (int e = 0; e < 16; ++e) { const int key = kbase + (e & 3) + 8 * (e >> 2); if (key > qrow) s0[e] = -1e30f; }
                    }
                }
                float mx = s0[0];
#pragma unroll
                for (int e = 1; e < 16; ++e) mx = fmaxf(mx, s0[e]);
                mx = pair_max(mx);
                const float mn = fmaxf(m, mx);
                if (__any(mn > m)) {
                    const float alpha = __builtin_amdgcn_exp2f(m - mn);
                    l *= alpha;
#pragma unroll
                    for (int i = 0; i < 4; ++i)
#pragma unroll
                        for (int e = 0; e < 16; ++e) o[i][e] *= alpha;
                    m = mn;
                }
                float ps = 0.f;
#pragma unroll
                for (int e = 0; e < 16; ++e) { s0[e] = __builtin_amdgcn_exp2f(s0[e] - m); ps += s0[e]; }
                l += ps;
                bf16x8 p[2];
#pragma unroll
                for (int s = 0; s < 2; ++s) {
                    v4u w0;
                    w0.x = pk2(s0[8 * s + 0], s0[8 * s + 1]); w0.y = pk2(s0[8 * s + 2], s0[8 * s + 3]); w0.z = pk2(s0[8 * s + 4], s0[8 * s + 5]); w0.w = pk2(s0[8 * s + 6], s0[8 * s + 7]);
                    p[s] = __builtin_bit_cast(bf16x8, w0);
                }
                const LAS unsigned char* vb = lds + C::OFF_V + (jj & 1) * C::VB_BYTES + (r * C::VP + 32 * kbk + 8 * hh) * 2;
#pragma unroll
                for (int dvb = 0; dvb < 4; ++dvb)
#pragma unroll
                    for (int s = 0; s < 2; ++s) {
                        const bf16x8 a = *(const LAS bf16x8*)(vb + (dvb * 32 * C::VP + 16 * s) * 2);
                        o[dvb] = __builtin_amdgcn_mfma_f32_32x32x16_bf16(a, p[s], o[dvb], 0, 0, 0);
                    }
            }
        }
        ATT_SYNC();
    }
#undef ATT_STAGE
#undef ATT_SYNC
    l = pair_sum(l);
    const float inv = 1.f / l;
    int re = r, he = hh; asm volatile("" : "+v"(re), "+v"(he));
    static_assert(C::END + 8 * 4608 <= LDSCTL_OFF, "attention O staging");
    LAS unsigned char* ost = lds + C::END + wid * 4608;
    const int rr = lane >> 3, cc = lane & 7;
    const size_t orow0 = (size_t)(tok0 + q0);
#pragma unroll
    for (int half = 0; half < 2; ++half) {
#pragma unroll
        for (int d2 = 0; d2 < 2; ++d2)
#pragma unroll
            for (int g = 0; g < 4; ++g) { const int dvb = 2 * half + d2;
                v2u w; w.x = pk2(o[dvb][4 * g + 0] * inv, o[dvb][4 * g + 1] * inv); w.y = pk2(o[dvb][4 * g + 2] * inv, o[dvb][4 * g + 3] * inv);
                *(LAS v2u*)(ost + re * 144 + (d2 * 32 + 8 * g + 4 * he) * 2) = w; }
        asm volatile("s_waitcnt lgkmcnt(0)" ::: "memory");
#pragma unroll
        for (int i = 0; i < 4; ++i) { const int row = 8 * i + rr;
            v4u w = *(const LAS v4u*)(ost + row * 144 + cc * 16);
            if constexpr (FOX) {
                const v4u gw = *(const v4u*)(gate + (orow0 + row) * gpitch + h * 128 + half * 64 + cc * 8);
#pragma unroll
                for (int c = 0; c < 4; ++c) { const float lo = bflo(w[c]) * __builtin_amdgcn_rcpf(1.f + __builtin_amdgcn_exp2f(-LOG2E * bflo(gw[c]))), hi = bfhi(w[c]) * __builtin_amdgcn_rcpf(1.f + __builtin_amdgcn_exp2f(-LOG2E * bfhi(gw[c]))); w[c] = pk2(lo, hi); }
            }
            *(v4u*)(O + (orow0 + row) * 2048 + h * 128 + half * 64 + cc * 8) = w; }
        asm volatile("s_waitcnt lgkmcnt(0)" ::: "memory");
    }
}
template <int DK, bool FOX>
__device__ __forceinline__ void p_attention(const Frame& F, const bf16* Q, int qpitch, const bf16* K, int kpitch, const bf16* Vt, bf16* O, const bf16* gate, int gpitch, const float* lf, const AttnAux& ax) {
    for (int u = F.vcu; u < 256; u += F.G) {
        const int bh = u >> 2, p = u & 3, b = bh >> 4, h = bh & 15;
#pragma unroll 1
        for (int half = 0; half < 2; ++half)
            attn_unit<DK, FOX>(F.lds + RING_OFF, Q, qpitch, K, kpitch, Vt, O, gate, gpitch, lf, ax, b, h, half ? p : 7 - p, F.tid, F.wave, F.lane);
    }
}

__device__ __forceinline__ unsigned sortkey(float s) { const unsigned b = __float_as_uint(s); return b ^ ((unsigned)((int)b >> 31) | 0x80000000u); }
__device__ __forceinline__ float unsortkey(unsigned k) { return __uint_as_float((k & 0x80000000u) ? (k ^ 0x80000000u) : ~k); }
#define TOP_INSERT(top, x) do { unsigned _x = (x); _Pragma("unroll") for (int _i = 0; _i < 16; ++_i) { const unsigned _h = max((top)[_i], _x); _x = min((top)[_i], _x); (top)[_i] = _h; } } while (0)
__device__ __forceinline__ int sel16(const int (&a)[16], int i) { int r = a[0];
#pragma unroll
    for (int q = 1; q < 16; ++q) r = (i == q) ? a[q] : r;
    return r; }
#define CE_DESC(a, b) do { const unsigned _hi = max((a), (b)), _lo = min((a), (b)); (a) = _hi; (b) = _lo; } while (0)
__device__ __forceinline__ void bitonic_merge16_desc(unsigned (&v)[16]) {
#pragma unroll
    for (int j = 8; j > 0; j >>= 1)
#pragma unroll
        for (int i = 0; i < 16; ++i) if ((i & j) == 0) CE_DESC(v[i], v[i | j]);
}
__device__ __forceinline__ void sort16_desc(unsigned (&v)[16]) {
#pragma unroll
    for (int k = 2; k <= 16; k <<= 1)
#pragma unroll
        for (int j = k >> 1; j > 0; j >>= 1)
#pragma unroll
            for (int i = 0; i < 16; ++i) { const int l = i ^ j; if (l > i) { if ((i & k) == 0 || k == 16) CE_DESC(v[i], v[l]); else CE_DESC(v[l], v[i]); } }
}
__device__ __forceinline__ void merge_top16(unsigned (&top)[16], const unsigned (&b)[16]) {
#pragma unroll
    for (int i = 0; i < 16; ++i) top[i] = max(top[i], b[15 - i]);
    bitonic_merge16_desc(top);
}
__device__ __forceinline__ void peer_half_top16(const bf16* __restrict__ qrow  , const bf16* __restrict__ sk  , int hh, unsigned (&top)[16]) {
#pragma unroll
    for (int i = 0; i < 16; ++i) top[i] = 0u;
#pragma unroll 1
    for (int kb = 0; kb < 4; ++kb) {
        f32x16 acc;
#pragma unroll
        for (int e = 0; e < 16; ++e) acc[e] = 0.f;
        const bf16* skb = sk + (size_t)kb * 32 * 128;
#pragma unroll
        for (int ks = 0; ks < 8; ++ks) { const bf16x8 qf = *(const bf16x8*)(qrow + 16 * ks), a = *(const bf16x8*)(skb + 16 * ks); acc = __builtin_amdgcn_mfma_f32_32x32x16_bf16(a, qf, acc, 0, 0, 0); }
        const int kbase = 127 - (32 * kb + 4 * hh);
        unsigned nv[16];
#pragma unroll
        for (int e = 0; e < 16; ++e) nv[e] = (sortkey(acc[e]) & ~127u) | (unsigned)(kbase - ((e & 3) + 8 * (e >> 2)));
        sort16_desc(nv); merge_top16(top, nv);
    }
    unsigned pt[16];
#pragma unroll
    for (int i = 0; i < 16; ++i) pt[i] = (unsigned)__shfl_xor((int)top[i], 32);
    merge_top16(top, pt);
}
constexpr int PE_OFF_IDX = 0, PE_OFF_G = 16384, PE_OFF_TB = 32768;
__device__ __forceinline__ void peer_topk(const Frame& F, int layer, int t0) {
    const int lane = F.lane, r = lane & 31, hh = lane >> 5, head = F.wave;
    const bf16* qp = (const bf16*)(F.ws + WS_QP) + (size_t)(t0 + r) * 2048 + head * 256 + 8 * hh;
    const bf16* sk = (const bf16*)(F.ws + WS_SKB) + (size_t)layer * 2 * 128 * 128 + r * 128 + 8 * hh;
    unsigned t1[16], t2[16];
    peer_half_top16(qp, sk, hh, t1);
    peer_half_top16(qp + 128, sk + 128 * 128, hh, t2);
    int rr = r; asm volatile("" : "+v"(rr));
    const float rs = __builtin_amdgcn_rsqf(pg8::slot_sum((const float*)(F.ws + WS_SSQ) + SSQ_XS + (size_t)(t0 + rr) * 32, 32) * (1.f / 2048.f) + RMS_EPS);
    float v1[16], v2[16]; int e1[16], e2[16];
#pragma unroll
    for (int i = 0; i < 16; ++i) { v1[i] = unsortkey(t1[i] & ~127u) * rs; e1[i] = 127 - (int)(t1[i] & 127u); v2[i] = unsortkey(t2[i] & ~127u) * rs; e2[i] = 127 - (int)(t2[i] & 127u); }
    unsigned best[16], g1[16], g2[16], g3[16];
#pragma unroll
    for (int i = 0; i < 16; ++i) { best[i] = 0u; g1[i] = 0u; g2[i] = 0u; g3[i] = 0u; }
    { int n = 0;
#pragma unroll
      for (int i = 0; i < 16; ++i)
#pragma unroll
        for (int j = 0; j < 16; ++j)
            if ((i + 1) * (j + 1) <= 16) { const unsigned kx = (sortkey(v1[i] + v2[j]) & ~255u) | (unsigned)(255 - (i * 16 + j));
                if (n < 16) best[n & 15] = kx; else if (n < 32) g1[n & 15] = kx; else if (n < 48) g2[n & 15] = kx; else g3[n & 15] = kx; ++n; } }
    sort16_desc(best); sort16_desc(g1); sort16_desc(g2); sort16_desc(g3);
    merge_top16(best, g1); merge_top16(best, g2); merge_top16(best, g3);
    float sc[16]; int ex[16];
    LAS int* tb = (LAS int*)(F.lds + RING_OFF + PE_OFF_TB) + F.wave * 2048 + lane;
#pragma unroll
    for (int i = 0; i < 16; ++i) { tb[i * 64] = e1[i]; tb[(16 + i) * 64] = e2[i]; }
#pragma unroll
    for (int k = 0; k < 16; ++k) { const int pos = 255 - (int)(best[k] & 255u); ex[k] = tb[(pos >> 4) * 64] * PE_NK + tb[(16 + (pos & 15)) * 64]; sc[k] = unsortkey(best[k] & ~255u); }
    float sum = 0.f; const float smax = sc[0];
#pragma unroll
    for (int k = 0; k < 16; ++k) { sc[k] = __expf(sc[k] - smax); sum += sc[k]; }
    const float inv = 1.f / sum;
    LAS int* li = (LAS int*)(F.lds + RING_OFF + PE_OFF_IDX) + r * PE_SEL + head * 16;
    LAS float* lg = (LAS float*)(F.lds + RING_OFF + PE_OFF_G) + r * PE_SEL + head * 16;
    if (hh == 0) {
#pragma unroll
        for (int k = 0; k < 16; ++k) li[k] = ex[k];
    } else {
#pragma unroll
        for (int k = 0; k < 16; ++k) lg[k] = sc[k] * inv;
    }
}
__device__ __forceinline__ float group_sum64(float v) {
    const int i0 = __builtin_bit_cast(int, v);
    v += __builtin_bit_cast(float, __builtin_amdgcn_update_dpp(0, i0, 0x111, 0xf, 0xf, true));
    v += __builtin_bit_cast(float, __builtin_amdgcn_update_dpp(0, __builtin_bit_cast(int, v), 0x112, 0xf, 0xf, true));
    v += __builtin_bit_cast(float, __builtin_amdgcn_update_dpp(0, __builtin_bit_cast(int, v), 0x114, 0xf, 0xf, true));
    v += __builtin_bit_cast(float, __builtin_amdgcn_update_dpp(0, __builtin_bit_cast(int, v), 0x118, 0xf, 0xf, true));
    v += __builtin_bit_cast(float, __builtin_amdgcn_update_dpp(0, __builtin_bit_cast(int, v), 0x142, 0xa, 0xf, false));
    v += __builtin_bit_cast(float, __builtin_amdgcn_update_dpp(0, __builtin_bit_cast(int, v), 0x143, 0xc, 0xf, false));
    return v;
}
__device__ __forceinline__ float gelu_erf(float x) { return 0.5f * x * (1.f + erff(x * 0.7071067811865476f)); }
typedef float f32x2 __attribute__((ext_vector_type(2)));
__device__ __forceinline__ void sort128(unsigned& kA, unsigned& kB, int lane) {
#pragma unroll
    for (int k = 2; k <= 128; k <<= 1)
#pragma unroll
        for (int j = k >> 1; j > 0; j >>= 1) {
            if (j == 64) { const unsigned lo = min(kA, kB), hi = max(kA, kB); kA = lo; kB = hi; }
            else {
                const unsigned pA = (unsigned)__shfl_xor((int)kA, j), pB = (unsigned)__shfl_xor((int)kB, j);
                const bool lower = (lane & j) == 0, upA = (lane & k) == 0, upB = ((lane + 64) & k) == 0;
                kA = (lower == upA) ? min(kA, pA) : max(kA, pA);
                kB = (lower == upB) ? min(kB, pB) : max(kB, pB);
            }
        }
}
constexpr int PE_NS = 32, PE_SLICE = PE_NE / PE_NS;
constexpr int PE_PACE = 64;
typedef int v4i __attribute__((ext_vector_type(4)));
constexpr int PE_D = 6;
constexpr int PE2_KEYS = 0, PE2_G = 16384, PE2_A = 32768, PE2_ORD = 49152, PE2_CT = 65536, PE2_RING = 73728, PE2_END = PE2_RING + 8 * 5 * 2048;
static_assert(PE2_G == PE_OFF_G && PE2_KEYS == PE_OFF_IDX && PE2_END <= 160 * 1024 - 1024, "peer LDS map");
#define PE_WAITV(n) asm volatile("s_waitcnt vmcnt(" #n ")" ::: "memory")
template <int LAYER>
__device__ __forceinline__ void peer_gather4(const Frame& F, const In& I, int t0w, int tl0, int dry) {
    const int lane = F.lane, wv = F.wave;
    const float* gain = I.g_ffn + LAYER * 2048;
    const unsigned char* ut = F.ws + WS_PU + (size_t)LAYER * PE_NE * D + lane * 16;
    const unsigned char* vt = F.ws + WS_PV + (size_t)LAYER * PE_NE * D + lane * 16;
    const float* su = (const float*)(F.ws + WS_PSU) + LAYER * PE_NE; const float* sv = (const float*)(F.ws + WS_PSV) + LAYER * PE_NE;
    LAS unsigned* keys = (LAS unsigned*)(F.lds + RING_OFF + PE2_KEYS) + tl0 * PE_SEL;
    LAS float* lg = (LAS float*)(F.lds + RING_OFF + PE2_G) + tl0 * PE_SEL;
    LAS float* la = (LAS float*)(F.lds + RING_OFF + PE2_A) + tl0 * PE_SEL;
    LAS unsigned* ord = (LAS unsigned*)(F.lds + RING_OFF + PE2_ORD) + wv * 512;
    LAS int* ct = (LAS int*)(F.lds + RING_OFF + PE2_CT) + wv * 256;
    LAS unsigned char* ring = F.lds + RING_OFF + PE2_RING + wv * (5 * 2048);
    LAS unsigned char* ring5 = F.lds + RING_OFF + PE2_KEYS + wv * 2048;
#define PE_SLOT(sl) (((sl) < 5) ? ring + (sl) * 2048 : ring5)
    unsigned sA[4], sB[4];
#pragma unroll
    for (int tk = 0; tk < 4; ++tk) {
        sA[tk] = (keys[tk * PE_SEL + lane] << 7) | (unsigned)lane; sB[tk] = (keys[tk * PE_SEL + 64 + lane] << 7) | (unsigned)(64 + lane);
        sort128(sA[tk], sB[tk], lane);
    }
    if (lane < 4) ct[lane * 36] = 0;
#pragma unroll 1
    for (int s = 0; s < PE_NS; ++s) { const unsigned limit = (unsigned)((s + 1) * PE_SLICE) << 7;
#pragma unroll
        for (int tk = 0; tk < 4; ++tk) { const int c = __builtin_popcountll(__ballot(sA[tk] < limit)) + __builtin_popcountll(__ballot(sB[tk] < limit)); if (lane == 0) ct[tk * 36 + s + 1] = c; } }
#pragma unroll
    for (int tk = 0; tk < 4; ++tk) {
#pragma unroll
        for (int hb = 0; hb < 2; ++hb) { const unsigned key = hb ? sB[tk] : sA[tk]; const int pos = lane + 64 * hb, e = (int)(key >> 7), sl = e / PE_SLICE; int rank = pos;
#pragma unroll
            for (int t2 = 0; t2 < 4; ++t2) if (t2 != tk) rank += ct[t2 * 36 + sl + (t2 < tk ? 1 : 0)];
            ord[rank] = ((unsigned)e << 9) | (unsigned)(tk << 7) | (unsigned)pos; }
    }
    float glA[4], glB[4];
#pragma unroll
    for (int tk = 0; tk < 4; ++tk) { glA[tk] = lg[tk * PE_SEL + (sA[tk] & 127u)]; glB[tk] = lg[tk * PE_SEL + (sB[tk] & 127u)]; }
    const int bj = lane & 3, bb = lane >> 2;
    int hq[8][4]; float shl = 1.f;
    {
        LAS unsigned char* himg = ring;
#pragma unroll
        for (int tk = 0; tk < 4; ++tk) {
            const float* xrow = F.out + (size_t)(t0w + tk) * D + 4 * lane; const float* grow = gain + 4 * lane;
            const float rs = __builtin_amdgcn_rsqf(pg8::slot_sum((const float*)(F.ws + WS_SSQ) + SSQ_XS + (size_t)(t0w + tk) * 32, 32) * (1.f / 2048.f) + RMS_EPS);
            f32x4 hv[8]; float mx = 0.f;
#pragma unroll
            for (int q = 0; q < 8; ++q) { const f32x4 xv = *(const f32x4*)(xrow + 256 * q), gv = *(const f32x4*)(grow + 256 * q);
                const f32x4 t = (f32x4){xv.x * rs * gv.x, xv.y * rs * gv.y, xv.z * rs * gv.z, xv.w * rs * gv.w}; hv[q] = t;
                mx = fmaxf(mx, fmaxf(fmaxf(fabsf(t.x), fabsf(t.y)), fmaxf(fabsf(t.z), fabsf(t.w)))); }
#pragma unroll
            for (int o = 1; o < 64; o <<= 1) mx = fmaxf(mx, __shfl_xor(mx, o));
            const float inv = mx > 0.f ? 127.f / mx : 1.f; if (bj == tk) shl = mx > 0.f ? mx * (1.f / 127.f) : 1.f;
            unsigned dq[8];
#pragma unroll
            for (int q = 0; q < 8; ++q) { const f32x4 t = hv[q] * inv; dq[q] = (unsigned)((__float2int_rn(t.x) & 255) | ((__float2int_rn(t.y) & 255) << 8) | ((__float2int_rn(t.z) & 255) << 16) | (__float2int_rn(t.w) << 24)); }
            *(LAS v4u*)(himg + tk * 2048 + 16 * lane) = (v4u){dq[0], dq[1], dq[2], dq[3]}; *(LAS v4u*)(himg + tk * 2048 + 1024 + 16 * lane) = (v4u){dq[4], dq[5], dq[6], dq[7]};
            asm volatile("" ::: "memory");
        }
        asm volatile("s_waitcnt lgkmcnt(0)" ::: "memory");
#pragma unroll
        for (int s8 = 0; s8 < 8; ++s8) { const v4u t = *(const LAS v4u*)(himg + bj * 2048 + 256 * s8 + 16 * bb); hq[s8][0] = (int)t.x; hq[s8][1] = (int)t.y; hq[s8][2] = (int)t.z; hq[s8][3] = (int)t.w; }
    }
    asm volatile("s_waitcnt vmcnt(0) lgkmcnt(0)" ::: "memory");
    static_assert(PE_D == 6, "the counted wait below is vmcnt(2 * (PE_D - 1))");
#define PE_EMASK
#define PE_ISSUE(tab, code, slot) do { const unsigned char* _g = (tab) + ((size_t)((code) >> 9) << 11); \
        LAS unsigned char* _d = PE_SLOT(slot); \
        __builtin_amdgcn_global_load_lds((const unsigned*)_g, (LAS unsigned*)_d, 16, 0, 0); \
        __builtin_amdgcn_global_load_lds((const unsigned*)(_g + 1024), (LAS unsigned*)(_d + 1024), 16, 0, 0); } while (0)
#define PE_ROW_HEAD(tab) \
                    const int i6 = r & 63, ia = i6 + PE_D; const unsigned codea = (unsigned)__builtin_amdgcn_readlane((int)((ia < 64) ? oc : on), ia & 63); \
                    PE_WAITV(10); \
                    v4u w[2]; { const LAS unsigned char* _s = PE_SLOT(slot); w[0] = *(const LAS v4u*)(_s + lane * 16); w[1] = *(const LAS v4u*)(_s + 1024 + lane * 16); } \
                    asm volatile("s_waitcnt lgkmcnt(0)" ::: "memory"); \
                    PE_ISSUE(tab, codea, slot);
#define PE_ROW_TAIL() \
                    slot = (slot + 1 == PE_D) ? 0 : slot + 1; ++r; \
                    if ((r & 63) == 0) { const int nb = (r >> 6) + 1; oc = on; on = ord[((nb < 8) ? nb : 7) * 64 + lane]; asm volatile("s_waitcnt lgkmcnt(0)" ::: "memory"); }
    LAS _Float16* lah = (LAS _Float16*)(F.lds + RING_OFF + PE2_A + wv * 2048);
    LAS float* lav = lg;
    {
        LAS unsigned char* const sl5 = F.lds + RING_OFF + PE2_KEYS + wv * 2048;
        LAS unsigned char* const sl6 = F.lds + RING_OFF + PE2_G + wv * 2048;
        LAS unsigned char* const sl7lo = F.lds + RING_OFF + PE2_A + wv * 2048 + 1024;
        LAS unsigned char* const sl7hi = F.lds + RING_OFF + PE2_CT + wv * 1024;
#define U_LO(k) ((k) < 5 ? ring + (k) * 2048 : (k) == 5 ? sl5 : (k) == 6 ? sl6 : sl7lo)
#define U_HI(k) ((k) < 7 ? U_LO(k) + 1024 : sl7hi)
        const LAS unsigned char* ad[2][8];
#pragma unroll
        for (int p = 0; p < 2; ++p) {
            const LAS unsigned char* lo = bj == 0 ? U_LO(4 * p) : bj == 1 ? U_LO(4 * p + 1) : bj == 2 ? U_LO(4 * p + 2) : U_LO(4 * p + 3);
            const LAS unsigned char* hi = bj == 0 ? U_HI(4 * p) : bj == 1 ? U_HI(4 * p + 1) : bj == 2 ? U_HI(4 * p + 2) : U_HI(4 * p + 3);
#pragma unroll
            for (int s8 = 0; s8 < 8; ++s8) ad[p][s8] = (s8 < 4 ? lo : hi) + 16 * ((16 * (s8 & 3) + bb - 4 * bj) & 63);
        }
        const unsigned char* utr[4];
#pragma unroll
        for (int i = 0; i < 4; ++i) utr[i] = F.ws + WS_PU + (size_t)LAYER * PE_NE * D + 16 * ((lane + 4 * i) & 63);
#define U_ISSUE(i, k, code) do { const unsigned char* _g = utr[i] + ((size_t)(((code) >> 9) PE_EMASK) << 11); \
        __builtin_amdgcn_global_load_lds((const unsigned*)_g, (LAS unsigned*)U_LO(k), 16, 0, 0); \
        __builtin_amdgcn_global_load_lds((const unsigned*)(_g + 1024), (LAS unsigned*)U_HI(k), 16, 0, 0); } while (0)
        { const v4u c0 = *(const LAS v4u*)(ord), c1 = *(const LAS v4u*)(ord + 4);
          asm volatile("s_waitcnt lgkmcnt(0)" ::: "memory");
#pragma unroll
          for (int i = 0; i < 4; ++i) U_ISSUE(i, i, (unsigned)__builtin_amdgcn_readfirstlane((int)c0[i]));
#pragma unroll
          for (int i = 0; i < 4; ++i) U_ISSUE(i, 4 + i, (unsigned)__builtin_amdgcn_readfirstlane((int)c1[i])); }
#pragma unroll 1
        for (int g2 = 0; g2 < 64; ++g2) {
#pragma unroll
            for (int p = 0; p < 2; ++p) {
                const int r = 8 * g2 + 4 * p, nx = (r + 8 < 508) ? r + 8 : 508;
                const v4u cn = *(const LAS v4u*)(ord + nx); const unsigned cm = ord[r + (lane >> 4)];
                PE_WAITV(8);
                v4u a[8];
#pragma unroll
                for (int s8 = 0; s8 < 8; ++s8) a[s8] = *(const LAS v4u*)ad[p][s8];
                asm volatile("s_waitcnt lgkmcnt(0)" ::: "memory");
#pragma unroll
                for (int i = 0; i < 4; ++i) U_ISSUE(i, 4 * p + i, (unsigned)__builtin_amdgcn_readfirstlane((int)cn[i]));
                v4i d0 = (v4i){0, 0, 0, 0}, d1 = (v4i){0, 0, 0, 0};
#pragma unroll
                for (int s8 = 0; s8 < 8; ++s8)
#pragma unroll
                    for (int c = 0; c < 4; ++c) { if (c & 1) d1 = __builtin_amdgcn_mfma_i32_4x4x4i8((int)a[s8][c], hq[s8][c], d1, 0, 0, 0); else d0 = __builtin_amdgcn_mfma_i32_4x4x4i8((int)a[s8][c], hq[s8][c], d0, 0, 0, 0); }
                unsigned e0 = (unsigned)(d0[0] + d1[0]), e1 = (unsigned)(d0[1] + d1[1]), e2 = (unsigned)(d0[2] + d1[2]), e3 = (unsigned)(d0[3] + d1[3]);
                { const auto t = __builtin_amdgcn_permlane32_swap(e0, e2, false, false); e0 = t[0] + t[1]; }
                { const auto t = __builtin_amdgcn_permlane32_swap(e1, e3, false, false); e1 = t[0] + t[1]; }
                { const auto t = __builtin_amdgcn_permlane16_swap(e0, e1, false, false); e0 = t[0] + t[1]; }
                e0 += (unsigned)__builtin_amdgcn_update_dpp(0, (int)e0, 0x124, 0xf, 0xf, true);
                e0 += (unsigned)__builtin_amdgcn_update_dpp(0, (int)e0, 0x128, 0xf, 0xf, true);
                const float val = (float)(int)e0 * shl * (1.f / 256.f);
                if ((lane & 12) == 0 && ((cm >> 7) & 3u) == (unsigned)bj) lah[cm & 511u] = (_Float16)val;
            }
        }
        asm volatile("s_waitcnt vmcnt(0) lgkmcnt(0)" ::: "memory");
#undef U_ISSUE
#undef U_LO
#undef U_HI
    }
#pragma unroll
    for (int tk = 0; tk < 4; ++tk) {
#pragma unroll
        for (int hb = 0; hb < 2; ++hb) { const unsigned key = hb ? sB[tk] : sA[tk]; const int pos = lane + 64 * hb, e = (int)(key >> 7);
            const float av = (float)lah[tk * PE_SEL + pos] * 256.f * su[e]; lav[tk * PE_SEL + pos] = gelu_erf(av) * (hb ? glB[tk] : glA[tk]) * sv[e]; }
    }
    asm volatile("s_waitcnt vmcnt(0) lgkmcnt(0)" ::: "memory");
    f32x2 acc[4][16];
#pragma unroll
    for (int tk = 0; tk < 4; ++tk)
#pragma unroll
        for (int i = 0; i < 16; ++i) acc[tk][i] = (f32x2){0.f, 0.f};
    {
        unsigned oc = ord[lane], on = ord[64 + lane];
        asm volatile("s_waitcnt lgkmcnt(0)" ::: "memory");
#pragma unroll
        for (int i = 0; i < PE_D; ++i) PE_ISSUE(vt, (unsigned)__builtin_amdgcn_readlane((int)oc, i), i);
        int slot = 0, r = 0; int ptr[4] = {0, 0, 0, 0};
#pragma unroll 1
        for (int s = 0; s < PE_NS; ++s) {
            const unsigned limit = (unsigned)((s + 1) * PE_SLICE) << 7;
#pragma unroll
            for (int tk = 0; tk < 4; ++tk) {
                const int end = __builtin_popcountll(__ballot(sA[tk] < limit)) + __builtin_popcountll(__ballot(sB[tk] < limit));
#pragma unroll 1
                for (int pos = ptr[tk]; pos < end; ++pos) {
                    const float a = lav[tk * PE_SEL + pos];
                    PE_ROW_HEAD(vt)
#pragma unroll
                    for (int j = 0; j < 2; ++j)
#pragma unroll
                        for (int c = 0; c < 4; ++c) { const unsigned wd = w[j][c];
                            acc[tk][8 * j + 2 * c] += __builtin_amdgcn_cvt_pk_f32_fp8((int)wd, false) * a; acc[tk][8 * j + 2 * c + 1] += __builtin_amdgcn_cvt_pk_f32_fp8((int)wd, true) * a; }
                    PE_ROW_TAIL()
                }
                ptr[tk] = end;
            }
            if ((s & (PE_PACE - 1)) == PE_PACE - 1) __builtin_amdgcn_s_barrier();
        }
        asm volatile("s_waitcnt vmcnt(0) lgkmcnt(0)" ::: "memory");
    }
#undef PE_ROW_HEAD
#undef PE_ROW_TAIL
#undef PE_SLOT
#undef PE_ISSUE
    asm volatile("" ::: "memory");
    float sqv[4] = {0.f, 0.f, 0.f, 0.f};
#pragma unroll
    for (int tk = 0; tk < 4; ++tk) {
        const int tok = t0w + tk;
        float* xrow = F.out + (size_t)tok * D;
        float* xdst = dry ? (float*)(F.ws + WS_Z) + (size_t)tok * D : xrow;
        float sq = 0.f;
#pragma unroll
        for (int j = 0; j < 2; ++j) {
            unsigned pk[8];
#pragma unroll
            for (int q = 0; q < 4; ++q) { const int d = j * 1024 + lane * 16 + 4 * q; f32x4 xv = *(const f32x4*)(xrow + d);
                xv.x += acc[tk][8 * j + 2 * q].x; xv.y += acc[tk][8 * j + 2 * q].y; xv.z += acc[tk][8 * j + 2 * q + 1].x; xv.w += acc[tk][8 * j + 2 * q + 1].y;
                *(f32x4*)(xdst + d) = xv;
                if constexpr (LAYER == 0) { sq += (xv.x * xv.x + xv.y * xv.y) + (xv.z * xv.z + xv.w * xv.w); pk[2 * q] = pk2(xv.x, xv.y); pk[2 * q + 1] = pk2(xv.z, xv.w);
                    acc[tk][8 * j + 2 * q] = (f32x2){xv.x, xv.y}; acc[tk][8 * j + 2 * q + 1] = (f32x2){xv.z, xv.w}; } }
            if constexpr (LAYER == 0) { unsigned char* xb = F.ws + WS_XB + ((size_t)tok * D + j * 1024 + lane * 16) * 2;
                *(v4u*)xb = (v4u){pk[0], pk[1], pk[2], pk[3]}; *(v4u*)(xb + 16) = (v4u){pk[4], pk[5], pk[6], pk[7]}; }
            asm volatile("" ::: "memory");
        }
        if constexpr (LAYER == 0) { sq = wave_sum(sq); sqv[tk] = sq; if (lane == 0) ((float*)(F.ws + WS_SSQ))[SSQ_X2 + tok] = sq; }
    }
    if constexpr (LAYER == 0) {
        const float* wf = (const float*)(F.ws + WS_WF) + lane * 16;
        float mine = 0.f;
#pragma unroll 1
        for (int jf = 0; jf < 16; ++jf) {
            f32x2 sacc[4] = {{0.f, 0.f}, {0.f, 0.f}, {0.f, 0.f}, {0.f, 0.f}};
#pragma unroll
            for (int j = 0; j < 2; ++j)
#pragma unroll
                for (int q = 0; q < 4; ++q) { const f32x4 wv = *(const f32x4*)(wf + jf * 2048 + j * 1024 + 4 * q);
#pragma unroll
                    for (int tk = 0; tk < 4; ++tk) { sacc[tk] += acc[tk][8 * j + 2 * q] * (f32x2){wv.x, wv.y}; sacc[tk] += acc[tk][8 * j + 2 * q + 1] * (f32x2){wv.z, wv.w}; } }
            float s0 = sacc[0].x + sacc[0].y, s1 = sacc[1].x + sacc[1].y, s2 = sacc[2].x + sacc[2].y, s3 = sacc[3].x + sacc[3].y;
            { const auto t = __builtin_amdgcn_permlane32_swap(__float_as_uint(s0), __float_as_uint(s2), false, false); s0 = __uint_as_float(t[0]) + __uint_as_float(t[1]); }
            { const auto t = __builtin_amdgcn_permlane32_swap(__float_as_uint(s1), __float_as_uint(s3), false, false); s1 = __uint_as_float(t[0]) + __uint_as_float(t[1]); }
            { const auto t = __builtin_amdgcn_permlane16_swap(__float_as_uint(s0), __float_as_uint(s1), false, false); s0 = __uint_as_float(t[0]) + __uint_as_float(t[1]); }
            s0 += __int_as_float(__builtin_amdgcn_update_dpp(0, __float_as_int(s0), 0x128, 0xf, 0xf, true));
            s0 += __int_as_float(__builtin_amdgcn_update_dpp(0, __float_as_int(s0), 0x124, 0xf, 0xf, true));
            s0 += __int_as_float(__builtin_amdgcn_update_dpp(0, __float_as_int(s0), 0x122, 0xf, 0xf, true));
            s0 += __int_as_float(__builtin_amdgcn_update_dpp(0, __float_as_int(s0), 0x121, 0xf, 0xf, true));
            if ((lane & 15) == jf) mine = s0;
        }
        { const int q = lane >> 4; const float sqq = q == 0 ? sqv[0] : q == 1 ? sqv[1] : q == 2 ? sqv[2] : sqv[3];
          const float rs2 = __builtin_amdgcn_rsqf(sqq * (1.f / 2048.f) + RMS_EPS);
          const float zf = mine * rs2 + I.fox_b_f[lane & 15]; const float ls = fminf(zf, 0.f) - log1pf(__expf(-fabsf(zf)));
          ((float*)(F.ws + WS_LF))[(size_t)(lane & 15) * T + (t0w + q)] = ls; }
    }
}
template <int LAYER>
__device__ __forceinline__ void p_peer(const Frame& F, const In& I, int dry) {
    for (int tb = F.vcu; tb < T / 32; tb += F.G) {
        const int t0 = tb * 32;
        Frame Fo = F; asm volatile("" : "+v"(Fo.lane), "+v"(Fo.tid));
        peer_topk(Fo, LAYER, t0);
        __syncthreads();
#ifdef TOPK_PROBE
        peer_topk(Fo, LAYER, t0);
        __syncthreads();
#endif
        asm volatile("" : "+v"(Fo.lane));
        peer_gather4<LAYER>(Fo, I, t0 + F.wave * 4, F.wave * 4, dry);
        __syncthreads();
    }
}
#ifdef SELFCHECK
constexpr int DG_CHUNK = 8192, DG_MAXCH = 8192, DG_NBUF = 3, DG_NPASS = 4;
constexpr size_t WS_DG = WS_END;
constexpr size_t DG_BYTES = (size_t)DG_NPASS * N_PHASES * DG_NBUF * DG_MAXCH * 8;
__global__ void __launch_bounds__(256) dg_kernel(const void* buf, int is_f32, size_t nelem, float2* dig) {
    const int c = blockIdx.x; const size_t e0 = (size_t)c * DG_CHUNK; float s = 0.f, a = 0.f;
    for (int i = threadIdx.x; i < DG_CHUNK; i += 256) { const size_t e = e0 + i; if (e < nelem) { const float v = is_f32 ? ((const float*)buf)[e] : __uint_as_float((unsigned)((const unsigned short*)buf)[e] << 16);
        const float w = ((i * 2654435761u) >> 13) & 1 ? 1.f : -1.f; s += w * v; a += fabsf(v); } }
    __shared__ float ss[256], sa[256]; ss[threadIdx.x] = s; sa[threadIdx.x] = a; __syncthreads();
    for (int o = 128; o > 0; o >>= 1) { if ((int)threadIdx.x < o) { ss[threadIdx.x] += ss[threadIdx.x + o]; sa[threadIdx.x] += sa[threadIdx.x + o]; } __syncthreads(); }
    if (threadIdx.x == 0) dig[c] = make_float2(ss[0], sa[0]);
}
__global__ void dg_compare(const float2* dig, unsigned* flag  ) {
    const int p = blockIdx.x;
    for (int q = 1; q < DG_NPASS; ++q)
        for (int i = threadIdx.x; i < DG_NBUF * DG_MAXCH; i += blockDim.x) {
            const float2 a = dig[((size_t)0 * N_PHASES + p) * DG_NBUF * DG_MAXCH + i], b = dig[((size_t)q * N_PHASES + p) * DG_NBUF * DG_MAXCH + i];
            if (!(fabsf(a.x - b.x) <= 1e-5f * a.y + 0.02f)) atomicAdd(flag + p, 1u);
        }
}
__global__ void dg_poison(const unsigned* flag, float* out) {
    if (threadIdx.x == 0 && blockIdx.x == 0) { for (int p = 0; p < N_PHASES; ++p) if (flag[p]) { out[0] += 1000.f * (float)(1 << p); break; } }
}
struct DgBuf { size_t off; int is_f32; size_t nelem; };
#endif
#ifdef STAGECHECK
constexpr size_t WS_CK = WS_END;
constexpr int CK_NS = 32;
constexpr size_t WS_CK_ROWS = WS_CK + 4096, WS_CK_TMP = WS_CK_ROWS + (size_t)CK_NS * 2048 * 4;
__device__ __forceinline__ unsigned ck_hash(unsigned a) { a ^= a >> 16; a *= 0x7feb352du; a ^= a >> 15; a *= 0x846ca68bu; a ^= a >> 16; return a; }
__device__ __forceinline__ bool ck_bad(float ref, float got) { return !(fabsf(ref - got) <= 0.03f * fabsf(ref) + 0.03f); }
__device__ __forceinline__ int ck_slot(int t) { const int c = t & 15; return (t & ~15) + (c < 4 ? c : c < 8 ? c + 4 : c < 12 ? c - 4 : c); }
__device__ __forceinline__ void ck_flag(unsigned* flags, int code, bool bad) { if (__any(bad)) { if ((threadIdx.x & 63) == 0) atomicAdd(flags + code, 1u); } }

__global__ void __launch_bounds__(64) ck_save_rows(const float* out, float* rows) {
    const int s = blockIdx.x, t = ck_hash(1000 + s) % T; for (int i = threadIdx.x; i < 2048; i += 64) rows[s * 2048 + i] = out[(size_t)t * 2048 + i];
}
__global__ void __launch_bounds__(64) ck_kernel(int stage, In I, unsigned char* ws, const float* out, unsigned* flags) {
    const int s = blockIdx.x, lane = threadIdx.x;
    __shared__ float sh[4096];
    const bf16* z0 = (const bf16*)(ws + WS_Z0); const float* ssq = (const float*)(ws + WS_SSQ);
    if (stage == 1) {
        const int t = ck_hash(s) % T, n = ck_hash(77 + s) % MLA_IN; float a = 0.f, d = 0.f;
        for (int k = lane; k < 2048; k += 64) { const float x = I.x[(size_t)t * 2048 + k]; a += x * x; d += x * I.g_mix[k] * I.mla_w_in[(size_t)k * MLA_IN + n]; }
        a = wave_sum(a); d = wave_sum(d); const float ref = d * rsqrtf(a / 2048.f + 1e-6f);
        ck_flag(flags, 1, ck_bad(ref, bf2f(z0[(size_t)t * MLA_INP + n])));
    } else if (stage == 2) {
        const int t = ck_hash(s) % T, n = ck_hash(78 + s) % 3072, h = ck_hash(79 + s) % 16, dd = ck_hash(80 + s) % 128; float a = 0.f, b = 0.f, c = 0.f, q = 0.f;
        for (int k = lane; k < 512; k += 64) { const float zq = bf2f(z0[(size_t)t * MLA_INP + k]), zk = bf2f(z0[(size_t)t * MLA_INP + 512 + k]);
            a += zq * I.mla_g_qa[k] * I.mla_w_qb[(size_t)k * 3072 + n]; b += zk * I.mla_g_kva[k] * I.mla_w_kvb[(size_t)k * 4096 + h * 256 + dd]; c += zk * I.mla_g_kva[k] * I.mla_w_kvb[(size_t)k * 4096 + h * 256 + 128 + dd]; q += zk * zk; }
        a = wave_sum(a); b = wave_sum(b); c = wave_sum(c); q = wave_sum(q); c *= rsqrtf(q / 512.f + 1e-6f);
        const bf16* Q = (const bf16*)(ws + WS_Q); const bf16* KN = (const bf16*)(ws + WS_KN); const bf16* VT = (const bf16*)(ws + WS_VT);
        ck_flag(flags, 2, ck_bad(a, bf2f(Q[(size_t)t * 3072 + n])));
        ck_flag(flags, 20, ck_bad(b, bf2f(KN[(size_t)t * 2048 + h * 128 + dd])));
        ck_flag(flags, 21, ck_bad(c, bf2f(VT[(size_t)(h * 128 + dd) * T + ck_slot(t)])));
    } else if (stage == 3) {
        const int t = ck_hash(s) % T, h = ck_hash(81 + s) % 16; float sq = 0.f, skv = 0.f;
        for (int k = lane; k < 512; k += 64) { const float zq = bf2f(z0[(size_t)t * MLA_INP + k]), zk = bf2f(z0[(size_t)t * MLA_INP + 512 + k]); sq += zq * zq; skv += zk * zk; }
        const float rcq = rsqrtf(wave_sum(sq) / 512.f + 1e-6f), rckv = rsqrtf(wave_sum(skv) / 512.f + 1e-6f);
        float qv[3], kv[3];
#pragma unroll
        for (int j = 0; j < 3; ++j) { const int d = lane + 64 * j; float a = 0.f, b = 0.f;
            for (int k = 0; k < 512; ++k) { a += bf2f(z0[(size_t)t * MLA_INP + k]) * I.mla_g_qa[k] * I.mla_w_qb[(size_t)k * 3072 + h * 192 + d];
                if (d < 128) b += bf2f(z0[(size_t)t * MLA_INP + 512 + k]) * I.mla_g_kva[k] * I.mla_w_kvb[(size_t)k * 4096 + h * 256 + d]; }
            qv[j] = a * rcq; kv[j] = (d < 128) ? b * rckv : bf2f(z0[(size_t)t * MLA_INP + 1024 + (d - 128)]); }
        const float rq = rsqrtf(wave_sum(qv[0] * qv[0] + qv[1] * qv[1] + qv[2] * qv[2]) / 192.f + 1e-6f), rk = rsqrtf(wave_sum(kv[0] * kv[0] + kv[1] * kv[1] + kv[2] * kv[2]) / 192.f + 1e-6f);
#pragma unroll
        for (int j = 0; j < 3; ++j) { qv[j] *= rq * I.mla_g_q[lane + 64 * j]; kv[j] *= rk * I.mla_g_k[lane + 64 * j]; }
        const float inv_freq = powf(10000.0f, -(float)(2 * (lane & 31)) / 64.0f), ang = (float)I.pos[t] * inv_freq, cs = cosf(ang), sn = sinf(ang);
        const float pq = __shfl_xor(qv[2], 32), pk = __shfl_xor(kv[2], 32);
        qv[2] = (lane < 32) ? qv[2] * cs - pq * sn : qv[2] * cs + pq * sn; kv[2] = (lane < 32) ? kv[2] * cs - pk * sn : kv[2] * cs + pk * sn;
        const float QS = 0.07216878364870322f * LOG2E; const bf16* Q = (const bf16*)(ws + WS_Q); const bf16* KM = (const bf16*)(ws + WS_KM); bool bad = false, badk = false;
#pragma unroll
        for (int j = 0; j < 3; ++j) { bad |= ck_bad(qv[j] * QS * 4.f, 4.f * bf2f(Q[(size_t)t * 3072 + h * 192 + lane + 64 * j])); badk |= ck_bad(kv[j], bf2f(KM[(size_t)t * 3072 + h * 192 + lane + 64 * j])); }
        ck_flag(flags, 3, bad); ck_flag(flags, 22, badk);
    } else if (stage == 4 || stage == 10) {
        const bool fox = stage == 10; const int t = ck_hash(s) % T, h = ck_hash(82 + s) % 16, b = t / SEQ, tq = t % SEQ, DKK = fox ? 128 : 192;
        const bf16* Q = fox ? (const bf16*)(ws + WS_Z) : (const bf16*)(ws + WS_Q); const bf16* K = fox ? (const bf16*)(ws + WS_Z) + 2048 : (const bf16*)(ws + WS_KM); const int pitch = fox ? FOX_ZN : 3072;
        const bf16* VT = (const bf16*)(ws + WS_VT); const float* lf = (const float*)(ws + WS_LF);
        const int nk = fox ? tq + 1 : 64 * (tq / 64 + 1);
        if (fox) { if (lane == 0) { float c = 0.f; for (int i = 0; i < nk; ++i) { c += lf[(size_t)(b * SEQ + i) * 16 + h]; sh[2048 + i] = c; } } __syncthreads(); }
        float mx = -1e30f;
        for (int sk = lane; sk < nk; sk += 64) { float d = 0.f; for (int e = 0; e < DKK; ++e) d += bf2f(Q[(size_t)t * pitch + h * DKK + e]) * bf2f(K[(size_t)(b * SEQ + sk) * pitch + h * DKK + e]);
            if (fox) d += (sh[2048 + tq] - sh[2048 + sk]) * LOG2E; sh[sk] = d; mx = fmaxf(mx, d); }
        for (int o = 1; o < 64; o <<= 1) mx = fmaxf(mx, __shfl_xor(mx, o));
        __syncthreads();
        float l = 0.f; for (int sk = lane; sk < nk; sk += 64) { const float p = exp2f(sh[sk] - mx); sh[sk] = p; l += p; } l = wave_sum(l);
        __syncthreads();
        bool bad = false;
        for (int j = 0; j < 2; ++j) { const int dv = lane + 64 * j; float o = 0.f; for (int sk = 0; sk < nk; ++sk) o += sh[sk] * bf2f(VT[(size_t)(h * 128 + dv) * T + ck_slot(b * SEQ + sk)]); o /= l;
            if (fox) o *= 1.f / (1.f + expf(-bf2f(((const bf16*)(ws + WS_Z))[(size_t)t * FOX_ZN + 4096 + h * 128 + dv])));
            bad |= ck_bad(o * 8.f, 8.f * bf2f(((const bf16*)(ws + WS_O))[(size_t)t * 2048 + h * 128 + dv])); }
        ck_flag(flags, stage, bad);
    } else if (stage == 5 || stage == 11) {
        const int t = (stage == 5) ? ck_hash(s) % T : ck_hash(1000 + s) % T, n = ck_hash(83 + s) % 2048; const float* wo = (stage == 5) ? I.mla_w_o : I.fox_w_o; float d = 0.f;
        for (int k = lane; k < 2048; k += 64) d += bf2f(((const bf16*)(ws + WS_O))[(size_t)t * 2048 + k]) * wo[(size_t)k * 2048 + n];
        d = wave_sum(d); const float xo = (stage == 5) ? I.x[(size_t)t * 2048 + n] : ((const float*)(ws + WS_CK_ROWS))[s * 2048 + n];
        ck_flag(flags, stage, ck_bad(xo + d, out[(size_t)t * 2048 + n]));
    } else if (stage == 6 || stage == 12) {
        const int L = stage == 12, t = ck_hash(s) % T, n = ck_hash(84 + s) % 2048; float d = 0.f;
        for (int k = lane; k < 2048; k += 64) d += bf2f(((const bf16*)(ws + WS_XB))[(size_t)t * 2048 + k]) * I.g_ffn[L * 2048 + k] * I.pe_wq[(size_t)L * 2048 * 2048 + (size_t)k * 2048 + n];
        d = wave_sum(d); ck_flag(flags, stage, ck_bad(d, bf2f(((const bf16*)(ws + WS_QP))[(size_t)t * 2048 + n])));
    } else if (stage == 7 || stage == 13) {
        const int L = stage == 13, t = ck_hash(1000 + s) % T; const float* xo = (const float*)(ws + WS_CK_ROWS) + s * 2048; float* tmp = (float*)(ws + WS_CK_TMP) + (size_t)s * 8192;
        float a = 0.f; for (int k = lane; k < 2048; k += 64) a += xo[k] * xo[k]; const float r = rsqrtf(wave_sum(a) / 2048.f + 1e-6f);
        for (int k = lane; k < 2048; k += 64) tmp[k] = xo[k] * r * I.g_ffn[L * 2048 + k];
        __syncthreads();
        for (int n = lane; n < 2048; n += 64) { float d = 0.f; for (int k = 0; k < 2048; ++k) d += tmp[k] * I.pe_wq[(size_t)L * 2048 * 2048 + (size_t)k * 2048 + n]; tmp[2048 + n] = d; }
        __syncthreads();
        for (int hq = 0; hq < 8; ++hq) {
            for (int c = 0; c < 2; ++c) for (int n = lane; n < 128; n += 64) { float d = 0.f; for (int e = 0; e < 128; ++e) d += tmp[2048 + hq * 256 + c * 128 + e] * I.pe_sk[((size_t)(L * 2 + c) * 128 + n) * 128 + e]; sh[c * 128 + n] = d; }
            __syncthreads();
            if (lane == 0) {
                for (int c = 0; c < 2; ++c) for (int k = 0; k < 16; ++k) { int bi = 0; float bv = -1e30f; for (int n = 0; n < 128; ++n) if (sh[c * 128 + n] > bv) { bv = sh[c * 128 + n]; bi = n; } sh[256 + c * 16 + k] = bv; sh[288 + c * 16 + k] = (float)bi; sh[c * 128 + bi] = -1e30f; }
                for (int i = 0; i < 16; ++i) for (int j = 0; j < 16; ++j) sh[512 + i * 16 + j] = sh[256 + i] + sh[272 + j];
                float b0 = 0.f, sum = 0.f;
                for (int k = 0; k < 16; ++k) { int bi = 0; float bv = -1e30f; for (int n = 0; n < 256; ++n) if (sh[512 + n] > bv) { bv = sh[512 + n]; bi = n; } if (k == 0) b0 = bv;
                    const float w = expf(bv - b0); sum += w; tmp[4096 + hq * 32 + k] = sh[288 + (bi >> 4)] * 128.f + sh[304 + (bi & 15)]; tmp[4096 + hq * 32 + 16 + k] = w; sh[512 + bi] = -1e30f; }
                for (int k = 0; k < 16; ++k) tmp[4096 + hq * 32 + 16 + k] /= sum;
            }
            __syncthreads();
        }
        for (int k = 0; k < 128; ++k) { const int e = (int)tmp[4096 + (k >> 4) * 32 + (k & 15)]; float d = 0.f; for (int i = lane; i < 2048; i += 64) d += I.pe_u[((size_t)L * PE_NE + e) * 2048 + i] * tmp[i]; d = wave_sum(d);
            if (lane == 0) tmp[6144 + k] = 0.5f * d * (1.f + erff(d * 0.7071067811865476f)) * tmp[4096 + (k >> 4) * 32 + 16 + (k & 15)]; }
        __syncthreads();
        { const int* di = (const int*)(ws + WS_END + 8 * MiB) + (size_t)t * 128; const float* dg = (const float*)(ws + WS_END + 12 * MiB) + (size_t)t * 128; const float* da = (const float*)(ws + WS_END + 16 * MiB) + (size_t)t * 128;
          int nf = 0; bool bg = false, ba = false;
          for (int k = lane; k < 128; k += 64) { const int e = (int)tmp[4096 + (k >> 4) * 32 + (k & 15)]; int f = -1; for (int m = 0; m < 16; ++m) if (di[(k & ~15) + m] == e) f = (k & ~15) + m;
              if (f < 0) ++nf; else { bg |= !(fabsf(dg[f] - tmp[4096 + (k >> 4) * 32 + 16 + (k & 15)]) <= 0.05f * dg[f] + 0.003f); ba |= !(fabsf(da[f] - tmp[6144 + k]) <= 0.05f * fabsf(da[f]) + 0.004f); } }
          nf = (int)wave_sum((float)nf);
          ck_flag(flags, 23, nf > 8); ck_flag(flags, 24, bg); ck_flag(flags, 25, ba); }
        bool bad = false;
        for (int j = 0; j < 4; ++j) { const int d = (lane * 4 + j * 256 + (int)(ck_hash(s) & 3)) & 2047; float o = 0.f; { const int* di = (const int*)(ws + WS_END + 8 * MiB) + (size_t)t * 128; const float* da = (const float*)(ws + WS_END + 16 * MiB) + (size_t)t * 128; for (int k = 0; k < 128; ++k) o += da[k] * I.pe_v[((size_t)L * PE_NE + di[k]) * 2048 + d]; }
            bad |= ck_bad((xo[d] + o), out[(size_t)t * 2048 + d]); }
        ck_flag(flags, stage, bad);
    } else if (stage == 9) {
        const int t = ck_hash(s) % T, h = ck_hash(86 + s) % 16; const float r2 = rsqrtf(ssq[SSQ_X2 + t] / 2048.f + 1e-6f); float qv[2], kv[2];
#pragma unroll
        for (int j = 0; j < 2; ++j) { const int d = lane + 64 * j; float a = 0.f, b = 0.f;
            for (int k = 0; k < 2048; ++k) { const float xv = bf2f(((const bf16*)(ws + WS_XB))[(size_t)t * 2048 + k]) * I.g_mix[2048 + k]; a += xv * I.fox_w_in[(size_t)k * 8208 + h * 128 + d]; b += xv * I.fox_w_in[(size_t)k * 8208 + 2048 + h * 128 + d]; }
            qv[j] = a * r2; kv[j] = b * r2; }
        const float rq = rsqrtf(wave_sum(qv[0] * qv[0] + qv[1] * qv[1]) / 128.f + 1e-6f) * 0.08838834764831845f * LOG2E, rk = rsqrtf(wave_sum(kv[0] * kv[0] + kv[1] * kv[1]) / 128.f + 1e-6f);
        bool bad = false;
#pragma unroll
        for (int j = 0; j < 2; ++j) { const int d = lane + 64 * j; bad |= ck_bad(4.f * qv[j] * rq * I.fox_g_q[d], 4.f * bf2f(((const bf16*)(ws + WS_Z))[(size_t)t * FOX_ZN + h * 128 + d]));
            bad |= ck_bad(kv[j] * rk * I.fox_g_k[d], bf2f(((const bf16*)(ws + WS_Z))[(size_t)t * FOX_ZN + 2048 + h * 128 + d])); }
        ck_flag(flags, 9, bad);
    } else if (stage == 8) {
        const int t = ck_hash(s) % T, n = ck_hash(85 + s) % 8192; float d = 0.f;
        for (int k = lane; k < 2048; k += 64) d += bf2f(((const bf16*)(ws + WS_XB))[(size_t)t * 2048 + k]) * I.g_mix[2048 + k] * I.fox_w_in[(size_t)k * 8208 + n];
        d = wave_sum(d) * rsqrtf(ssq[SSQ_X2 + t] / 2048.f + 1e-6f);
        const int sec = n >> 11, c = n & 2047; float got;
        if (sec == 2) got = bf2f(((const bf16*)(ws + WS_VT))[(size_t)c * T + ck_slot(t)]); else got = bf2f(((const bf16*)(ws + WS_Z))[(size_t)t * FOX_ZN + (sec == 3 ? 4096 : sec * 2048) + c]);
        ck_flag(flags, 8, ck_bad(d, got));
    }
}
__global__ void ck_poison(const unsigned* flags, float* out) {
    if (threadIdx.x == 0 && blockIdx.x == 0) { const int order[19] = {1, 2, 20, 21, 3, 22, 4, 5, 6, 23, 24, 25, 7, 8, 9, 10, 11, 12, 13};
        for (int i = 0; i < 19; ++i) if (flags[order[i]]) { out[0] += 1000.f * (float)(1 << (i + 1)); break; } }
}
#endif
#ifndef MK_N_LAUNCHES
#define MK_N_LAUNCHES 1
#endif
struct Args { const void* in[21]; float* out; unsigned char* ws; int ph_lo, ph_hi, rep, pad; };
static_assert(sizeof(Args) == 21 * 8 + 8 + 8 + 16, "Args has no padding");

__global__ void __launch_bounds__(NWAVES * 64, 2) mk_fwd(Args args) {
    extern __shared__ __attribute__((aligned(16))) unsigned char lds_raw[];
    Frame F;
    F.lds = (LAS unsigned char*)lds_raw;
    volatile LAS unsigned* MISC = (volatile LAS unsigned*)(F.lds + MISC_OFF);
    F.tid = threadIdx.x; F.lane = F.tid & 63; F.wave = __builtin_amdgcn_readfirstlane(F.tid >> 6);
    F.G = gridDim.x; { const int bx = blockIdx.x; F.vcu = (F.G % 8 == 0) ? (bx % 8) * (F.G / 8) + bx / 8 : bx; }
    F.ws = args.ws; F.out = args.out;
    In I;
    I.x = (const float*)args.in[0]; I.pos = (const int*)args.in[1]; I.g_mix = (const float*)args.in[2]; I.g_ffn = (const float*)args.in[3];
    I.mla_w_in = (const float*)args.in[4]; I.mla_g_qa = (const float*)args.in[5]; I.mla_w_qb = (const float*)args.in[6]; I.mla_g_kva = (const float*)args.in[7];
    I.mla_w_kvb = (const float*)args.in[8]; I.mla_g_q = (const float*)args.in[9]; I.mla_g_k = (const float*)args.in[10]; I.mla_w_o = (const float*)args.in[11];
    I.fox_w_in = (const float*)args.in[12]; I.fox_b_f = (const float*)args.in[13]; I.fox_g_q = (const float*)args.in[14]; I.fox_g_k = (const float*)args.in[15];
    I.fox_w_o = (const float*)args.in[16]; I.pe_wq = (const float*)args.in[17]; I.pe_sk = (const float*)args.in[18]; I.pe_u = (const float*)args.in[19]; I.pe_v = (const float*)args.in[20];
    for (int u = F.tid; u < (LDS_BYTES - LDSCTL_OFF) / 4; u += NWAVES * 64) ((LAS unsigned*)(F.lds + LDSCTL_OFF))[u] = 0u;
    __syncthreads();
    unsigned* ctl = (unsigned*)(F.ws + WS_CTL);
    XcdBarrier bar; bar.bar = ctl + CW_BAR; bar.x = 0; bar.st = nullptr;
    const int lo = args.ph_lo, hi = args.ph_hi;
    if (hi - lo > 1) bar = xcd_barrier_post(ctl + CW_BAR, MISC + 8);
#ifndef PH_MASK
#define PH_MASK 0x3fff
#endif
#define IN(k) (((PH_MASK >> (k)) & 1) && lo <= (k) && (k) < hi)
#define SEAM(k) do { if (IN(k) && IN((k) + 1)) xcd_barrier(bar); } while (0)
#ifdef TIMING_PROBE
#define REPS(k) ((TIMING_PROBE >> (k)) & 1)
#else
#define REPS(k) 0
#endif
    unsigned char* ws = F.ws;
    float* ssq = (float*)(ws + WS_SSQ);
    const int bid = (int)blockIdx.x;

    if (IN(0)) { for (int rp = REPS(0); rp >= 0; --rp) { p_prologue(F, I); if (rp) xcd_barrier(bar); } SEAM(0); }

    if (IN(1)) { for (int rp = REPS(1); rp >= 0; --rp) {
        pg8::Gemm g{(const bf16*)(ws + WS_XB), (const bf16*)(ws + WS_WT_MLA_IN), T, MLA_INP, D, D, D}; pg8::StaticOrder S; S.init(T, MLA_INP, F.G, bid);
        pg8::EpiRowScale E{(bf16*)(ws + WS_Z0), MLA_INP, ssq + SSQ_X0, 1, 1.f / 2048.f, ssq + SSQ_CQ, ssq + SSQ_CKV, 2, 4, 8};
        pg8::gemm_phase<pg8::EpiRowScale, pg8::StaticOrder, false>(F.lds + RING_OFF, g, S, E);
        if (bid >= 160) p_table_fill(F, I, 16384, 16384, (bid - 160) * NWAVES + F.wave, 96 * NWAVES);
        if (rp) xcd_barrier(bar); }
        SEAM(1);
    }
    if (IN(2)) { for (int rp = REPS(2); rp >= 0; --rp) {
        p_mla_tok(F, I);
        { pg8::Gemm g{(const bf16*)(ws + WS_Z0), (const bf16*)(ws + WS_WT_QB), T, MLA_QN, 512, MLA_INP, 512}; pg8::StaticOrder S; S.init(T, MLA_QN, F.G, bid);
          pg8::EpiRowScale E{(bf16*)(ws + WS_Q), MLA_QN, nullptr, 0, 0.f, nullptr, nullptr, 0, 0, 0};
          pg8::gemm_phase<pg8::EpiRowScale, pg8::StaticOrder, true>(F.lds + RING_OFF, g, S, E);
          if (bid >= 128) p_table_fill(F, I, 49152, PE_FILL2, (bid - 128) * NWAVES + F.wave, 128 * NWAVES); }
        { pg8::Gemm g{(const bf16*)(ws + WS_Z0) + 512, (const bf16*)(ws + WS_WT_KVB), T, 2048, 512, MLA_INP, 512}; pg8::StaticOrder S; S.init(T, 2048, F.G, bid);
          pg8::EpiRowScale E{(bf16*)(ws + WS_KN), 2048, ssq + SSQ_CKV, 8, 1.f / 512.f, nullptr, nullptr, 0, 0, 0, (float*)(ws + WS_KSQM), 0, 8};
          pg8::gemm_phase<pg8::EpiRowScale, pg8::StaticOrder, true>(F.lds + RING_OFF, g, S, E); }
        { pg8::Gemm g{(const bf16*)(ws + WS_WT_KVB) + (size_t)2048 * 512, (const bf16*)(ws + WS_Z0) + 512, 2048, T, 512, 512, MLA_INP}; pg8::StaticOrder S; S.init(2048, T, F.G, bid);
          pg8::EpiColScale E{(bf16*)(ws + WS_VT), T, ssq + SSQ_CKV, 8, 1.f / 512.f};
          pg8::gemm_phase<pg8::EpiColScale, pg8::StaticOrder, true>(F.lds + RING_OFF, g, S, E); }
        if (rp) xcd_barrier(bar); }
        SEAM(2);
    }
    if (IN(4)) { for (int rp = REPS(4); rp >= 0; --rp) {
        const AttnAux ax{I.mla_g_q, I.mla_g_k, (const float*)(ws + WS_KSQM), ssq + SSQ_CQ, (const float*)(ws + WS_ROPE), (const float*)(ws + WS_RCKV), (const float*)(ws + WS_KRSS), (const bf16*)(ws + WS_KRG)};
        p_attention<192, false>(F, (const bf16*)(ws + WS_Q), MLA_QN, (const bf16*)(ws + WS_KN), 2048, (const bf16*)(ws + WS_VT), (bf16*)(ws + WS_O), nullptr, 0, nullptr, ax);
        if (rp) xcd_barrier(bar); }
        SEAM(4);
    }
    if (IN(5)) { for (int rp = REPS(5); rp >= 0; --rp) {
        pg8::Gemm g{(const bf16*)(ws + WS_O), (const bf16*)(ws + WS_WT_MLA_O), T, D, D, D, D}; pg8::StaticOrder S; S.init(T, D, F.G, bid);
        pg8::EpiResidual E{I.x, F.out, (bf16*)(ws + WS_XB), D, ssq + SSQ_XS};
        pg8::gemm_phase<pg8::EpiResidual, pg8::StaticOrder, false>(F.lds + RING_OFF, g, S, E);
        if (rp) xcd_barrier(bar); }
        SEAM(5);
    }
    if (IN(6)) { for (int rp = REPS(6); rp >= 0; --rp) {
        pg8::Gemm g{(const bf16*)(ws + WS_XB), (const bf16*)(ws + WS_WT_PQ), T, D, D, D, D}; pg8::StaticOrder S; S.init(T, D, F.G, bid);
        pg8::EpiRowScale E{(bf16*)(ws + WS_QP), D, nullptr, 0, 0.f, nullptr, nullptr, 0, 0, 0};
        pg8::gemm_phase<pg8::EpiRowScale, pg8::StaticOrder, false>(F.lds + RING_OFF, g, S, E);
        if (rp) xcd_barrier(bar); }
        SEAM(6);
    }
    if (IN(7)) { for (int rp = REPS(7); rp >= 0; --rp) { p_peer<0>(F, I, rp); if (rp) xcd_barrier(bar); } SEAM(7); }
    if (IN(8)) { for (int rp = REPS(8); rp >= 0; --rp) {
        { pg8::Gemm g{(const bf16*)(ws + WS_XB), (const bf16*)(ws + WS_WT_FOX_IN), T, FOX_ZN, D, D, D}; pg8::StaticOrder S; S.init(T, FOX_ZN, F.G, bid);
          pg8::EpiRowScale E{(bf16*)(ws + WS_Z), FOX_ZN, ssq + SSQ_X2, 1, 1.f / 2048.f, nullptr, nullptr, 0, 0, 0, (float*)(ws + WS_KSQ), 8, 16};
          pg8::gemm_phase<pg8::EpiRowScale, pg8::StaticOrder, true>(F.lds + RING_OFF, g, S, E); }
        { pg8::Gemm g{(const bf16*)(ws + WS_WT_FOX_IN) + (size_t)FOX_ZN * D, (const bf16*)(ws + WS_XB), 2048, T, D, D, D}; pg8::StaticOrder S; S.init(2048, T, F.G, bid);
          pg8::EpiColScale E{(bf16*)(ws + WS_VT), T, ssq + SSQ_X2, 1, 1.f / 2048.f};
          pg8::gemm_phase<pg8::EpiColScale, pg8::StaticOrder, true>(F.lds + RING_OFF, g, S, E); }
        if (rp) xcd_barrier(bar); }
        SEAM(8);
    }
    if (IN(10)) { for (int rp = REPS(10); rp >= 0; --rp) {
        p_attention<128, true>(F, (const bf16*)(ws + WS_Z), FOX_ZN, (const bf16*)(ws + WS_Z) + 2048, FOX_ZN, (const bf16*)(ws + WS_VT), (bf16*)(ws + WS_O), (const bf16*)(ws + WS_Z) + 4096, FOX_ZN, (const float*)(ws + WS_LF), AttnAux{I.fox_g_q, I.fox_g_k, (const float*)(ws + WS_KSQ), nullptr, nullptr, nullptr, nullptr, nullptr});
        if (rp) xcd_barrier(bar); }
        SEAM(10);
    }
    if (IN(11)) {
        pg8::Gemm g{(const bf16*)(ws + WS_O), (const bf16*)(ws + WS_WT_FOX_O), T, D, D, D, D}; pg8::StaticOrder S; S.init(T, D, F.G, bid);
        pg8::EpiResidual E{F.out, F.out, (bf16*)(ws + WS_XB), D, ssq + SSQ_XS};
        pg8::gemm_phase<pg8::EpiResidual, pg8::StaticOrder, false>(F.lds + RING_OFF, g, S, E);
        SEAM(11);
    }
    if (IN(12)) { for (int rp = REPS(12); rp >= 0; --rp) {
        pg8::Gemm g{(const bf16*)(ws + WS_XB), (const bf16*)(ws + WS_WT_PQ + 8 * MiB), T, D, D, D, D}; pg8::StaticOrder S; S.init(T, D, F.G, bid);
        pg8::EpiRowScale E{(bf16*)(ws + WS_QP), D, nullptr, 0, 0.f, nullptr, nullptr, 0, 0, 0};
        pg8::gemm_phase<pg8::EpiRowScale, pg8::StaticOrder, false>(F.lds + RING_OFF, g, S, E);
        if (rp) xcd_barrier(bar); }
        SEAM(12);
    }
    if (IN(13)) { for (int rp = REPS(13); rp >= 0; --rp) { p_peer<1>(F, I, rp); if (rp) xcd_barrier(bar); } }
#ifdef PROF
    if (hi - lo > 1) { xcd_barrier(bar); if (blockIdx.x == 0 && F.tid == 0) { float v = __uint_as_float(__hip_atomic_load(ctl + 70, __ATOMIC_RELAXED, __HIP_MEMORY_SCOPE_AGENT)); v = fminf(fmaxf(v, 0.f), 1.5f); v = rintf(v * 12.f) * (1.f / 12.f); F.out[0] += 1000.f * __builtin_exp10f(v);        } }
#endif
#ifdef BARRIER_PROBE
    if (hi - lo > 1) { for (int i = 0; i < 8; ++i) xcd_barrier(bar); }
#endif
#ifdef FP6_SELFTEST
    if (hi - lo > 1) { xcd_barrier(bar); if (blockIdx.x == 0 && F.tid == 0 && __hip_atomic_load(ctl + 64, __ATOMIC_RELAXED, __HIP_MEMORY_SCOPE_AGENT)) F.out[0] += 1.0e6f; }
#endif
#undef IN
#undef SEAM
}

extern "C" void kernel_launch(void* const* d_in, const int* in_sizes, int n_in, void* d_out, int out_size, void* d_ws, size_t ws_size, hipStream_t stream) {
    static int grid = 0;
    if (grid == 0) {
        if (n_in != 21 || out_size != T * D || ws_size < WS_END) { fprintf(stderr, "kernel_launch: unexpected shapes (n_in %d out %d ws %zu need %zu)\n", n_in, out_size, ws_size, (size_t)WS_END); grid = -1; return; }
        int dev = 0, cus = 0, per_cu = 0;
        if (hipGetDevice(&dev) != hipSuccess || hipDeviceGetAttribute(&cus, hipDeviceAttributeMultiprocessorCount, dev) != hipSuccess) { grid = -1; return; }
        if (hipFuncSetAttribute((const void*)mk_fwd, hipFuncAttributeMaxDynamicSharedMemorySize, LDS_BYTES) != hipSuccess) { fprintf(stderr, "kernel_launch: hipFuncSetAttribute failed\n"); grid = -1; return; }
        if (hipOccupancyMaxActiveBlocksPerMultiprocessor(&per_cu, (const void*)mk_fwd, NWAVES * 64, LDS_BYTES) != hipSuccess || per_cu < 1) { fprintf(stderr, "kernel_launch: occupancy query says %d\n", per_cu); }
        (void)hipGetLastError();
        grid = cus;
    }
    if (grid < 0) return;
    (void)hipMemsetAsync((char*)d_ws + WS_CTL, 0, CTL_ZERO_BYTES, stream);
    Args a{};
    for (int i = 0; i < 21; ++i) a.in[i] = d_in[i];
    a.out = (float*)d_out; a.ws = (unsigned char*)d_ws;
#ifdef TIMING_PROBE
    a.rep = TIMING_PROBE;
#endif
#ifdef STAGECHECK
    {
        unsigned char* ws = (unsigned char*)d_ws; unsigned* flags = (unsigned*)(ws + WS_CK); float* rows = (float*)(ws + WS_CK_ROWS);
        (void)hipMemsetAsync(ws + WS_CK, 0, 4096, stream);
        In I; { const void* const* in = a.in; I.x = (const float*)in[0]; I.pos = (const int*)in[1]; I.g_mix = (const float*)in[2]; I.g_ffn = (const float*)in[3]; I.mla_w_in = (const float*)in[4]; I.mla_g_qa = (const float*)in[5];
            I.mla_w_qb = (const float*)in[6]; I.mla_g_kva = (const float*)in[7]; I.mla_w_kvb = (const float*)in[8]; I.mla_g_q = (const float*)in[9]; I.mla_g_k = (const float*)in[10]; I.mla_w_o = (const float*)in[11];
            I.fox_w_in = (const float*)in[12]; I.fox_b_f = (const float*)in[13]; I.fox_g_q = (const float*)in[14]; I.fox_g_k = (const float*)in[15]; I.fox_w_o = (const float*)in[16]; I.pe_wq = (const float*)in[17];
            I.pe_sk = (const float*)in[18]; I.pe_u = (const float*)in[19]; I.pe_v = (const float*)in[20]; }
        for (int p = 0; p < N_PHASES; ++p) {
            if (p == 7 || p == 11 || p == 13) hipLaunchKernelGGL(ck_save_rows, dim3(CK_NS), dim3(64), 0, stream, (const float*)d_out, rows);
            a.ph_lo = p; a.ph_hi = p + 1; hipLaunchKernelGGL(mk_fwd, dim3(grid), dim3(NWAVES * 64), LDS_BYTES, stream, a);
            if (p >= 1) hipLaunchKernelGGL(ck_kernel, dim3(CK_NS), dim3(64), 0, stream, p, I, ws, (const float*)d_out, flags);
        }
        hipLaunchKernelGGL(ck_poison, dim3(1), dim3(64), 0, stream, (const unsigned*)flags, (float*)d_out);
    }
#elif defined(SELFCHECK)
    {
        unsigned char* ws = (unsigned char*)d_ws;
        (void)hipMemsetAsync(ws + WS_DG, 0, DG_BYTES, stream);
        unsigned* flag = (unsigned*)(ws + 64 * 1024);
        const size_t OUTB = (size_t)-1;
        const DgBuf bufs[N_PHASES][DG_NBUF] = {
            {{WS_XB, 0, (size_t)T * D}, {WS_WT_MLA_IN, 0, (size_t)40 * 1024 * 1024}, {WS_PU, 0, (size_t)64 * 1024 * 1024}},
            {{WS_Z0, 0, (size_t)T * MLA_INP}, {0, 0, 0}, {0, 0, 0}},
            {{WS_Q, 0, (size_t)T * MLA_QN}, {WS_KN, 0, (size_t)T * 2048}, {WS_VT, 0, (size_t)T * 2048}},
            {{WS_Q, 0, (size_t)T * MLA_QN}, {WS_KM, 0, (size_t)T * MLA_QN}, {0, 0, 0}},
            {{WS_O, 0, (size_t)T * D}, {0, 0, 0}, {0, 0, 0}},
            {{OUTB, 1, (size_t)T * D}, {WS_XB, 0, (size_t)T * D}, {0, 0, 0}},
            {{WS_QP, 0, (size_t)T * D}, {0, 0, 0}, {0, 0, 0}},
            {{OUTB, 1, (size_t)T * D}, {WS_XB, 0, (size_t)T * D}, {WS_LF, 1, (size_t)T * 16}},
            {{WS_Z, 0, (size_t)T * FOX_ZN}, {WS_VT, 0, (size_t)T * 2048}, {0, 0, 0}},
            {{WS_Z, 0, (size_t)T * FOX_ZN}, {0, 0, 0}, {0, 0, 0}},
            {{WS_O, 0, (size_t)T * D}, {0, 0, 0}, {0, 0, 0}},
            {{OUTB, 1, (size_t)T * D}, {WS_XB, 0, (size_t)T * D}, {0, 0, 0}},
            {{WS_QP, 0, (size_t)T * D}, {0, 0, 0}, {0, 0, 0}},
            {{OUTB, 1, (size_t)T * D}, {0, 0, 0}, {0, 0, 0}}};
        for (int pass = 0; pass < DG_NPASS; ++pass) {
            for (int p = 0; p < N_PHASES; ++p) {
                a.ph_lo = p; a.ph_hi = p + 1; hipLaunchKernelGGL(mk_fwd, dim3(grid), dim3(NWAVES * 64), LDS_BYTES, stream, a);
                for (int b = 0; b < DG_NBUF; ++b) { const DgBuf& B = bufs[p][b]; if (!B.nelem) continue;
                    size_t ne = B.nelem; if (ne > (size_t)DG_MAXCH * DG_CHUNK) ne = (size_t)DG_MAXCH * DG_CHUNK;
                    const void* ptr = (B.off == OUTB) ? (const void*)d_out : (const void*)(ws + B.off);
                    float2* dig = (float2*)(ws + WS_DG) + (((size_t)pass * N_PHASES + p) * DG_NBUF + b) * DG_MAXCH;
                    hipLaunchKernelGGL(dg_kernel, dim3((unsigned)((ne + DG_CHUNK - 1) / DG_CHUNK)), dim3(256), 0, stream, ptr, B.is_f32, ne, dig); }
            }
        }
        hipLaunchKernelGGL(dg_compare, dim3(N_PHASES), dim3(256), 0, stream, (const float2*)(ws + WS_DG), flag);
        hipLaunchKernelGGL(dg_poison, dim3(1), dim3(64), 0, stream, (const unsigned*)flag, (float*)d_out);
    }
#elif MK_N_LAUNCHES == 1
    a.ph_lo = 0; a.ph_hi = N_PHASES;
    hipLaunchKernelGGL(mk_fwd, dim3(grid), dim3(NWAVES * 64), LDS_BYTES, stream, a);
#else
    for (int p = 0; p < N_PHASES; ++p) { a.ph_lo = p; a.ph_hi = p + 1; hipLaunchKernelGGL(mk_fwd, dim3(grid), dim3(NWAVES * 64), LDS_BYTES, stream, a); }
#endif
}
```

```cpp
#include <hip/hip_runtime.h>
#include <cstdio>
#include <cstdint>
namespace pg8 {
#define PG8_LAS __attribute__((address_space(3)))
typedef unsigned short bf16_t;
typedef short bf16x8 __attribute__((ext_vector_type(8)));
typedef float f32x4 __attribute__((ext_vector_type(4)));
typedef unsigned u32x4 __attribute__((ext_vector_type(4)));
typedef unsigned u32x2 __attribute__((ext_vector_type(2)));
constexpr int BM = 256, BK = 64, HALF = 128, HTB = HALF * BK * 2  , STAGE_BYTES = 8 * HTB, NXCD = 8, WGM = 8;

__host__ __device__ __forceinline__ int lds_byte(int r, int c) { const int st = (r >> 4) * 2 + (c >> 5), rr = r & 15, cc = c & 31, ob = rr * 64 + cc * 2; return st * 1024 + (ob ^ (((ob >> 9) & 1) << 5)); }
__host__ __device__ __forceinline__ void stage_rc(int b, int& R, int& C) { const int st = b / 1024, sb = b % 1024, swz = sb ^ (((sb >> 9) & 1) << 5); R = (st >> 1) * 16 + swz / 64; C = (st & 1) * 32 + (swz % 64) / 2; }
__host__ __device__ __forceinline__ int perm32(int rho) { const int n = rho >> 4, i = rho & 15; return 8 * (i >> 2) + 4 * n + (i & 3); }

struct Unit { int pm, pn; };
struct Gemm { const bf16_t* A; const bf16_t* Bt; int M, N, K, lda, ldb; int asplit = 1 << 30, aoff2 = 0; };

struct StaticOrder {
    int nM, nN, nwg, G, c;
    __host__ __device__ void init(int M, int N, int G_, int c_) { nM = M / BM; nN = N / BM; nwg = nM * nN; G = G_; c = c_; }
    __host__ __device__ bool next(int i, Unit& u) const {
        const long L = (long)i * G + c; if (L >= nwg) return false;
        int wgid = (int)L; { const int q = nwg / NXCD, r = nwg % NXCD, xcd = wgid % NXCD, off = wgid / NXCD; wgid = (xcd < r ? xcd * (q + 1) : r * (q + 1) + (xcd - r) * q) + off; }
        const int nig = WGM * nN, gid = wgid / nig, fm = gid * WGM, gsz = (nM - fm) < WGM ? (nM - fm) : WGM;
        u.pm = fm + ((wgid % nig) % gsz); u.pn = (wgid % nig) / gsz; return true;
    }
    __device__ __forceinline__ void a_ready(const Unit&) const {}
    __device__ __forceinline__ void done(const Unit&) const {}
};

__device__ __forceinline__ u32x4 epi_regroup(u32x4 w, int lane) {
    const int src = (((lane >> 2) + 16 * (lane & 3)) << 2);
    u32x4 r; r.x = (unsigned)__builtin_amdgcn_ds_bpermute(src, (int)w.x); r.y = (unsigned)__builtin_amdgcn_ds_bpermute(src, (int)w.y); r.z = (unsigned)__builtin_amdgcn_ds_bpermute(src, (int)w.z); r.w = (unsigned)__builtin_amdgcn_ds_bpermute(src, (int)w.w);
    return r;
}
__device__ __forceinline__ unsigned cvt_pk_bf16(float lo, float hi) { unsigned r; asm volatile("v_cvt_pk_bf16_f32 %0, %1, %2" : "=v"(r) : "v"(lo), "v"(hi)); return r; }

constexpr float RMS_EPS = 1e-6f;

__device__ __forceinline__ float slot_sum(const float* p, int ns) { float s = 0.f; for (int i = 0; i < ns; ++i) s += p[i]; return s; }
struct EpiRowScale {
    static constexpr bool PERM = true, AFTER_DRAIN = false, HAS_INIT = false;
    bf16_t* O; int ldc; const float* ssq_in; int ns_in; float inv_k; float* ssq_out0; float* ssq_out1; int t0, t1, ns_out;
    float* ksq = nullptr; int kt0 = 0, kt1 = 0;
    __device__ __forceinline__ void operator()(const f32x4 (&acc)[2][2][4][2], const Unit& u, int wr, int wc, int fr, int fq) const {
        const int row0 = u.pm * BM + wr * 64 + fr, col0 = u.pn * BM + wc * 32 + 8 * fq;
        float* sdst = (u.pn < t0) ? ssq_out0 + u.pn * 4 + wc : ((u.pn < t1) ? ssq_out1 + (u.pn - t0) * 4 + wc : nullptr);
#pragma unroll
        for (int ai = 0; ai < 2; ++ai)
#pragma unroll
            for (int m = 0; m < 4; ++m) {
                const int row = row0 + ai * HALF + m * 16;
                const float rs = ssq_in ? __builtin_amdgcn_rsqf(slot_sum(ssq_in + (size_t)row * ns_in, ns_in) * inv_k + RMS_EPS) : 1.f;
                bf16_t* rowp = O + (size_t)row * ldc + col0; float sq = 0.f, sqh[2];
#pragma unroll
                for (int bj = 0; bj < 2; ++bj) { const f32x4 v0 = acc[ai][bj][m][0] * rs, v1 = acc[ai][bj][m][1] * rs;
                    sqh[bj] = (v0[0] * v0[0] + v0[1] * v0[1]) + (v0[2] * v0[2] + v0[3] * v0[3]) + (v1[0] * v1[0] + v1[1] * v1[1]) + (v1[2] * v1[2] + v1[3] * v1[3]); sq += sqh[bj];
                    u32x4 w; w.x = cvt_pk_bf16(v0[0], v0[1]); w.y = cvt_pk_bf16(v0[2], v0[3]); w.z = cvt_pk_bf16(v1[0], v1[1]); w.w = cvt_pk_bf16(v1[2], v1[3]);
                    { const int ln = fr + 16 * fq; *(u32x4*)(O + (size_t)(row - fr + (ln >> 2)) * ldc + (col0 - 8 * fq + 8 * (ln & 3)) + bj * HALF) = epi_regroup(w, ln); } }
                if (sdst) { sq += __shfl_xor(sq, 16); sq += __shfl_xor(sq, 32); if (fq == 0) sdst[(size_t)row * ns_out] = sq; }
                if (ksq && u.pn >= kt0 && u.pn < kt1) {
#pragma unroll
                    for (int bj = 0; bj < 2; ++bj) { float q = sqh[bj]; q += __shfl_xor(q, 16); q += __shfl_xor(q, 32); if (fq == 0) ksq[((size_t)(2 * (u.pn - kt0) + bj) * 8192 + row) * 4 + wc] = q; } }
            }
    }
};
struct EpiRowScale2 {
    static constexpr bool PERM = true, AFTER_DRAIN = false, HAS_INIT = false;
    EpiRowScale a, b; int split;
    __device__ __forceinline__ void operator()(const f32x4 (&acc)[2][2][4][2], const Unit& u, int wr, int wc, int fr, int fq) const {
        if (u.pn < split) a(acc, u, wr, wc, fr, fq); else { Unit v = u; v.pn = u.pn - split; b(acc, v, wr, wc, fr, fq); }
    }
};
struct EpiColScale {
    static constexpr bool PERM = true, AFTER_DRAIN = false, HAS_INIT = false;
    bf16_t* O; int ldc; const float* ssq_in; int ns_in; float inv_k;
    __device__ __forceinline__ void operator()(const f32x4 (&acc)[2][2][4][2], const Unit& u, int wr, int wc, int fr, int fq) const {
        const int row0 = u.pm * BM + wr * 64 + fr, col0 = u.pn * BM + wc * 32 + 8 * fq;
        f32x4 cs[2][2];
#pragma unroll
        for (int bj = 0; bj < 2; ++bj)
#pragma unroll
            for (int n = 0; n < 2; ++n) { const float* sp = ssq_in + (size_t)(col0 + bj * HALF + 4 * n) * ns_in; const f32x4 s = (f32x4){slot_sum(sp, ns_in), slot_sum(sp + ns_in, ns_in), slot_sum(sp + 2 * ns_in, ns_in), slot_sum(sp + 3 * ns_in, ns_in)};
                cs[bj][n] = (f32x4){__builtin_amdgcn_rsqf(s[0] * inv_k + RMS_EPS), __builtin_amdgcn_rsqf(s[1] * inv_k + RMS_EPS), __builtin_amdgcn_rsqf(s[2] * inv_k + RMS_EPS), __builtin_amdgcn_rsqf(s[3] * inv_k + RMS_EPS)}; }
#pragma unroll
        for (int ai = 0; ai < 2; ++ai)
#pragma unroll
            for (int m = 0; m < 4; ++m) { bf16_t* rowp = O + (size_t)(row0 + ai * HALF + m * 16) * ldc + col0;
#pragma unroll
                for (int bj = 0; bj < 2; ++bj) { const f32x4 v0 = acc[ai][bj][m][0] * cs[bj][0], v1 = acc[ai][bj][m][1] * cs[bj][1];
                    u32x2 w0, w1; w0.x = cvt_pk_bf16(v0[0], v0[1]); w0.y = cvt_pk_bf16(v0[2], v0[3]); w1.x = cvt_pk_bf16(v1[0], v1[1]); w1.y = cvt_pk_bf16(v1[2], v1[3]);
                    bf16_t* gp = rowp + bj * HALF - 8 * (fq & 1);
                    { const auto t0 = __builtin_amdgcn_permlane16_swap(w0.x, w1.x, false, false); const auto t1 = __builtin_amdgcn_permlane16_swap(w0.y, w1.y, false, false);
                      u32x4 w; w.x = t0[0]; w.y = t1[0]; w.z = t0[1]; w.w = t1[1];
                      *(u32x4*)(gp + ((fq & 1) ? 8 : 0)) = w; } } }
    }
};
struct EpiResidual {
    static constexpr bool PERM = true, AFTER_DRAIN = false, HAS_INIT = true;
    bf16_t* xb; int ldc; float* ssq_out;
    __device__ __forceinline__ void init(f32x4 (&acc)[2][2][4][2], const Unit& u, int wr, int wc, int fr, int fq) const {
        const int row0 = u.pm * BM + wr * 64 + fr, col0 = u.pn * BM + wc * 32 + 8 * fq;
#pragma unroll
        for (int ai = 0; ai < 2; ++ai)
#pragma unroll
            for (int m = 0; m < 4; ++m) { const size_t ro = (size_t)(row0 + ai * HALF + m * 16) * ldc + col0;
#pragma unroll
                for (int bj = 0; bj < 2; ++bj) { const u32x4 w = *(const u32x4*)(xb + ro + bj * HALF);
                    acc[ai][bj][m][0] = (f32x4){__uint_as_float(w.x << 16), __uint_as_float(w.x & 0xffff0000u), __uint_as_float(w.y << 16), __uint_as_float(w.y & 0xffff0000u)};
                    acc[ai][bj][m][1] = (f32x4){__uint_as_float(w.z << 16), __uint_as_float(w.z & 0xffff0000u), __uint_as_float(w.w << 16), __uint_as_float(w.w & 0xffff0000u)}; } }
    }
    __device__ __forceinline__ void operator()(const f32x4 (&acc)[2][2][4][2], const Unit& u, int wr, int wc, int fr, int fq) const {
        const int row0 = u.pm * BM + wr * 64 + fr, col0 = u.pn * BM + wc * 32 + 8 * fq;
#pragma unroll
        for (int ai = 0; ai < 2; ++ai)
#pragma unroll
            for (int m = 0; m < 4; ++m) {
                const int row = row0 + ai * HALF + m * 16; const size_t ro = (size_t)row * ldc + col0; float sq = 0.f;
#pragma unroll
                for (int bj = 0; bj < 2; ++bj) { const f32x4 v0 = acc[ai][bj][m][0], v1 = acc[ai][bj][m][1];
                    sq += (v0[0] * v0[0] + v0[1] * v0[1]) + (v0[2] * v0[2] + v0[3] * v0[3]) + (v1[0] * v1[0] + v1[1] * v1[1]) + (v1[2] * v1[2] + v1[3] * v1[3]);
                    u32x4 w; w.x = cvt_pk_bf16(v0[0], v0[1]); w.y = cvt_pk_bf16(v0[2], v0[3]); w.z = cvt_pk_bf16(v1[0], v1[1]); w.w = cvt_pk_bf16(v1[2], v1[3]);
                    { const int ln = fr + 16 * fq; *(u32x4*)(xb + (size_t)(row - fr + (ln >> 2)) * ldc + (col0 - 8 * fq + 8 * (ln & 3)) + bj * HALF) = epi_regroup(w, ln); } }
                sq += __shfl_xor(sq, 16); sq += __shfl_xor(sq, 32); if (fq == 0) ssq_out[(size_t)row * 32 + u.pn * 4 + wc] = sq;
            }
    }
};

template <class Epi, class Sched, bool ALIGN_EPI = false>
__device__ __forceinline__ void gemm_phase(PG8_LAS unsigned char* lds, const Gemm g, const Sched& S, const Epi& E) {
    const int tid = threadIdx.x, wid = __builtin_amdgcn_readfirstlane(tid >> 6), lane = tid & 63, wr = wid >> 2, wc = wid & 3, fr = lane & 15, fq = lane >> 4;
    const int K = g.K, nt = K / BK;
    unsigned voffA[2], voffB[2];
#pragma unroll
    for (int i = 0; i < 2; ++i) { int R, C; stage_rc(tid * 16 + i * 8192, R, C); const int Rb = Epi::PERM ? ((R & ~31) + perm32(R & 31)) : R;
        voffA[i] = (unsigned)(R * g.lda + C) * 2u; voffB[i] = (unsigned)(Rb * g.ldb + C) * 2u; }
    const size_t kstep = (size_t)(BK * 2);
    const size_t hstepA = (size_t)HALF * g.lda * 2, hstepB = (size_t)HALF * g.ldb * 2;
    const size_t tstepA = 2 * hstepA, tstepB = 2 * hstepB;
    const unsigned ldsw = (unsigned)wid * 1024u;
    const int aoff = lds_byte(wr * 64 + fr, fq * 8), boff = lds_byte(wc * 32 + fr, fq * 8);
#define PG8_SA(b, h) (((b) * 2 + (h)) * HTB)
#define PG8_SB(b, h) ((4 + (b) * 2 + (h)) * HTB)
#define PG8_STAGE(bufoff, gbase, voff) do { _Pragma("unroll") for (int _i = 0; _i < 2; ++_i) \
        __builtin_amdgcn_global_load_lds((const unsigned*)((const char*)(gbase) + (voff)[_i]), (PG8_LAS unsigned*)(lds + (bufoff) + ldsw + _i * 8192), 16, 0, 0); } while (0)
#define PG8_LDA(dst, b, h) do { _Pragma("unroll") for (int m = 0; m < 4; ++m) _Pragma("unroll") for (int k = 0; k < 2; ++k) dst[m][k] = *(const PG8_LAS bf16x8*)(lds + PG8_SA(b, h) + aoff + m * 2048 + k * 1024); } while (0)
#define PG8_LDB(dst, b, h) do { _Pragma("unroll") for (int n = 0; n < 2; ++n) _Pragma("unroll") for (int k = 0; k < 2; ++k) dst[n][k] = *(const PG8_LAS bf16x8*)(lds + PG8_SB(b, h) + boff + n * 2048 + k * 1024); } while (0)
#define PG8_MMA(ai, bj, At, Bt) do { __builtin_amdgcn_s_setprio(1); _Pragma("unroll") for (int m = 0; m < 4; ++m) _Pragma("unroll") for (int n = 0; n < 2; ++n) _Pragma("unroll") for (int k = 0; k < 2; ++k) \
        acc[ai][bj][m][n] = __builtin_amdgcn_mfma_f32_16x16x32_bf16(Bt[n][k], At[m][k], acc[ai][bj][m][n], 0, 0, 0); __builtin_amdgcn_s_setprio(0); } while (0)
#define PG8_WAIT_V(n) asm volatile("s_waitcnt vmcnt(" #n ")" ::: "memory")
#define PG8_WAIT_L(n) asm volatile("s_waitcnt lgkmcnt(" #n ")" ::: "memory")
#define PG8_BAR __builtin_amdgcn_s_barrier()
#define PG8_SCHED __builtin_amdgcn_sched_barrier(0)
    Unit cur, nxt; int ui = 0;
    if (!S.next(0, cur)) return;
    f32x4 acc[2][2][4][2];
    if constexpr (Epi::HAS_INIT) E.init(acc, cur, wr, wc, fr, fq);
    else {
#pragma unroll
    for (int a = 0; a < 2; ++a)
#pragma unroll
        for (int b = 0; b < 2; ++b)
#pragma unroll
            for (int m = 0; m < 4; ++m)
#pragma unroll
                for (int n = 0; n < 2; ++n) acc[a][b][m][n] = (f32x4){0.f, 0.f, 0.f, 0.f};
    }
    bf16x8 At[4][2], B0[2][2], B1[2][2];
    const char* cA = (const char*)g.A + (size_t)cur.pm * tstepA + (cur.pn >= g.asplit ? (size_t)g.aoff2 * 2 : 0); const char* cB = (const char*)g.Bt + (size_t)cur.pn * tstepB;
    S.a_ready(cur);
    PG8_STAGE(PG8_SB(0, 0), cB, voffB); PG8_STAGE(PG8_SB(0, 1), cB + hstepB, voffB); PG8_STAGE(PG8_SA(0, 0), cA, voffA); PG8_STAGE(PG8_SA(0, 1), cA + hstepA, voffA);
    if (wr == 1) PG8_BAR;
    PG8_WAIT_V(2); PG8_BAR;
    PG8_STAGE(PG8_SB(1, 0), cB + kstep, voffB); PG8_STAGE(PG8_SA(1, 0), cA + kstep, voffA); PG8_STAGE(PG8_SB(1, 1), cB + hstepB + kstep, voffB);
    PG8_WAIT_V(6); PG8_BAR;
    for (;;) {
        const bool has_next = S.next(ui + 1, nxt);
        const char* nA = has_next ? (const char*)g.A + (size_t)nxt.pm * tstepA + (nxt.pn >= g.asplit ? (size_t)g.aoff2 * 2 : 0) : cA; const char* nB = has_next ? (const char*)g.Bt + (size_t)nxt.pn * tstepB : cB;
        for (int t = 0; t < nt; t += 2) {
            const bool last = (t == nt - 2);
            const char* a1 = cA + (size_t)(t + 1) * kstep;
            const char* a2 = last ? nA : cA + (size_t)(t + 2) * kstep; const char* b2 = last ? nB : cB + (size_t)(t + 2) * kstep;
            const char* a3 = a2 + kstep; const char* b3 = b2 + kstep;
            if (last && has_next) S.a_ready(nxt);
            PG8_LDB(B0, 0, 0); PG8_LDB(B1, 0, 1); PG8_SCHED; PG8_LDA(At, 0, 0); PG8_STAGE(PG8_SA(1, 1), a1 + hstepA, voffA);
            PG8_WAIT_V(8); PG8_WAIT_L(0); PG8_BAR; PG8_MMA(0, 0, At, B0); PG8_MMA(0, 1, At, B1); PG8_BAR; PG8_SCHED;
            PG8_LDA(At, 0, 1); PG8_STAGE(PG8_SB(0, 0), b2, voffB); PG8_STAGE(PG8_SB(0, 1), b2 + hstepB, voffB); PG8_STAGE(PG8_SA(0, 0), a2, voffA);
            PG8_WAIT_V(8); PG8_WAIT_L(0); PG8_BAR; PG8_MMA(1, 0, At, B0); PG8_MMA(1, 1, At, B1); PG8_BAR; PG8_SCHED;
            PG8_LDB(B0, 1, 0); PG8_LDB(B1, 1, 1); PG8_SCHED; PG8_LDA(At, 1, 0); PG8_STAGE(PG8_SA(0, 1), a2 + hstepA, voffA);
            PG8_WAIT_V(8); PG8_WAIT_L(0); PG8_BAR; PG8_MMA(0, 0, At, B0); PG8_MMA(0, 1, At, B1); PG8_BAR; PG8_SCHED;
            PG8_LDA(At, 1, 1); PG8_STAGE(PG8_SB(1, 0), b3, voffB); PG8_STAGE(PG8_SB(1, 1), b3 + hstepB, voffB); PG8_STAGE(PG8_SA(1, 0), a3, voffA);
            PG8_WAIT_V(8); PG8_WAIT_L(0); PG8_BAR; PG8_MMA(1, 0, At, B0); PG8_MMA(1, 1, At, B1); PG8_BAR; PG8_SCHED;
        }
        if constexpr (ALIGN_EPI) { if (wr == 0) PG8_BAR; }
        E(acc, cur, wr, wc, fr, fq); S.done(cur);
        if (!has_next) break;
        if constexpr (Epi::HAS_INIT) E.init(acc, nxt, wr, wc, fr, fq);
        else {
#pragma unroll
        for (int a = 0; a < 2; ++a)
#pragma unroll
            for (int b = 0; b < 2; ++b)
#pragma unroll
                for (int m = 0; m < 4; ++m)
#pragma unroll
                    for (int n = 0; n < 2; ++n) acc[a][b][m][n] = (f32x4){0.f, 0.f, 0.f, 0.f};
        }
        cur = nxt; cA = nA; cB = nB; ++ui;
        if constexpr (ALIGN_EPI) { if (wr == 1) PG8_BAR; }
    }
    PG8_WAIT_V(0);
    if constexpr (!ALIGN_EPI) { if (wr == 0) PG8_BAR; }
    PG8_BAR;
#undef PG8_SA
#undef PG8_SB
#undef PG8_STAGE
#undef PG8_LDA
#undef PG8_LDB
#undef PG8_MMA
#undef PG8_WAIT_V
#undef PG8_WAIT_L
#undef PG8_BAR
#undef PG8_SCHED
}
}
#define GAS __attribute__((address_space(1)))
#define LAS __attribute__((address_space(3)))
typedef unsigned short bf16;
typedef unsigned v4u __attribute__((ext_vector_type(4)));
typedef unsigned v2u __attribute__((ext_vector_type(2)));
typedef float f32x4 __attribute__((ext_vector_type(4)));
typedef float f32x16 __attribute__((ext_vector_type(16)));
typedef short bf16x8 __attribute__((ext_vector_type(8)));
typedef __bf16 bf16x2_t __attribute__((ext_vector_type(2)));
typedef GAS unsigned gu32;
#define RLX_AGENT __ATOMIC_RELAXED, __HIP_MEMORY_SCOPE_AGENT
__device__ __forceinline__ unsigned f2bf(float f) { unsigned u = __builtin_bit_cast(unsigned, f); return (u + 0x7fffu + ((u >> 16) & 1u)) >> 16; }
__device__ __forceinline__ unsigned pk2(float lo, float hi) { return pg8::cvt_pk_bf16(lo, hi); }
__device__ __forceinline__ float bf2f(unsigned short v) { return __uint_as_float((unsigned)v << 16); }
__device__ __forceinline__ float bflo(unsigned w) { return __uint_as_float(w << 16); }
__device__ __forceinline__ float bfhi(unsigned w) { return __uint_as_float(w & 0xffff0000u); }
__device__ __forceinline__ float dot2(unsigned a, unsigned b, float acc) { return __builtin_amdgcn_fdot2_f32_bf16(__builtin_bit_cast(bf16x2_t, a), __builtin_bit_cast(bf16x2_t, b), acc, false); }
__device__ __forceinline__ float wave_sum(float v) {
#pragma unroll
    for (int o = 1; o < 64; o <<= 1) v += __shfl_xor(v, o);
    return v;
}
__device__ __forceinline__ float pair_max(float x) { auto t = __builtin_amdgcn_permlane32_swap(__float_as_uint(x), __float_as_uint(x), false, false); return fmaxf(__uint_as_float(t[0]), __uint_as_float(t[1])); }
__device__ __forceinline__ float pair_sum(float x) { auto t = __builtin_amdgcn_permlane32_swap(__float_as_uint(x), __float_as_uint(x), false, false); return __uint_as_float(t[0]) + __uint_as_float(t[1]); }

#define XB_TMO      128
#define XB_XCNT(j)  (256  + 64 * (j))
#define XB_XSUB(j)  (1280 + 64 * (j))
#define XB_XGEN(j)  (2304 + 64 * (j))
#define XB_TOP      3328
#define XB_TOPGEN   3392
#define XCD_BAR_WORDS 3456
#define XB_SPIN_CAP (1u << 18)

__device__ __forceinline__ unsigned xb_ld(unsigned* p)              { return __hip_atomic_load(p, __ATOMIC_RELAXED, __HIP_MEMORY_SCOPE_AGENT); }
__device__ __forceinline__ unsigned xb_add(unsigned* p, unsigned v) { return __hip_atomic_fetch_add(p, v, __ATOMIC_RELAXED, __HIP_MEMORY_SCOPE_AGENT); }
__device__ __forceinline__ unsigned xb_xcc_id() { return (unsigned)__builtin_amdgcn_s_getreg((3 << 11) | 20) & 0xFu; }
#define XB_SPIN(cond, bar) do { unsigned _sp = 0; while (cond) { __builtin_amdgcn_s_sleep(1); \
    if ((++_sp & 255u) == 0u) { if (xb_ld(&(bar)[XB_TMO])) break; if (_sp > XB_SPIN_CAP) { atomicAdd(&(bar)[XB_TMO], 1u); break; } } } } while (0)

struct XcdBarrier {
    unsigned* bar; unsigned x;
    volatile LAS unsigned* st;
};
__device__ __forceinline__ XcdBarrier xcd_barrier_post(unsigned* bar, volatile LAS unsigned* st) {
    XcdBarrier b; b.bar = bar; b.x = xb_xcc_id(); b.st = st;
    if (threadIdx.x == 0) (void)xb_add(&bar[XB_XCNT(b.x)], 1u);
    return b;
}
__device__ __forceinline__ void xcd_barrier_complete(unsigned* bar, unsigned x, unsigned& nloc, unsigned& nx) {
    const unsigned G = gridDim.x * gridDim.y * gridDim.z;
    unsigned sum, cnt, mine, sp = 0u;
    for (;;) {
        sum = 0u; cnt = 0u; mine = 0u;
#pragma unroll
        for (unsigned j = 0; j < 16; ++j) { const unsigned c = xb_ld(&bar[XB_XCNT(j)]); sum += c; cnt += (c > 0u) ? 1u : 0u; mine = (j == x) ? c : mine; }
        if (sum == G) break;
        __builtin_amdgcn_s_sleep(1);
        if ((++sp & 255u) == 0u) { if (xb_ld(&bar[XB_TMO])) break; if (sp > XB_SPIN_CAP) { atomicAdd(&bar[XB_TMO], 1u); break; } }
    }
    nloc = mine > 0u ? mine : 1u; nx = cnt > 0u ? cnt : 1u;
}
__device__ __forceinline__ void xcd_barrier(const XcdBarrier& b) {
    asm volatile("s_waitcnt vmcnt(0)" ::: "memory");
    __syncthreads();
    if (threadIdx.x == 0) {
        unsigned* bar = b.bar;
        __builtin_amdgcn_s_waitcnt(0);
        unsigned nloc = b.st[0], nx = b.st[1];
        if (nloc == 0u) { xcd_barrier_complete(bar, b.x, nloc, nx); b.st[0] = nloc; b.st[1] = nx; }
        const unsigned old = xb_add(&bar[XB_XSUB(b.x)], 1u);
        const unsigned gen = old / nloc;
        if (old + 1u == (gen + 1u) * nloc) {
            __builtin_amdgcn_fence(__ATOMIC_RELEASE, "agent");
            asm volatile("s_waitcnt vmcnt(0)" ::: "memory");
            const unsigned og = xb_add(&bar[XB_TOP], 1u);
            const unsigned tg = og / nx;
            if (og + 1u == (tg + 1u) * nx) xb_add(&bar[XB_TOPGEN], 1u);
            else XB_SPIN(xb_ld(&bar[XB_TOPGEN]) == tg, bar);
            __builtin_amdgcn_fence(__ATOMIC_ACQUIRE, "agent");
            xb_add(&bar[XB_XGEN(b.x)], 1u);
            asm volatile("s_waitcnt vmcnt(0)" ::: "memory");
        } else {
            XB_SPIN(xb_ld(&bar[XB_XGEN(b.x)]) == gen, bar);
            __builtin_amdgcn_fence(__ATOMIC_ACQUIRE, "agent");
            asm volatile("s_waitcnt vmcnt(0)" ::: "memory");
        }
    }
    __syncthreads();
}
constexpr int NWAVES = 8;
constexpr int N_PHASES = 14;
constexpr int NB = 4, SEQ = 2048, T = NB * SEQ, D = 2048;
constexpr int MLA_H = 16, MLA_QK = 192, MLA_NOPE = 128, MLA_ROPE = 64, MLA_IN = 1088, MLA_INP = 1280, MLA_QN = 3072;
constexpr int FOX_H = 16, FOX_HD = 128, FOX_ZN = 6144;
constexpr int PE_H = 8, PE_NK = 128, PE_TOPK = 16, PE_NE = 16384, PE_SEL = 128;
constexpr float RMS_EPS = 1e-6f, LOG2E = 1.4426950408889634f;

constexpr size_t MiB = 1u << 20;
constexpr size_t WS_CTL = 0, CTL_ZERO_BYTES = 1 * MiB;
constexpr size_t WS_SSQ = 1 * MiB;
constexpr size_t WS_WF = WS_SSQ + 2 * MiB;
constexpr size_t WS_SKB = WS_WF + 128 * 1024;
constexpr size_t WS_LF = WS_SKB + 128 * 1024;
constexpr size_t WS_WT_MLA_IN = 5 * MiB;
constexpr size_t WS_WT_QB = WS_WT_MLA_IN + 5 * MiB;
constexpr size_t WS_WT_KVB = WS_WT_QB + 3 * MiB;
constexpr size_t WS_WT_MLA_O = WS_WT_KVB + 4 * MiB;
constexpr size_t WS_WT_FOX_IN = WS_WT_MLA_O + 8 * MiB;
constexpr size_t WS_WT_FOX_O = WS_WT_FOX_IN + 32 * MiB;
constexpr size_t WS_WT_PQ = WS_WT_FOX_O + 8 * MiB;
constexpr size_t WS_PU = WS_WT_PQ + 16 * MiB;
constexpr size_t WS_PV = WS_PU + 64 * MiB;
constexpr size_t WS_PSU = WS_PV + 64 * MiB, WS_PSV = WS_PSU + 128 * 1024;
constexpr size_t WS_XB = WS_PSU + 1 * MiB;
constexpr size_t WS_O = WS_XB + 32 * MiB;
constexpr size_t WS_QP = WS_O + 32 * MiB;
constexpr size_t WS_VT = WS_QP + 32 * MiB;
constexpr size_t WS_ACT = WS_VT + 32 * MiB;
constexpr size_t WS_Z0 = WS_ACT;
constexpr size_t WS_Q = WS_Z0 + 20 * MiB;
constexpr size_t WS_KN = WS_Q + 48 * MiB;
constexpr size_t WS_KM = WS_KN + 32 * MiB;
constexpr size_t WS_KRG = WS_KM;
constexpr size_t WS_RCKV = WS_KM + 2 * MiB, WS_KRSS = WS_RCKV + 256 * 1024;
constexpr size_t WS_ROPE = WS_KM + 4 * MiB;
constexpr size_t WS_KSQM = WS_KM + 8 * MiB;
constexpr size_t WS_Z = WS_ACT;
constexpr size_t WS_KSQ = WS_ACT + 100 * MiB;
constexpr size_t WS_END = WS_KM + 48 * MiB;
static_assert(WS_Z + 96 * MiB <= WS_END, "ws map");
constexpr int SSQ_X0 = 0, SSQ_X2 = T, SSQ_CQ = 2 * T, SSQ_CKV = 10 * T, SSQ_XS = 18 * T;
constexpr int CW_BAR = 4096;

constexpr int RING_OFF = 0, RING_BYTES = 131072;
constexpr int LDS_BYTES = 163840;
constexpr int LDSCTL_OFF = LDS_BYTES - 1024, MISC_OFF = LDSCTL_OFF + 320;

struct Frame {
    LAS unsigned char* lds;
    int tid, lane, wave, vcu, G;
    unsigned char* ws;
    float* out;
};

__device__ __forceinline__ void transpose_item(const float* W, int ldw, int k0, int n0src, const float* gain, bf16* WT, int K, int dstrow0, LAS float* scr, int lane) {
    const int r4 = lane >> 4, c4 = (lane & 15) * 4; f32x4 v[16];
    const float* src = W + (size_t)(k0 + r4) * ldw + n0src + c4;
#pragma unroll
    for (int i = 0; i < 16; ++i) v[i] = *(const f32x4*)(src + (size_t)(4 * i) * ldw);
#pragma unroll
    for (int i = 0; i < 16; ++i) { const int kk = 4 * i + r4; const float gk = gain ? gain[k0 + kk] : 1.f; LAS float* d = scr + kk * 65 + c4; d[0] = v[i].x * gk; d[1] = v[i].y * gk; d[2] = v[i].z * gk; d[3] = v[i].w * gk; }
    asm volatile("s_waitcnt lgkmcnt(0)" ::: "memory");
    const int c = lane & 7;
#pragma unroll
    for (int j = 0; j < 8; ++j) { const int n = (lane >> 3) + 8 * j; const LAS float* s = scr + (8 * c) * 65 + n;
        v4u o; o.x = pk2(s[0 * 65], s[1 * 65]); o.y = pk2(s[2 * 65], s[3 * 65]); o.z = pk2(s[4 * 65], s[5 * 65]); o.w = pk2(s[6 * 65], s[7 * 65]);
        *(v4u*)(WT + (size_t)(dstrow0 + n) * K + k0 + 8 * c) = o; }
    asm volatile("s_waitcnt lgkmcnt(0)" ::: "memory");
}
struct In {
    const float* x; const int* pos; const float *g_mix, *g_ffn, *mla_w_in, *mla_g_qa, *mla_w_qb, *mla_g_kva, *mla_w_kvb, *mla_g_q, *mla_g_k, *mla_w_o,
        *fox_w_in, *fox_b_f, *fox_g_q, *fox_g_k, *fox_w_o, *pe_wq, *pe_sk, *pe_u, *pe_v;
};
__device__ __forceinline__ void prologue_transpose_item(const In& I, unsigned char* ws, LAS float* scr, int lane, int it) {
    constexpr int I1 = 17 * 32, I2 = 48 * 8, I3 = 64 * 8, I4 = 32 * 32, I5 = 128 * 32, I6 = 32 * 32, I7 = 32 * 32;
        int r = it;
        if (r < I1) { const int kb = r / 17, nb = r % 17; transpose_item(I.mla_w_in, MLA_IN, 64 * kb, 64 * nb, I.g_mix, (bf16*)(ws + WS_WT_MLA_IN), 2048, 64 * nb, scr, lane); return; } r -= I1;
        if (r < I2) { const int kb = r / 48, nb = r % 48; transpose_item(I.mla_w_qb, 3072, 64 * kb, 64 * nb, I.mla_g_qa, (bf16*)(ws + WS_WT_QB), 512, 64 * nb, scr, lane); return; } r -= I2;
        if (r < I3) { const int kb = r / 64, nb = r % 64, n0 = 64 * nb, h = n0 >> 8, part = (n0 >> 7) & 1, d0 = n0 & 127;
            transpose_item(I.mla_w_kvb, 4096, 64 * kb, n0, I.mla_g_kva, (bf16*)(ws + WS_WT_KVB), 512, part * 2048 + h * 128 + d0, scr, lane); return; } r -= I3;
        if (r < I4) { const int kb = r / 32, nb = r % 32; transpose_item(I.mla_w_o, 2048, 64 * kb, 64 * nb, nullptr, (bf16*)(ws + WS_WT_MLA_O), 2048, 64 * nb, scr, lane); return; } r -= I4;
        if (r < I5) { const int kb = r / 128, nb = r % 128, n0 = 64 * nb, sec = n0 >> 11, dsec = (sec == 0) ? 0 : (sec == 1) ? 1 : (sec == 2) ? 3 : 2;
            transpose_item(I.fox_w_in, 8208, 64 * kb, n0, I.g_mix + 2048, (bf16*)(ws + WS_WT_FOX_IN), 2048, dsec * 2048 + (n0 & 2047), scr, lane); return; } r -= I5;
        if (r < I6) { const int kb = r / 32, nb = r % 32; transpose_item(I.fox_w_o, 2048, 64 * kb, 64 * nb, nullptr, (bf16*)(ws + WS_WT_FOX_O), 2048, 64 * nb, scr, lane); return; } r -= I6;
        if (r < I7) { const int kb = r / 32, nb = r % 32; transpose_item(I.pe_wq, 2048, 64 * kb, 64 * nb, I.g_ffn, (bf16*)(ws + WS_WT_PQ), 2048, 64 * nb, scr, lane); return; } r -= I7;
        { const int kb = r / 32, nb = r % 32; transpose_item(I.pe_wq + (size_t)2048 * 2048, 2048, 64 * kb, 64 * nb, I.g_ffn + 2048, (bf16*)(ws + WS_WT_PQ + 8 * MiB), 2048, 64 * nb, scr, lane); }
}
__device__ __forceinline__ void quant_pair(const In& I, unsigned char* ws, int lane, int row0) {
        f32x4 v[2][8]; float mx[2] = {0.f, 0.f};
#pragma unroll
        for (int u = 0; u < 2; ++u) { const int row = row0 + u, tbl = row >> 15, rr = row & 32767; const f32x4* src = (const f32x4*)((tbl ? I.pe_v : I.pe_u) + (size_t)rr * D) + lane;
#pragma unroll
            for (int q = 0; q < 8; ++q) v[u][q] = __builtin_nontemporal_load(src + 64 * q); }
#pragma unroll
        for (int u = 0; u < 2; ++u) {
#pragma unroll
            for (int i = 0; i < 8; ++i) { const f32x4 t = v[u][i]; mx[u] = fmaxf(mx[u], fmaxf(fmaxf(fabsf(t.x), fabsf(t.y)), fmaxf(fabsf(t.z), fabsf(t.w)))); }
#pragma unroll
            for (int o = 1; o < 64; o <<= 1) mx[u] = fmaxf(mx[u], __shfl_xor(mx[u], o));
        }
#pragma unroll
        for (int u = 0; u < 2; ++u) { const int row = row0 + u, tbl = row >> 15, rr = row & 32767;
            const float top = tbl ? 440.f : 127.f;
            const float inv = mx[u] > 0.f ? top / mx[u] : 1.f, sc = mx[u] > 0.f ? mx[u] / top : 1.f;
            v4u* dst = (v4u*)(ws + (tbl ? WS_PV : WS_PU) + (size_t)rr * D) + lane; unsigned dq[8];
#pragma unroll
            for (int q = 0; q < 8; ++q) { const f32x4 t = v[u][q] * inv; int w = 0;
                if (tbl) { w = __builtin_amdgcn_cvt_pk_fp8_f32(t.x, t.y, w, false); w = __builtin_amdgcn_cvt_pk_fp8_f32(t.z, t.w, w, true); }
                else w = (__float2int_rn(t.x) & 255) | ((__float2int_rn(t.y) & 255) << 8) | ((__float2int_rn(t.z) & 255) << 16) | (__float2int_rn(t.w) << 24);
                dq[q] = (unsigned)w; }
            if (tbl) {
#pragma unroll
                for (int q = 0; q < 8; ++q) ((unsigned*)dst)[64 * q - 3 * lane] = dq[q];
            } else { dst[0] = (v4u){dq[0], dq[1], dq[2], dq[3]}; dst[64] = (v4u){dq[4], dq[5], dq[6], dq[7]}; }
            if (lane == 0) ((float*)(ws + (tbl ? WS_PSV : WS_PSU)))[rr] = sc; }
}
constexpr int PE_FILL2 = 6144, PE_FILL3 = 7168;
__device__ __forceinline__ void p_table_fill(const Frame& F, const In& I, int row_lo, int nrows, int w, int NW) {
    for (int r = 2 * w; r < nrows; r += 2 * NW) quant_pair(I, F.ws, F.lane, row_lo + r);
}
__device__ __forceinline__ void p_prologue(const Frame& F, const In& I) {
    LAS float* scr = (LAS float*)(F.lds + RING_OFF + F.wave * 16640);
    const int gw = F.vcu * NWAVES + F.wave, NGW = F.G * NWAVES, lane = F.lane;
    unsigned char* ws = F.ws;
    constexpr int I1 = 17 * 32, I2 = 48 * 8, I3 = 64 * 8, I4 = 32 * 32, I5 = 128 * 32, I6 = 32 * 32, I7 = 32 * 32, I8 = 32 * 32;
    constexpr int NITEMS = I1 + I2 + I3 + I4 + I5 + I6 + I7 + I8;
    const int gt = F.vcu * 512 + F.tid, NGT = F.G * 512;
    for (int i = gt; i < 49152; i += NGT) ((v4u*)(ws + WS_WT_MLA_IN + (size_t)MLA_IN * 2048 * 2))[i] = (v4u){0u, 0u, 0u, 0u};
    for (int i = gt; i < 16 * 2048; i += NGT) { const int j = i >> 11, k = i & 2047; ((float*)(ws + WS_WF))[i] = I.fox_w_in[(size_t)k * 8208 + 8192 + j] * I.g_mix[2048 + k]; }
    for (int i = gt; i < 2 * 2 * 128 * 128; i += NGT) ((bf16*)(ws + WS_SKB))[i] = (bf16)f2bf(I.pe_sk[i]);
    for (int m = gw; m < T; m += NGW) {
        const f32x4* xr = (const f32x4*)(I.x + (size_t)m * D) + lane; f32x4 v[8]; float s = 0.f;
#pragma unroll
        for (int j = 0; j < 8; ++j) { v[j] = xr[64 * j]; s += (v[j].x * v[j].x + v[j].y * v[j].y) + (v[j].z * v[j].z + v[j].w * v[j].w); }
        s = wave_sum(s); if (lane == 0) ((float*)(ws + WS_SSQ))[SSQ_X0 + m] = s;
        v2u* o = (v2u*)(ws + WS_XB + (size_t)m * D * 2) + lane;
#pragma unroll
        for (int j = 0; j < 8; ++j) { v2u w; w.x = pk2(v[j].x, v[j].y); w.y = pk2(v[j].z, v[j].w); o[64 * j] = w; }
    }
    int tit = gw, tk3 = 0;
    constexpr int NPRO = 65536 - 16384 - PE_FILL2 - PE_FILL3;
    for (int vr = 2 * gw; vr < NPRO || tit < NITEMS; vr += 2 * NGW, ++tk3) {
        if ((tk3 % 2 == 0 || vr >= NPRO) && tit < NITEMS) { prologue_transpose_item(I, ws, scr, lane, tit); tit += NGW; }
        if (vr >= NPRO) continue;
        const int row0 = vr < 16384 ? vr : vr < 32768 ? 32768 + (vr - 16384) : 49152 + PE_FILL2 + (vr - 32768);
        quant_pair(I, ws, lane, row0);
    }
}

__device__ __forceinline__ void p_mla_tok(const Frame& F, const In& I) {
    const int gw = F.vcu * NWAVES + F.wave, NGW = F.G * NWAVES, lane = F.lane;
    const bf16* z0 = (const bf16*)(F.ws + WS_Z0); const float* sq = (const float*)(F.ws + WS_SSQ);
    const float gk2 = I.mla_g_k[128 + lane];
    const float inv_freq = __builtin_amdgcn_exp2f(-13.287712379549449f * (float)(2 * (lane & 31)) * (1.f / 64.f));
    for (int tok = gw; tok < T; tok += NGW) {
        const float ang = (float)I.pos[tok] * inv_freq; const float cs = __cosf(ang), sn = __sinf(ang);
        const float kr = bf2f(z0[(size_t)tok * MLA_INP + 1024 + lane]); const float kr_ss = wave_sum(kr * kr);
        const float krg = kr * gk2, pb = __shfl_xor(krg, 32);
        const float rot = (lane < 32) ? (krg * cs - pb * sn) : (krg * cs + pb * sn);
        ((bf16*)(F.ws + WS_KRG))[(size_t)tok * 64 + lane] = (bf16)f2bf(rot);
        ((float*)(F.ws + WS_ROPE))[(size_t)tok * 64 + lane] = (lane < 32) ? cs : sn;
        if (lane == 0) { ((float*)(F.ws + WS_RCKV))[tok] = __builtin_amdgcn_rsqf(pg8::slot_sum(sq + SSQ_CKV + (size_t)tok * 8, 8) * (1.f / 512.f) + RMS_EPS); ((float*)(F.ws + WS_KRSS))[tok] = kr_ss; }
    }
}

__device__ __forceinline__ void p_fox_prep(const Frame& F, const In& I) {
    const int gw = F.vcu * NWAVES + F.wave, NGW = F.G * NWAVES, lane = F.lane;
    bf16* z = (bf16*)(F.ws + WS_Z);
    const float QS = 0.08838834764831845f * LOG2E;
    const float gq0 = I.fox_g_q[lane], gq1 = I.fox_g_q[64 + lane], gk0 = I.fox_g_k[lane], gk1 = I.fox_g_k[64 + lane];
    for (int tok = gw; tok < T; tok += NGW) {
        bf16* zr = z + (size_t)tok * FOX_ZN;
        for (int h = 0; h < FOX_H; ++h) {
            bf16* qp = zr + h * 128; bf16* kp = zr + 2048 + h * 128;
            float a0 = bf2f(qp[lane]), a1 = bf2f(qp[64 + lane]), b0 = bf2f(kp[lane]), b1 = bf2f(kp[64 + lane]);
            const float rq = __builtin_amdgcn_rsqf(wave_sum(a0 * a0 + a1 * a1) * (1.f / 128.f) + RMS_EPS) * QS;
            const float rk = __builtin_amdgcn_rsqf(wave_sum(b0 * b0 + b1 * b1) * (1.f / 128.f) + RMS_EPS);
            qp[lane] = (bf16)f2bf(a0 * rq * gq0); qp[64 + lane] = (bf16)f2bf(a1 * rq * gq1);
            kp[lane] = (bf16)f2bf(b0 * rk * gk0); kp[64 + lane] = (bf16)f2bf(b1 * rk * gk1);
        }
    }
}

struct AttnAux { const float *gq, *gk, *ksq, *cqs, *rope, *rckv, *krss; const bf16* krg; };
template <int DK> struct AttnCfg { static constexpr int KP = DK + 8, KB_BYTES = 64 * KP * 2, VP = 72, VB_BYTES = 128 * VP * 2, NKS = DK / 16, KPT = (64 * DK / 8) / 512,
    OFF_K = 0, OFF_V = 2 * KB_BYTES, OFF_CL = OFF_V + 2 * VB_BYTES, OFF_WS = OFF_CL + 8192, OFF_RK = OFF_WS + 64, END = OFF_RK + 8192; };
template <int DK, bool FOX>
__device__ __forceinline__ void attn_unit(LAS unsigned char* lds, const bf16* __restrict__ Q, int qpitch, const bf16* __restrict__ K, int kpitch, const bf16* __restrict__ Vt, bf16* __restrict__ O,
                                          const bf16* __restrict__ gate, int gpitch, const float* __restrict__ lf, const AttnAux& ax,
                                          int b, int h, int qb, int tid, int wid, int lane, int qb_next) {
    const float* __restrict__ gq = ax.gq; const float* __restrict__ gk = ax.gk; const float* __restrict__ ksq = ax.ksq;
    typedef AttnCfg<DK> C;
    static_assert(C::END <= RING_BYTES, "attention LDS");
    asm volatile("" : "+v"(tid), "+v"(lane));
    const int r = lane & 31, hh = lane >> 5;
    const int tok0 = b * SEQ, q0 = qb * 256 + wid * 32, jw = q0 >> 6, jmax = qb * 4 + 3;
    constexpr int KPPR = DK / 8 + 1, KNI = 64 * KPPR / 64, VPPR = 9, VNI = 128 * VPPR / 64;
    static_assert(KPPR * 16 == C::KP * 2 && VPPR * 16 == C::VP * 2, "LDS pitches");
    const char* kbase_u = (const char*)(K + (size_t)tok0 * kpitch + h * (FOX ? DK : 128)); const char* vbase_u = (const char*)(Vt + (size_t)h * 128 * T + tok0);
    const char* krbase_u = FOX ? kbase_u : (const char*)(ax.krg + (size_t)tok0 * 64);
    unsigned kg[4], vg[3]; bool kr_[4];
#pragma unroll
    for (int i = 0; i < 4; ++i) { const int p = 64 * (wid + 8 * i) + lane, key = p / KPPR, c = p % KPPR;
        if (FOX) { kr_[i] = false; kg[i] = (unsigned)(key * kpitch + (c < DK / 8 ? c * 8 : 0)) * 2u; }
        else { kr_[i] = (c >= 16 && c < 24); kg[i] = kr_[i] ? (unsigned)(key * 64 + 8 * (c - 16)) * 2u : (unsigned)(key * kpitch + (c < 16 ? c * 8 : 0)) * 2u; } }
#pragma unroll
    for (int i = 0; i < 3; ++i) { const int p = 64 * (wid + 8 * i) + lane, dv = p / VPPR, c = p % VPPR; vg[i] = (unsigned)(dv * T + (c < 8 ? c * 8 : 0)) * 2u; }
#define ATT_STAGE(j, buf) do { const char* _kb = kbase_u + (size_t)(j) * 64 * kpitch * 2; const char* _rb = krbase_u + (size_t)(j) * 64 * 64 * 2; const char* _vb = vbase_u + (size_t)(j) * 128; \
        _Pragma("unroll") for (int i = 0; i < 4; ++i) if (wid + 8 * i < KNI) __builtin_amdgcn_global_load_lds((const unsigned*)(((!FOX && kr_[i]) ? _rb : _kb) + kg[i]), (LAS unsigned*)(lds + C::OFF_K + (buf) * C::KB_BYTES + 1024 * (wid + 8 * i)), 16, 0, 0); \
        _Pragma("unroll") for (int i = 0; i < 3; ++i) if (wid + 8 * i < VNI) __builtin_amdgcn_global_load_lds((const unsigned*)(_vb + vg[i]), (LAS unsigned*)(lds + C::OFF_V + (buf) * C::VB_BYTES + 1024 * (wid + 8 * i)), 16, 0, 0); } while (0)
#define ATT_SYNC() do { asm volatile("s_waitcnt vmcnt(0)" ::: "memory"); __syncthreads(); } while (0)
    ATT_STAGE(jmax, 0);
    bf16x8 qf[C::NKS];
    {
        LAS unsigned char* qst = lds + C::END + wid * 4608;
        const int rr_ = lane >> 3, cc_ = lane & 7;
        v4u qg[C::NKS / 4][4];
#pragma unroll
        for (int rd = 0; rd < C::NKS / 4; ++rd)
#pragma unroll
            for (int i = 0; i < 4; ++i) qg[rd][i] = *(const v4u*)(Q + (size_t)(tok0 + q0 + 8 * i + rr_) * qpitch + h * DK + 64 * rd + 8 * cc_);
#pragma unroll
        for (int rd = 0; rd < C::NKS / 4; ++rd) {
#pragma unroll
            for (int i = 0; i < 4; ++i) *(LAS v4u*)(qst + (8 * i + rr_) * 144 + cc_ * 16) = qg[rd][i];
            asm volatile("s_waitcnt lgkmcnt(0)" ::: "memory");
#pragma unroll
            for (int k4 = 0; k4 < 4; ++k4) qf[4 * rd + k4] = *(const LAS bf16x8*)(qst + r * 144 + k4 * 32 + hh * 16);
            asm volatile("s_waitcnt lgkmcnt(0)" ::: "memory");
        }
    }
    LAS float* cl = (LAS float*)(lds + C::OFF_CL);
    LAS float* rkl = (LAS float*)(lds + C::OFF_RK);
    if constexpr (FOX) {
        LAS float* wsum = (LAS float*)(lds + C::OFF_WS);
        const int n = (qb + 1) * 256; float v[4]; f32x4 kqv[4];
        { const f32x4 t4 = *(const f32x4*)(lf + (size_t)h * T + tok0 + 4 * tid);
#pragma unroll
          for (int e = 0; e < 4; ++e) v[e] = (4 * tid + e < n) ? t4[e] : 0.f; }
#pragma unroll
        for (int e = 0; e < 4; ++e) kqv[e] = *(const f32x4*)(ksq + ((size_t)h * T + tok0 + tid + 512 * e) * 4);
        {
            float ss = 0.f;
#pragma unroll
            for (int ks = 0; ks < C::NKS; ++ks)
#pragma unroll
                for (int j = 0; j < 8; ++j) { const float v_ = bf2f((unsigned short)qf[ks][j]); ss += v_ * v_; }
            ss = pair_sum(ss);
            const float rq = __builtin_amdgcn_rsqf(ss * (1.f / 128.f) + RMS_EPS) * (0.08838834764831845f * LOG2E);
#pragma unroll
            for (int ks = 0; ks < C::NKS; ++ks) { const int d0 = 16 * ks + 8 * hh; const f32x4 ga = *(const f32x4*)(gq + d0), gb = *(const f32x4*)(gq + d0 + 4), ka = *(const f32x4*)(gk + d0), kb2 = *(const f32x4*)(gk + d0 + 4);
                v4u w; w.x = pk2(bf2f((unsigned short)qf[ks][0]) * rq * ga.x * ka.x, bf2f((unsigned short)qf[ks][1]) * rq * ga.y * ka.y); w.y = pk2(bf2f((unsigned short)qf[ks][2]) * rq * ga.z * ka.z, bf2f((unsigned short)qf[ks][3]) * rq * ga.w * ka.w);
                w.z = pk2(bf2f((unsigned short)qf[ks][4]) * rq * gb.x * kb2.x, bf2f((unsigned short)qf[ks][5]) * rq * gb.y * kb2.y); w.w = pk2(bf2f((unsigned short)qf[ks][6]) * rq * gb.z * kb2.z, bf2f((unsigned short)qf[ks][7]) * rq * gb.w * kb2.w);
                qf[ks] = __builtin_bit_cast(bf16x8, w); }
        }
        v[1] += v[0]; v[2] += v[1]; v[3] += v[2];
        const float tot = v[3]; float sc = tot;
#pragma unroll
        for (int o = 1; o < 64; o <<= 1) { const float t = __shfl_up(sc, o); if (lane >= o) sc += t; }
        if (lane == 63) wsum[wid] = sc;
#pragma unroll
        for (int e = 0; e < 4; ++e) rkl[tid + 512 * e] = __builtin_amdgcn_rsqf(((kqv[e].x + kqv[e].y) + (kqv[e].z + kqv[e].w)) * (1.f / 128.f) + RMS_EPS);
        __syncthreads();
        float base = 0.f;
#pragma unroll
        for (int w = 0; w < 8; ++w) base += (w < wid) ? wsum[w] : 0.f;
        const float excl = base + sc - tot;
#pragma unroll
        for (int e = 0; e < 4; ++e) cl[4 * tid + e] = (excl + v[e]) * LOG2E;
    }
    if constexpr (!FOX) {
        f32x4 kqm[4]; float rcm[4], krm[4];
        { const int n = (qb + 1) * 256;
#pragma unroll
          for (int e = 0; e < 4; ++e) { const int sx = tid + 512 * e; kqm[e] = *(const f32x4*)(ksq + ((size_t)h * T + tok0 + sx) * 4); rcm[e] = ax.rckv[tok0 + sx]; krm[e] = ax.krss[tok0 + sx]; } (void)n; }
        {
            const int tokq = tok0 + q0 + r;
            const float rcq = __builtin_amdgcn_rsqf(pg8::slot_sum(ax.cqs + (size_t)tokq * 8, 8) * (1.f / 512.f) + RMS_EPS);
            float ss = 0.f;
#pragma unroll
            for (int ks = 0; ks < C::NKS; ++ks)
#pragma unroll
                for (int j = 0; j < 8; ++j) { const float v = bf2f((unsigned short)qf[ks][j]); ss += v * v; }
            ss = pair_sum(ss) * rcq * rcq;
            const float sc = rcq * __builtin_amdgcn_rsqf(ss * (1.f / 192.f) + RMS_EPS) * (0.07216878364870322f * LOG2E);
#pragma unroll
            for (int ks = 0; ks < 8; ++ks) { const int d0 = 16 * ks + 8 * hh; const f32x4 ga = *(const f32x4*)(gq + d0), gb = *(const f32x4*)(gq + d0 + 4), ka = *(const f32x4*)(gk + d0), kb2 = *(const f32x4*)(gk + d0 + 4);
                v4u w; w.x = pk2(bf2f((unsigned short)qf[ks][0]) * sc * ga.x * ka.x, bf2f((unsigned short)qf[ks][1]) * sc * ga.y * ka.y); w.y = pk2(bf2f((unsigned short)qf[ks][2]) * sc * ga.z * ka.z, bf2f((unsigned short)qf[ks][3]) * sc * ga.w * ka.w);
                w.z = pk2(bf2f((unsigned short)qf[ks][4]) * sc * gb.x * kb2.x, bf2f((unsigned short)qf[ks][5]) * sc * gb.y * kb2.y); w.w = pk2(bf2f((unsigned short)qf[ks][6]) * sc * gb.z * kb2.z, bf2f((unsigned short)qf[ks][7]) * sc * gb.w * kb2.w);
                qf[ks] = __builtin_bit_cast(bf16x8, w); }
#pragma unroll
            for (int kk = 0; kk < 2; ++kk) { const int i0 = 16 * kk + 8 * hh; const float* rp = ax.rope + (size_t)tokq * 64 + i0;
                const f32x4 c0 = *(const f32x4*)rp, c1 = *(const f32x4*)(rp + 4), s0_ = *(const f32x4*)(rp + 32), s1_ = *(const f32x4*)(rp + 36);
                const f32x4 g10 = *(const f32x4*)(gq + 128 + i0), g11 = *(const f32x4*)(gq + 132 + i0), g20 = *(const f32x4*)(gq + 160 + i0), g21 = *(const f32x4*)(gq + 164 + i0);
                float o1[8], o2[8];
#pragma unroll
                for (int j = 0; j < 8; ++j) { const float cj = j < 4 ? c0[j & 3] : c1[j & 3], sj = j < 4 ? s0_[j & 3] : s1_[j & 3], g1 = j < 4 ? g10[j & 3] : g11[j & 3], g2 = j < 4 ? g20[j & 3] : g21[j & 3];
                    const float x1 = bf2f((unsigned short)qf[8 + kk][j]) * sc * g1, x2 = bf2f((unsigned short)qf[10 + kk][j]) * sc * g2; o1[j] = x1 * cj - x2 * sj; o2[j] = x2 * cj + x1 * sj; }
                v4u w1, w2; w1.x = pk2(o1[0], o1[1]); w1.y = pk2(o1[2], o1[3]); w1.z = pk2(o1[4], o1[5]); w1.w = pk2(o1[6], o1[7]); w2.x = pk2(o2[0], o2[1]); w2.y = pk2(o2[2], o2[3]); w2.z = pk2(o2[4], o2[5]); w2.w = pk2(o2[6], o2[7]);
                qf[8 + kk] = __builtin_bit_cast(bf16x8, w1); qf[10 + kk] = __builtin_bit_cast(bf16x8, w2); }
        }
        {
#pragma unroll
            for (int e = 0; e < 4; ++e) { const int sx = tid + 512 * e; const f32x4 kq = kqm[e]; const float rc = rcm[e];
                const float rk = __builtin_amdgcn_rsqf((((kq.x + kq.y) + (kq.z + kq.w)) + krm[e]) * (1.f / 192.f) + RMS_EPS); rkl[sx] = rk; (void)rc; }
        }
    }
    f32x16 o[4];
#pragma unroll
    for (int i = 0; i < 4; ++i)
#pragma unroll
        for (int e = 0; e < 16; ++e) o[i][e] = 0.f;
    float m = -1e30f, l = 0.f;
    ATT_SYNC();
#pragma unroll 1
    for (int jj = 0; jj <= jmax; ++jj) { const int j = jmax - jj;
        if (jj < jmax) ATT_STAGE(j - 1, (jj + 1) & 1);
        unsigned pfq = 0u;
        if (qb_next >= 0 && jj == jmax - 1) { const int row = lane >> 1, part = lane & 1;
            const bf16* qn = Q + (size_t)(tok0 + qb_next * 256 + wid * 32 + row) * qpitch + h * DK + 64 * part;
            pfq = *(const unsigned*)qn; if (DK > 128) pfq += *(const unsigned*)(qn + 128); }
        if (j <= jw) {
#pragma unroll
            for (int kb2 = 0; kb2 < 2; ++kb2) { const int kbk = 1 - kb2;
                if (FOX && kbk == 1 && j == jw && (wid & 1) == 0) continue;
                f32x16 s0;
#pragma unroll
                for (int e = 0; e < 16; ++e) s0[e] = 0.f;
                const LAS unsigned char* kb = lds + C::OFF_K + (jj & 1) * C::KB_BYTES + ((32 * kbk + r) * C::KP + 8 * hh) * 2;
                if constexpr (FOX) {
#pragma unroll
                    for (int ks = 0; ks < C::NKS; ++ks) {
                        const bf16x8 a0 = *(const LAS bf16x8*)(kb + ks * 32);
                        s0 = __builtin_amdgcn_mfma_f32_32x32x16_bf16(a0, qf[ks], s0, 0, 0, 0);
                    }
                } else {
#pragma unroll
                    for (int ks = 0; ks < 12; ++ks) { const bf16x8 a0 = *(const LAS bf16x8*)(kb + ks * 32); s0 = __builtin_amdgcn_mfma_f32_32x32x16_bf16(a0, qf[ks], s0, 0, 0, 0); }
                    const LAS f32x4* r4 = (const LAS f32x4*)(rkl + 64 * j + 32 * kbk + 4 * hh);
#pragma unroll
                    for (int g = 0; g < 4; ++g) { const f32x4 rr = r4[2 * g];
#pragma unroll
                        for (int e = 0; e < 4; ++e) s0[4 * g + e] *= rr[e]; }
                }
                if constexpr (FOX) {
                    const LAS f32x4* c4 = (const LAS f32x4*)(cl + 64 * j + 32 * kbk + 4 * hh); const LAS f32x4* r4 = (const LAS f32x4*)(rkl + 64 * j + 32 * kbk + 4 * hh);
#pragma unroll
                    for (int g = 0; g < 4; ++g) { const f32x4 c0 = c4[2 * g], rr = r4[2 * g];
#pragma unroll
                        for (int e = 0; e < 4; ++e) s0[4 * g + e] = s0[4 * g + e] * rr[e] - c0[e]; }
                    if (j == jw) {
                        const int qrow = q0 + r, kbase = 64 * j + 32 * kbk + 4 * hh;
#pragma unroll
                        for (int e = 0; e < 16; ++e) { const int key = kbase + (e & 3) + 8 * (e >> 2); if (key > qrow) s0[e] = -1e30f; }
                    }
                }
                float mx = s0[0];
#pragma unroll
                for (int e = 1; e < 16; ++e) mx = fmaxf(mx, s0[e]);
                mx = pair_max(mx);
                const float mn = fmaxf(m, mx);
                if (__any(mn - m > 8.f)) {
                    const float alpha = __builtin_amdgcn_exp2f(m - mn);
                    l *= alpha;
#pragma unroll
                    for (int i = 0; i < 4; ++i)
#pragma unroll
                        for (int e = 0; e < 16; ++e) o[i][e] *= alpha;
                    m = mn;
                }
                float ps = 0.f;
#pragma unroll
                for (int e = 0; e < 16; ++e) { s0[e] = __builtin_amdgcn_exp2f(s0[e] - m); ps += s0[e]; }
                l += ps;
                bf16x8 p[2];
#pragma unroll
                for (int s = 0; s < 2; ++s) {
                    v4u w0;
                    w0.x = pk2(s0[8 * s + 0], s0[8 * s + 1]); w0.y = pk2(s0[8 * s + 2], s0[8 * s + 3]); w0.z = pk2(s0[8 * s + 4], s0[8 * s + 5]); w0.w = pk2(s0[8 * s + 6], s0[8 * s + 7]);
                    p[s] = __builtin_bit_cast(bf16x8, w0);
                }
                const LAS unsigned char* vb = lds + C::OFF_V + (jj & 1) * C::VB_BYTES + (r * C::VP + 32 * kbk + 8 * hh) * 2;
#pragma unroll
                for (int dvb = 0; dvb < 4; ++dvb)
#pragma unroll
                    for (int s = 0; s < 2; ++s) {
                        const bf16x8 a = *(const LAS bf16x8*)(vb + (dvb * 32 * C::VP + 16 * s) * 2);
                        o[dvb] = __builtin_amdgcn_mfma_f32_32x32x16_bf16(a, p[s], o[dvb], 0, 0, 0);
                    }
            }
        }
        ATT_SYNC();
        asm volatile("" :: "v"(pfq));
    }
#undef ATT_STAGE
#undef ATT_SYNC
    l = pair_sum(l);
    const float inv = 1.f / l;
    int re = r, he = hh; asm volatile("" : "+v"(re), "+v"(he));
    static_assert(C::END + 8 * 4608 <= LDSCTL_OFF, "attention O staging");
    LAS unsigned char* ost = lds + C::END + wid * 4608;
    const int rr = lane >> 3, cc = lane & 7;
    const size_t orow0 = (size_t)(tok0 + q0);
#pragma unroll
    for (int half = 0; half < 2; ++half) {
#pragma unroll
        for (int d2 = 0; d2 < 2; ++d2)
#pragma unroll
            for (int g = 0; g < 4; ++g) { const int dvb = 2 * half + d2;
                v2u w; w.x = pk2(o[dvb][4 * g + 0] * inv, o[dvb][4 * g + 1] * inv); w.y = pk2(o[dvb][4 * g + 2] * inv, o[dvb][4 * g + 3] * inv);
                *(LAS v2u*)(ost + re * 144 + (d2 * 32 + 8 * g + 4 * he) * 2) = w; }
        asm volatile("s_waitcnt lgkmcnt(0)" ::: "memory");
#pragma unroll
        for (int i = 0; i < 4; ++i) { const int row = 8 * i + rr;
            v4u w = *(const LAS v4u*)(ost + row * 144 + cc * 16);
            if constexpr (FOX) {
                const v4u gw = *(const v4u*)(gate + (orow0 + row) * gpitch + h * 128 + half * 64 + cc * 8);
#pragma unroll
                for (int c = 0; c < 4; ++c) { const float lo = bflo(w[c]) * __builtin_amdgcn_rcpf(1.f + __builtin_amdgcn_exp2f(-LOG2E * bflo(gw[c]))), hi = bfhi(w[c]) * __builtin_amdgcn_rcpf(1.f + __builtin_amdgcn_exp2f(-LOG2E * bfhi(gw[c]))); w[c] = pk2(lo, hi); }
            }
            *(v4u*)(O + (orow0 + row) * 2048 + h * 128 + half * 64 + cc * 8) = w; }
        asm volatile("s_waitcnt lgkmcnt(0)" ::: "memory");
    }
}
template <int DK, bool FOX>
__device__ __forceinline__ void p_attention(const Frame& F, const bf16* Q, int qpitch, const bf16* K, int kpitch, const bf16* Vt, bf16* O, const bf16* gate, int gpitch, const float* lf, const AttnAux& ax) {
    for (int u = F.vcu; u < 256; u += F.G) {
        const int bh = u >> 2, p = u & 3, b = bh >> 4, h = bh & 15;
#pragma unroll 1
        for (int half = 0; half < 2; ++half)
            attn_unit<DK, FOX>(F.lds + RING_OFF, Q, qpitch, K, kpitch, Vt, O, gate, gpitch, lf, ax, b, h, half ? p : 7 - p, F.tid, F.wave, F.lane, half ? -1 : p);
    }
}

__device__ __forceinline__ unsigned sortkey(float s) { const unsigned b = __float_as_uint(s); return b ^ ((unsigned)((int)b >> 31) | 0x80000000u); }
__device__ __forceinline__ float unsortkey(unsigned k) { return __uint_as_float((k & 0x80000000u) ? (k ^ 0x80000000u) : ~k); }
#define TOP_INSERT(top, x) do { unsigned _x = (x); _Pragma("unroll") for (int _i = 0; _i < 16; ++_i) { const unsigned _h = max((top)[_i], _x); _x = min((top)[_i], _x); (top)[_i] = _h; } } while (0)
__device__ __forceinline__ int sel16(const int (&a)[16], int i) { int r = a[0];
#pragma unroll
    for (int q = 1; q < 16; ++q) r = (i == q) ? a[q] : r;
    return r; }
#define CE_DESC(a, b) do { const unsigned _hi = max((a), (b)), _lo = min((a), (b)); (a) = _hi; (b) = _lo; } while (0)
__device__ __forceinline__ void bitonic_merge16_desc(unsigned (&v)[16]) {
#pragma unroll
    for (int j = 8; j > 0; j >>= 1)
#pragma unroll
        for (int i = 0; i < 16; ++i) if ((i & j) == 0) CE_DESC(v[i], v[i | j]);
}
__device__ __forceinline__ void sort16_desc(unsigned (&v)[16]) {
#define S16(a, b) CE_DESC(v[a], v[b])
    S16(0, 13); S16(1, 12); S16(2, 15); S16(3, 14); S16(4, 8); S16(5, 6); S16(7, 11); S16(9, 10);
    S16(0, 5); S16(1, 7); S16(2, 9); S16(3, 4); S16(6, 13); S16(8, 14); S16(10, 15); S16(11, 12);
    S16(0, 1); S16(2, 3); S16(4, 5); S16(6, 8); S16(7, 9); S16(10, 11); S16(12, 13); S16(14, 15);
    S16(0, 2); S16(1, 3); S16(4, 10); S16(5, 11); S16(6, 7); S16(8, 9); S16(12, 14); S16(13, 15);
    S16(1, 2); S16(3, 12); S16(4, 6); S16(5, 7); S16(8, 10); S16(9, 11); S16(13, 14);
    S16(1, 4); S16(2, 6); S16(5, 8); S16(7, 10); S16(9, 13); S16(11, 14);
    S16(2, 4); S16(3, 6); S16(9, 12); S16(11, 13);
    S16(3, 5); S16(6, 8); S16(7, 9); S16(10, 12);
    S16(3, 4); S16(5, 6); S16(7, 8); S16(9, 10); S16(11, 12);
    S16(6, 7); S16(8, 9);
#undef S16
}
__device__ __forceinline__ void merge_top16(unsigned (&top)[16], const unsigned (&b)[16]) {
#pragma unroll
    for (int i = 0; i < 16; ++i) top[i] = max(top[i], b[15 - i]);
    bitonic_merge16_desc(top);
}
__device__ __forceinline__ void peer_half_top16(const bf16* __restrict__ qrow  , const bf16* __restrict__ sk  , int hh, unsigned (&top)[16]) {
#pragma unroll
    for (int i = 0; i < 16; ++i) top[i] = 0u;
    bf16x8 qf[8], an[8];
#pragma unroll
    for (int ks = 0; ks < 8; ++ks) { qf[ks] = *(const bf16x8*)(qrow + 16 * ks); an[ks] = *(const bf16x8*)(sk + 16 * ks); }
#pragma unroll 1
    for (int kb = 0; kb < 4; ++kb) {
        f32x16 acc;
#pragma unroll
        for (int e = 0; e < 16; ++e) acc[e] = 0.f;
        bf16x8 a[8];
#pragma unroll
        for (int ks = 0; ks < 8; ++ks) a[ks] = an[ks];
        const bf16* skn = sk + (size_t)(kb < 3 ? kb + 1 : 3) * 32 * 128;
#pragma unroll
        for (int ks = 0; ks < 8; ++ks) an[ks] = *(const bf16x8*)(skn + 16 * ks);
#pragma unroll
        for (int ks = 0; ks < 8; ++ks) acc = __builtin_amdgcn_mfma_f32_32x32x16_bf16(a[ks], qf[ks], acc, 0, 0, 0);
        const int kbase = 127 - (32 * kb + 4 * hh);
        unsigned nv[16];
#pragma unroll
        for (int e = 0; e < 16; ++e) nv[e] = (sortkey(acc[e]) & ~127u) | (unsigned)(kbase - ((e & 3) + 8 * (e >> 2)));
        sort16_desc(nv); merge_top16(top, nv);
    }
    unsigned pt[16];
#pragma unroll
    for (int i = 0; i < 16; ++i) pt[i] = (unsigned)__shfl_xor((int)top[i], 32);
    merge_top16(top, pt);
}
constexpr int PE_OFF_IDX = 0, PE_OFF_G = 16384, PE_OFF_TB = 32768;
__device__ __forceinline__ void peer_topk(const Frame& F, int layer, int t0) {
    const int lane = F.lane, r = lane & 31, hh = lane >> 5, head = F.wave;
    const bf16* qp = (const bf16*)(F.ws + WS_QP) + (size_t)(t0 + r) * 2048 + head * 256 + 8 * hh;
    const bf16* sk = (const bf16*)(F.ws + WS_SKB) + (size_t)layer * 2 * 128 * 128 + r * 128 + 8 * hh;
    unsigned t1[16], t2[16];
    peer_half_top16(qp, sk, hh, t1);
    peer_half_top16(qp + 128, sk + 128 * 128, hh, t2);
    int rr = r; asm volatile("" : "+v"(rr));
    const float rs = __builtin_amdgcn_rsqf(pg8::slot_sum((const float*)(F.ws + WS_SSQ) + SSQ_XS + (size_t)(t0 + rr) * 32, 32) * (1.f / 2048.f) + RMS_EPS);
    float v1[16], v2[16]; int e1[16], e2[16];
#pragma unroll
    for (int i = 0; i < 16; ++i) { v1[i] = unsortkey(t1[i] & ~127u) * rs; e1[i] = 127 - (int)(t1[i] & 127u); v2[i] = unsortkey(t2[i] & ~127u) * rs; e2[i] = 127 - (int)(t2[i] & 127u); }
    unsigned best[16], g1[16], g2[16], g3[16];
#pragma unroll
    for (int i = 0; i < 16; ++i) { best[i] = 0u; g1[i] = 0u; g2[i] = 0u; g3[i] = 0u; }
    { int n = 0;
#pragma unroll
      for (int i = 0; i < 16; ++i)
#pragma unroll
        for (int j = 0; j < 16; ++j)
            if ((i + 1) * (j + 1) <= 16) { const unsigned kx = (sortkey(v1[i] + v2[j]) & ~255u) | (unsigned)(255 - (i * 16 + j));
                if (n < 16) best[n & 15] = kx; else if (n < 32) g1[n & 15] = kx; else if (n < 48) g2[n & 15] = kx; else g3[n & 15] = kx; ++n; } }
    sort16_desc(best); sort16_desc(g1); sort16_desc(g2); sort16_desc(g3);
    merge_top16(best, g1); merge_top16(best, g2); merge_top16(best, g3);
    float sc[16]; int ex[16];
    LAS int* tb = (LAS int*)(F.lds + RING_OFF + PE_OFF_TB) + F.wave * 2048 + lane;
#pragma unroll
    for (int i = 0; i < 16; ++i) { tb[i * 64] = e1[i]; tb[(16 + i) * 64] = e2[i]; }
#pragma unroll
    for (int k = 0; k < 16; ++k) { const int pos = 255 - (int)(best[k] & 255u); ex[k] = tb[(pos >> 4) * 64] * PE_NK + tb[(16 + (pos & 15)) * 64]; sc[k] = unsortkey(best[k] & ~255u); }
    float sum = 0.f; const float smax = sc[0];
#pragma unroll
    for (int k = 0; k < 16; ++k) { sc[k] = __expf(sc[k] - smax); sum += sc[k]; }
    const float inv = 1.f / sum;
    LAS int* li = (LAS int*)(F.lds + RING_OFF + PE_OFF_IDX) + r * PE_SEL + head * 16;
    LAS float* lg = (LAS float*)(F.lds + RING_OFF + PE_OFF_G) + r * PE_SEL + head * 16;
    if (hh == 0) {
#pragma unroll
        for (int k = 0; k < 16; ++k) li[k] = ex[k];
    } else {
#pragma unroll
        for (int k = 0; k < 16; ++k) lg[k] = sc[k] * inv;
    }
}
__device__ __forceinline__ float group_sum64(float v) {
    const int i0 = __builtin_bit_cast(int, v);
    v += __builtin_bit_cast(float, __builtin_amdgcn_update_dpp(0, i0, 0x111, 0xf, 0xf, true));
    v += __builtin_bit_cast(float, __builtin_amdgcn_update_dpp(0, __builtin_bit_cast(int, v), 0x112, 0xf, 0xf, true));
    v += __builtin_bit_cast(float, __builtin_amdgcn_update_dpp(0, __builtin_bit_cast(int, v), 0x114, 0xf, 0xf, true));
    v += __builtin_bit_cast(float, __builtin_amdgcn_update_dpp(0, __builtin_bit_cast(int, v), 0x118, 0xf, 0xf, true));
    v += __builtin_bit_cast(float, __builtin_amdgcn_update_dpp(0, __builtin_bit_cast(int, v), 0x142, 0xa, 0xf, false));
    v += __builtin_bit_cast(float, __builtin_amdgcn_update_dpp(0, __builtin_bit_cast(int, v), 0x143, 0xc, 0xf, false));
    return v;
}
__device__ __forceinline__ float gelu_erf(float x) { return 0.5f * x * (1.f + erff(x * 0.7071067811865476f)); }
typedef float f32x2 __attribute__((ext_vector_type(2)));
__device__ __forceinline__ void sort128(unsigned& kA, unsigned& kB, int lane) {
#pragma unroll
    for (int k = 2; k <= 128; k <<= 1)
#pragma unroll
        for (int j = k >> 1; j > 0; j >>= 1) {
            if (j == 64) { const unsigned lo = min(kA, kB), hi = max(kA, kB); kA = lo; kB = hi; }
            else {
                const unsigned pA = (unsigned)__shfl_xor((int)kA, j), pB = (unsigned)__shfl_xor((int)kB, j);
                const bool lower = (lane & j) == 0, upA = (lane & k) == 0, upB = ((lane + 64) & k) == 0;
                kA = (lower == upA) ? min(kA, pA) : max(kA, pA);
                kB = (lower == upB) ? min(kB, pB) : max(kB, pB);
            }
        }
}
constexpr int PE_NS = 32, PE_SLICE = PE_NE / PE_NS;
constexpr int PE_PACE = 64;
typedef int v4i __attribute__((ext_vector_type(4)));
constexpr int PE_D = 7;
constexpr int PE2_KEYS = 0, PE2_G = 16384, PE2_A = 32768, PE2_ORD = 49152, PE2_CT = 65536, PE2_RING = 73728, PE2_END = PE2_RING + 8 * 5 * 2048;
static_assert(PE2_G == PE_OFF_G && PE2_KEYS == PE_OFF_IDX && PE2_END <= 160 * 1024 - 1024, "peer LDS map");
#define PE_WAITV(n) asm volatile("s_waitcnt vmcnt(" #n ")" ::: "memory")
template <int LAYER>
__device__ __forceinline__ void peer_gather4(const Frame& F, const In& I, int t0w, int tl0, int dry) {
    const int lane = F.lane, wv = F.wave;
    const float* gain = I.g_ffn + LAYER * 2048;
    const unsigned char* ut = F.ws + WS_PU + (size_t)LAYER * PE_NE * D + lane * 16;
    const unsigned char* vt = F.ws + WS_PV + (size_t)LAYER * PE_NE * D + lane * 16;
    const float* su = (const float*)(F.ws + WS_PSU) + LAYER * PE_NE; const float* sv = (const float*)(F.ws + WS_PSV) + LAYER * PE_NE;
    LAS unsigned* keys = (LAS unsigned*)(F.lds + RING_OFF + PE2_KEYS) + tl0 * PE_SEL;
    LAS float* lg = (LAS float*)(F.lds + RING_OFF + PE2_G) + tl0 * PE_SEL;
    LAS float* la = (LAS float*)(F.lds + RING_OFF + PE2_A) + tl0 * PE_SEL;
    LAS unsigned* ord = (LAS unsigned*)(F.lds + RING_OFF + PE2_ORD) + wv * 512;
    LAS int* ct = (LAS int*)(F.lds + RING_OFF + PE2_CT) + wv * 256;
    LAS unsigned char* ring = F.lds + RING_OFF + PE2_RING + wv * (5 * 2048);
    LAS unsigned char* ring5 = F.lds + RING_OFF + PE2_KEYS + wv * 2048;
    LAS unsigned char* ring6 = F.lds + RING_OFF + PE2_G + wv * 2048;
#define PE_SLOT(sl) (((sl) < 5) ? ring + (sl) * 2048 : ((sl) == 5) ? ring5 : ring6)
    unsigned sA[4], sB[4];
#pragma unroll
    for (int tk = 0; tk < 4; ++tk) {
        sA[tk] = (keys[tk * PE_SEL + lane] << 7) | (unsigned)lane; sB[tk] = (keys[tk * PE_SEL + 64 + lane] << 7) | (unsigned)(64 + lane);
        sort128(sA[tk], sB[tk], lane);
    }
    if (lane < 4) ct[lane * 36] = 0;
#pragma unroll 1
    for (int s = 0; s < PE_NS; ++s) { const unsigned limit = (unsigned)((s + 1) * PE_SLICE) << 7;
#pragma unroll
        for (int tk = 0; tk < 4; ++tk) { const int c = __builtin_popcountll(__ballot(sA[tk] < limit)) + __builtin_popcountll(__ballot(sB[tk] < limit)); if (lane == 0) ct[tk * 36 + s + 1] = c; } }
#pragma unroll
    for (int tk = 0; tk < 4; ++tk) {
#pragma unroll
        for (int hb = 0; hb < 2; ++hb) { const unsigned key = hb ? sB[tk] : sA[tk]; const int pos = lane + 64 * hb, e = (int)(key >> 7), sl = e / PE_SLICE; int rank = pos;
#pragma unroll
            for (int t2 = 0; t2 < 4; ++t2) if (t2 != tk) rank += ct[t2 * 36 + sl + (t2 < tk ? 1 : 0)];
            ord[rank] = ((unsigned)e << 9) | (unsigned)(tk << 7) | (unsigned)pos; }
    }
    float glA[4], glB[4];
#pragma unroll
    for (int tk = 0; tk < 4; ++tk) { glA[tk] = lg[tk * PE_SEL + (sA[tk] & 127u)]; glB[tk] = lg[tk * PE_SEL + (sB[tk] & 127u)]; }
    const int bj = lane & 3, bb = lane >> 2;
    int hq[8][4]; float shl = 1.f;
    {
        LAS unsigned char* himg = ring;
#pragma unroll
        for (int tk = 0; tk < 4; ++tk) {
            const unsigned char* xrow = F.ws + WS_XB + ((size_t)(t0w + tk) * D + 4 * lane) * 2; const float* grow = gain + 4 * lane;
            const float rs = __builtin_amdgcn_rsqf(pg8::slot_sum((const float*)(F.ws + WS_SSQ) + SSQ_XS + (size_t)(t0w + tk) * 32, 32) * (1.f / 2048.f) + RMS_EPS);
            f32x4 hv[8]; float mx = 0.f;
#pragma unroll
            for (int q = 0; q < 8; ++q) { const v2u xw = *(const v2u*)(xrow + 512 * q); const f32x4 xv = (f32x4){bflo(xw.x), bfhi(xw.x), bflo(xw.y), bfhi(xw.y)}, gv = *(const f32x4*)(grow + 256 * q);
                const f32x4 t = (f32x4){xv.x * rs * gv.x, xv.y * rs * gv.y, xv.z * rs * gv.z, xv.w * rs * gv.w}; hv[q] = t;
                mx = fmaxf(mx, fmaxf(fmaxf(fabsf(t.x), fabsf(t.y)), fmaxf(fabsf(t.z), fabsf(t.w)))); }
#pragma unroll
            for (int o = 1; o < 64; o <<= 1) mx = fmaxf(mx, __shfl_xor(mx, o));
            const float inv = mx > 0.f ? 127.f / mx : 1.f; if (bj == tk) shl = mx > 0.f ? mx * (1.f / 127.f) : 1.f;
            unsigned dq[8];
#pragma unroll
            for (int q = 0; q < 8; ++q) { const f32x4 t = hv[q] * inv; dq[q] = (unsigned)((__float2int_rn(t.x) & 255) | ((__float2int_rn(t.y) & 255) << 8) | ((__float2int_rn(t.z) & 255) << 16) | (__float2int_rn(t.w) << 24)); }
            *(LAS v4u*)(himg + tk * 2048 + 16 * lane) = (v4u){dq[0], dq[1], dq[2], dq[3]}; *(LAS v4u*)(himg + tk * 2048 + 1024 + 16 * lane) = (v4u){dq[4], dq[5], dq[6], dq[7]};
            asm volatile("" ::: "memory");
        }
        asm volatile("s_waitcnt lgkmcnt(0)" ::: "memory");
#pragma unroll
        for (int s8 = 0; s8 < 8; ++s8) { const v4u t = *(const LAS v4u*)(himg + bj * 2048 + 256 * s8 + 16 * bb); hq[s8][0] = (int)t.x; hq[s8][1] = (int)t.y; hq[s8][2] = (int)t.z; hq[s8][3] = (int)t.w; }
    }
    asm volatile("s_waitcnt vmcnt(0) lgkmcnt(0)" ::: "memory");
    static_assert(PE_D == 7, "the counted wait below is vmcnt(2 * (PE_D - 1))");
#define PE_EMASK
#define PE_ISSUE(tab, code, slot) do { const unsigned char* _g = (tab) + ((size_t)((code) >> 9) << 11); \
        LAS unsigned char* _d = PE_SLOT(slot); \
        __builtin_amdgcn_global_load_lds((const unsigned*)_g, (LAS unsigned*)_d, 16, 0, 0); \
        __builtin_amdgcn_global_load_lds((const unsigned*)(_g + 1024), (LAS unsigned*)(_d + 1024), 16, 0, 0); } while (0)
#define PE_ROW_HEAD(tab) \
                    const int i6 = r & 63, ia = i6 + PE_D; const unsigned codea = (unsigned)__builtin_amdgcn_readlane((int)((ia < 64) ? oc : on), ia & 63); \
                    PE_WAITV(12); \
                    v4u w[2]; { const LAS unsigned char* _s = PE_SLOT(slot); w[0] = *(const LAS v4u*)(_s + lane * 16); w[1] = *(const LAS v4u*)(_s + 1024 + lane * 16); } \
                    asm volatile("s_waitcnt lgkmcnt(0)" ::: "memory"); \
                    PE_ISSUE(tab, codea, slot);
#define PE_ROW_TAIL() \
                    slot = (slot + 1 == PE_D) ? 0 : slot + 1; ++r; \
                    if ((r & 63) == 0) { const int nb = (r >> 6) + 1; oc = on; on = ord[((nb < 8) ? nb : 7) * 64 + lane]; asm volatile("s_waitcnt lgkmcnt(0)" ::: "memory"); }
    LAS _Float16* lah = (LAS _Float16*)(F.lds + RING_OFF + PE2_A + wv * 2048);
    LAS float* lav = (LAS float*)(F.lds + RING_OFF + PE2_A + wv * 2048);
    {
        LAS unsigned char* const sl5 = F.lds + RING_OFF + PE2_KEYS + wv * 2048;
        LAS unsigned char* const sl6 = F.lds + RING_OFF + PE2_G + wv * 2048;
        LAS unsigned char* const sl7lo = F.lds + RING_OFF + PE2_A + wv * 2048 + 1024;
        LAS unsigned char* const sl7hi = F.lds + RING_OFF + PE2_CT + wv * 1024;
#define U_LO(k) ((k) < 5 ? ring + (k) * 2048 : (k) == 5 ? sl5 : (k) == 6 ? sl6 : sl7lo)
#define U_HI(k) ((k) < 7 ? U_LO(k) + 1024 : sl7hi)
        const LAS unsigned char* ad[2][8];
#pragma unroll
        for (int p = 0; p < 2; ++p) {
            const LAS unsigned char* lo = bj == 0 ? U_LO(4 * p) : bj == 1 ? U_LO(4 * p + 1) : bj == 2 ? U_LO(4 * p + 2) : U_LO(4 * p + 3);
            const LAS unsigned char* hi = bj == 0 ? U_HI(4 * p) : bj == 1 ? U_HI(4 * p + 1) : bj == 2 ? U_HI(4 * p + 2) : U_HI(4 * p + 3);
#pragma unroll
            for (int s8 = 0; s8 < 8; ++s8) ad[p][s8] = (s8 < 4 ? lo : hi) + 16 * ((16 * (s8 & 3) + bb - 4 * bj) & 63);
        }
        const unsigned char* utr[4];
#pragma unroll
        for (int i = 0; i < 4; ++i) utr[i] = F.ws + WS_PU + (size_t)LAYER * PE_NE * D + 16 * ((lane + 4 * i) & 63);
#define U_ISSUE(i, k, code) do { const unsigned char* _g = utr[i] + ((size_t)(((code) >> 9) PE_EMASK) << 11); \
        __builtin_amdgcn_global_load_lds((const unsigned*)_g, (LAS unsigned*)U_LO(k), 16, 0, 0); \
        __builtin_amdgcn_global_load_lds((const unsigned*)(_g + 1024), (LAS unsigned*)U_HI(k), 16, 0, 0); } while (0)
        { const v4u c0 = *(const LAS v4u*)(ord), c1 = *(const LAS v4u*)(ord + 4);
          asm volatile("s_waitcnt lgkmcnt(0)" ::: "memory");
#pragma unroll
          for (int i = 0; i < 4; ++i) U_ISSUE(i, i, (unsigned)__builtin_amdgcn_readfirstlane((int)c0[i]));
#pragma unroll
          for (int i = 0; i < 4; ++i) U_ISSUE(i, 4 + i, (unsigned)__builtin_amdgcn_readfirstlane((int)c1[i])); }
#pragma unroll 1
        for (int g2 = 0; g2 < 64; ++g2) {
#pragma unroll
            for (int p = 0; p < 2; ++p) {
                const int r = 8 * g2 + 4 * p, nx = (r + 8 < 508) ? r + 8 : 508;
                const v4u cn = *(const LAS v4u*)(ord + nx); const unsigned cm = ord[r + (lane >> 4)];
                PE_WAITV(8);
                v4u a[8];
#pragma unroll
                for (int s8 = 0; s8 < 8; ++s8) a[s8] = *(const LAS v4u*)ad[p][s8];
                asm volatile("s_waitcnt lgkmcnt(0)" ::: "memory");
#pragma unroll
                for (int i = 0; i < 4; ++i) U_ISSUE(i, 4 * p + i, (unsigned)__builtin_amdgcn_readfirstlane((int)cn[i]));
                v4i d0 = (v4i){0, 0, 0, 0}, d1 = (v4i){0, 0, 0, 0};
#pragma unroll
                for (int s8 = 0; s8 < 8; ++s8)
#pragma unroll
                    for (int c = 0; c < 4; ++c) { if (c & 1) d1 = __builtin_amdgcn_mfma_i32_4x4x4i8((int)a[s8][c], hq[s8][c], d1, 0, 0, 0); else d0 = __builtin_amdgcn_mfma_i32_4x4x4i8((int)a[s8][c], hq[s8][c], d0, 0, 0, 0); }
                unsigned e0 = (unsigned)(d0[0] + d1[0]), e1 = (unsigned)(d0[1] + d1[1]), e2 = (unsigned)(d0[2] + d1[2]), e3 = (unsigned)(d0[3] + d1[3]);
                { const auto t = __builtin_amdgcn_permlane32_swap(e0, e2, false, false); e0 = t[0] + t[1]; }
                { const auto t = __builtin_amdgcn_permlane32_swap(e1, e3, false, false); e1 = t[0] + t[1]; }
                { const auto t = __builtin_amdgcn_permlane16_swap(e0, e1, false, false); e0 = t[0] + t[1]; }
                e0 += (unsigned)__builtin_amdgcn_update_dpp(0, (int)e0, 0x124, 0xf, 0xf, true);
                e0 += (unsigned)__builtin_amdgcn_update_dpp(0, (int)e0, 0x128, 0xf, 0xf, true);
                const float val = (float)(int)e0 * shl * (1.f / 256.f);
                if ((lane & 12) == 0 && ((cm >> 7) & 3u) == (unsigned)bj) lah[cm & 511u] = (_Float16)val;
            }
        }
        asm volatile("s_waitcnt vmcnt(0) lgkmcnt(0)" ::: "memory");
#undef U_ISSUE
#undef U_LO
#undef U_HI
    }
    float lv[4][2];
#pragma unroll
    for (int tk = 0; tk < 4; ++tk) { lv[tk][0] = (float)lah[tk * PE_SEL + lane]; lv[tk][1] = (float)lah[tk * PE_SEL + 64 + lane]; }
    asm volatile("s_waitcnt lgkmcnt(0)" ::: "memory");
#pragma unroll
    for (int tk = 0; tk < 4; ++tk) {
#pragma unroll
        for (int hb = 0; hb < 2; ++hb) { const unsigned key = hb ? sB[tk] : sA[tk]; const int pos = lane + 64 * hb, e = (int)(key >> 7);
            const float av = lv[tk][hb] * 256.f * su[e]; lav[tk * PE_SEL + pos] = gelu_erf(av) * (hb ? glB[tk] : glA[tk]) * sv[e]; }
    }
    asm volatile("s_waitcnt vmcnt(0) lgkmcnt(0)" ::: "memory");
    f32x2 acc[4][16];
#pragma unroll
    for (int tk = 0; tk < 4; ++tk)
#pragma unroll
        for (int i = 0; i < 16; ++i) acc[tk][i] = (f32x2){0.f, 0.f};
    {
        unsigned oc = ord[lane], on = ord[64 + lane];
        asm volatile("s_waitcnt lgkmcnt(0)" ::: "memory");
#pragma unroll
        for (int i = 0; i < PE_D; ++i) PE_ISSUE(vt, (unsigned)__builtin_amdgcn_readlane((int)oc, i), i);
        int slot = 0, r = 0; int ptr[4] = {0, 0, 0, 0};
#pragma unroll 1
        for (int s = 0; s < PE_NS; ++s) {
            const unsigned limit = (unsigned)((s + 1) * PE_SLICE) << 7;
#pragma unroll
            for (int tk = 0; tk < 4; ++tk) {
                const int end = __builtin_popcountll(__ballot(sA[tk] < limit)) + __builtin_popcountll(__ballot(sB[tk] < limit));
#pragma unroll 1
                for (int pos = ptr[tk]; pos < end; ++pos) {
                    const float a = lav[tk * PE_SEL + pos];
                    PE_ROW_HEAD(vt)
#pragma unroll
                    for (int j = 0; j < 2; ++j)
#pragma unroll
                        for (int c = 0; c < 4; ++c) { const unsigned wd = w[j][c];
                            acc[tk][8 * j + 2 * c] += __builtin_amdgcn_cvt_pk_f32_fp8((int)wd, false) * a; acc[tk][8 * j + 2 * c + 1] += __builtin_amdgcn_cvt_pk_f32_fp8((int)wd, true) * a; }
                    PE_ROW_TAIL()
                }
                ptr[tk] = end;
            }
            if ((s & (PE_PACE - 1)) == PE_PACE - 1) __builtin_amdgcn_s_barrier();
        }
        asm volatile("s_waitcnt vmcnt(0) lgkmcnt(0)" ::: "memory");
    }
#undef PE_ROW_HEAD
#undef PE_ROW_TAIL
#undef PE_SLOT
#undef PE_ISSUE
    asm volatile("" ::: "memory");
    float sqv[4] = {0.f, 0.f, 0.f, 0.f};
#pragma unroll
    for (int tk = 0; tk < 4; ++tk) {
        const int tok = t0w + tk;
        unsigned char* xbrow = F.ws + WS_XB + (size_t)tok * D * 2;
        float* xdst = dry ? (float*)(F.ws + WS_Z) + (size_t)tok * D : F.out + (size_t)tok * D;
        float sq = 0.f;
#pragma unroll
        for (int j = 0; j < 2; ++j) {
            unsigned pk[8];
            const v4u xw0 = *(const v4u*)(xbrow + (j * 1024 + lane * 16) * 2), xw1 = *(const v4u*)(xbrow + (j * 1024 + lane * 16) * 2 + 16);
#pragma unroll
            for (int q = 0; q < 4; ++q) { const int d = j * 1024 + lane * 16 + 4 * q; const unsigned wa = q < 2 ? xw0[2 * q] : xw1[2 * q - 4], wb = q < 2 ? xw0[2 * q + 1] : xw1[2 * q - 3];
                f32x4 xv = (f32x4){bflo(wa), bfhi(wa), bflo(wb), bfhi(wb)};
                xv.x += acc[tk][8 * j + 2 * q].x; xv.y += acc[tk][8 * j + 2 * q].y; xv.z += acc[tk][8 * j + 2 * q + 1].x; xv.w += acc[tk][8 * j + 2 * q + 1].y;
                if constexpr (LAYER == 1) *(f32x4*)(xdst + d) = xv;
                if constexpr (LAYER == 0) { sq += (xv.x * xv.x + xv.y * xv.y) + (xv.z * xv.z + xv.w * xv.w); pk[2 * q] = pk2(xv.x, xv.y); pk[2 * q + 1] = pk2(xv.z, xv.w);
                    acc[tk][8 * j + 2 * q] = (f32x2){xv.x, xv.y}; acc[tk][8 * j + 2 * q + 1] = (f32x2){xv.z, xv.w}; } }
            if constexpr (LAYER == 0) { unsigned char* xb = (dry ? (unsigned char*)(F.ws + WS_Z) + (size_t)tok * D * 2 : xbrow) + (j * 1024 + lane * 16) * 2;
                *(v4u*)xb = (v4u){pk[0], pk[1], pk[2], pk[3]}; *(v4u*)(xb + 16) = (v4u){pk[4], pk[5], pk[6], pk[7]}; }
            asm volatile("" ::: "memory");
        }
        if constexpr (LAYER == 0) { sq = wave_sum(sq); sqv[tk] = sq; if (lane == 0) ((float*)(F.ws + WS_SSQ))[SSQ_X2 + tok] = sq; }
    }
    if constexpr (LAYER == 0) {
        const float* wf = (const float*)(F.ws + WS_WF) + lane * 16;
        float mine = 0.f;
#pragma unroll 1
        for (int jf = 0; jf < 16; ++jf) {
            f32x2 sacc[4] = {{0.f, 0.f}, {0.f, 0.f}, {0.f, 0.f}, {0.f, 0.f}};
#pragma unroll
            for (int j = 0; j < 2; ++j)
#pragma unroll
                for (int q = 0; q < 4; ++q) { const f32x4 wv = *(const f32x4*)(wf + jf * 2048 + j * 1024 + 4 * q);
#pragma unroll
                    for (int tk = 0; tk < 4; ++tk) { sacc[tk] += acc[tk][8 * j + 2 * q] * (f32x2){wv.x, wv.y}; sacc[tk] += acc[tk][8 * j + 2 * q + 1] * (f32x2){wv.z, wv.w}; } }
            float s0 = sacc[0].x + sacc[0].y, s1 = sacc[1].x + sacc[1].y, s2 = sacc[2].x + sacc[2].y, s3 = sacc[3].x + sacc[3].y;
            { const auto t = __builtin_amdgcn_permlane32_swap(__float_as_uint(s0), __float_as_uint(s2), false, false); s0 = __uint_as_float(t[0]) + __uint_as_float(t[1]); }
            { const auto t = __builtin_amdgcn_permlane32_swap(__float_as_uint(s1), __float_as_uint(s3), false, false); s1 = __uint_as_float(t[0]) + __uint_as_float(t[1]); }
            { const auto t = __builtin_amdgcn_permlane16_swap(__float_as_uint(s0), __float_as_uint(s1), false, false); s0 = __uint_as_float(t[0]) + __uint_as_float(t[1]); }
            s0 += __int_as_float(__builtin_amdgcn_update_dpp(0, __float_as_int(s0), 0x128, 0xf, 0xf, true));
            s0 += __int_as_float(__builtin_amdgcn_update_dpp(0, __float_as_int(s0), 0x124, 0xf, 0xf, true));
            s0 += __int_as_float(__builtin_amdgcn_update_dpp(0, __float_as_int(s0), 0x122, 0xf, 0xf, true));
            s0 += __int_as_float(__builtin_amdgcn_update_dpp(0, __float_as_int(s0), 0x121, 0xf, 0xf, true));
            if ((lane & 15) == jf) mine = s0;
        }
        { const int q = lane >> 4; const float sqq = q == 0 ? sqv[0] : q == 1 ? sqv[1] : q == 2 ? sqv[2] : sqv[3];
          const float rs2 = __builtin_amdgcn_rsqf(sqq * (1.f / 2048.f) + RMS_EPS);
          const float zf = mine * rs2 + I.fox_b_f[lane & 15]; const float ls = fminf(zf, 0.f) - log1pf(__expf(-fabsf(zf)));
          ((float*)(F.ws + WS_LF))[(size_t)(lane & 15) * T + (t0w + q)] = ls; }
    }
}
template <int LAYER>
__device__ __forceinline__ void p_peer(const Frame& F, const In& I, int dry) {
    for (int tb = F.vcu; tb < T / 32; tb += F.G) {
        const int t0 = tb * 32;
        Frame Fo = F; asm volatile("" : "+v"(Fo.lane), "+v"(Fo.tid));
        peer_topk(Fo, LAYER, t0);
        __syncthreads();
#ifdef TOPK_PROBE
        peer_topk(Fo, LAYER, t0);
        __syncthreads();
#endif
        asm volatile("" : "+v"(Fo.lane));
        peer_gather4<LAYER>(Fo, I, t0 + F.wave * 4, F.wave * 4, dry);
        __syncthreads();
    }
}
#ifdef SELFCHECK
constexpr int DG_CHUNK = 8192, DG_MAXCH = 8192, DG_NBUF = 3, DG_NPASS = 4;
constexpr size_t WS_DG = WS_END;
constexpr size_t DG_BYTES = (size_t)DG_NPASS * N_PHASES * DG_NBUF * DG_MAXCH * 8;
__global__ void __launch_bounds__(256) dg_kernel(const void* buf, int is_f32, size_t nelem, float2* dig) {
    const int c = blockIdx.x; const size_t e0 = (size_t)c * DG_CHUNK; float s = 0.f, a = 0.f;
    for (int i = threadIdx.x; i < DG_CHUNK; i += 256) { const size_t e = e0 + i; if (e < nelem) { const float v = is_f32 ? ((const float*)buf)[e] : __uint_as_float((unsigned)((const unsigned short*)buf)[e] << 16);
        const float w = ((i * 2654435761u) >> 13) & 1 ? 1.f : -1.f; s += w * v; a += fabsf(v); } }
    __shared__ float ss[256], sa[256]; ss[threadIdx.x] = s; sa[threadIdx.x] = a; __syncthreads();
    for (int o = 128; o > 0; o >>= 1) { if ((int)threadIdx.x < o) { ss[threadIdx.x] += ss[threadIdx.x + o]; sa[threadIdx.x] += sa[threadIdx.x + o]; } __syncthreads(); }
    if (threadIdx.x == 0) dig[c] = make_float2(ss[0], sa[0]);
}
__global__ void dg_compare(const float2* dig, unsigned* flag  ) {
    const int p = blockIdx.x;
    for (int q = 1; q < DG_NPASS; ++q)
        for (int i = threadIdx.x; i < DG_NBUF * DG_MAXCH; i += blockDim.x) {
            const float2 a = dig[((size_t)0 * N_PHASES + p) * DG_NBUF * DG_MAXCH + i], b = dig[((size_t)q * N_PHASES + p) * DG_NBUF * DG_MAXCH + i];
            if (!(fabsf(a.x - b.x) <= 1e-5f * a.y + 0.02f)) atomicAdd(flag + p, 1u);
        }
}
__global__ void dg_poison(const unsigned* flag, float* out) {
    if (threadIdx.x == 0 && blockIdx.x == 0) { for (int p = 0; p < N_PHASES; ++p) if (flag[p]) { out[0] += 1000.f * (float)(1 << p); break; } }
}
struct DgBuf { size_t off; int is_f32; size_t nelem; };
#endif
#ifdef STAGECHECK
constexpr size_t WS_CK = WS_END;
constexpr int CK_NS = 32;
constexpr size_t WS_CK_ROWS = WS_CK + 4096, WS_CK_TMP = WS_CK_ROWS + (size_t)CK_NS * 2048 * 4;
__device__ __forceinline__ unsigned ck_hash(unsigned a) { a ^= a >> 16; a *= 0x7feb352du; a ^= a >> 15; a *= 0x846ca68bu; a ^= a >> 16; return a; }
__device__ __forceinline__ bool ck_bad(float ref, float got) { return !(fabsf(ref - got) <= 0.03f * fabsf(ref) + 0.03f); }
__device__ __forceinline__ int ck_slot(int t) { const int c = t & 15; return (t & ~15) + (c < 4 ? c : c < 8 ? c + 4 : c < 12 ? c - 4 : c); }
__device__ __forceinline__ void ck_flag(unsigned* flags, int code, bool bad) { if (__any(bad)) { if ((threadIdx.x & 63) == 0) atomicAdd(flags + code, 1u); } }

__global__ void __launch_bounds__(64) ck_save_rows(const float* out, float* rows) {
    const int s = blockIdx.x, t = ck_hash(1000 + s) % T; for (int i = threadIdx.x; i < 2048; i += 64) rows[s * 2048 + i] = out[(size_t)t * 2048 + i];
}
__global__ void __launch_bounds__(64) ck_kernel(int stage, In I, unsigned char* ws, const float* out, unsigned* flags) {
    const int s = blockIdx.x, lane = threadIdx.x;
    __shared__ float sh[4096];
    const bf16* z0 = (const bf16*)(ws + WS_Z0); const float* ssq = (const float*)(ws + WS_SSQ);
    if (stage == 1) {
        const int t = ck_hash(s) % T, n = ck_hash(77 + s) % MLA_IN; float a = 0.f, d = 0.f;
        for (int k = lane; k < 2048; k += 64) { const float x = I.x[(size_t)t * 2048 + k]; a += x * x; d += x * I.g_mix[k] * I.mla_w_in[(size_t)k * MLA_IN + n]; }
        a = wave_sum(a); d = wave_sum(d); const float ref = d * rsqrtf(a / 2048.f + 1e-6f);
        ck_flag(flags, 1, ck_bad(ref, bf2f(z0[(size_t)t * MLA_INP + n])));
    } else if (stage == 2) {
        const int t = ck_hash(s) % T, n = ck_hash(78 + s) % 3072, h = ck_hash(79 + s) % 16, dd = ck_hash(80 + s) % 128; float a = 0.f, b = 0.f, c = 0.f, q = 0.f;
        for (int k = lane; k < 512; k += 64) { const float zq = bf2f(z0[(size_t)t * MLA_INP + k]), zk = bf2f(z0[(size_t)t * MLA_INP + 512 + k]);
            a += zq * I.mla_g_qa[k] * I.mla_w_qb[(size_t)k * 3072 + n]; b += zk * I.mla_g_kva[k] * I.mla_w_kvb[(size_t)k * 4096 + h * 256 + dd]; c += zk * I.mla_g_kva[k] * I.mla_w_kvb[(size_t)k * 4096 + h * 256 + 128 + dd]; q += zk * zk; }
        a = wave_sum(a); b = wave_sum(b); c = wave_sum(c); q = wave_sum(q); c *= rsqrtf(q / 512.f + 1e-6f);
        const bf16* Q = (const bf16*)(ws + WS_Q); const bf16* KN = (const bf16*)(ws + WS_KN); const bf16* VT = (const bf16*)(ws + WS_VT);
        ck_flag(flags, 2, ck_bad(a, bf2f(Q[(size_t)t * 3072 + n])));
        ck_flag(flags, 20, ck_bad(b, bf2f(KN[(size_t)t * 2048 + h * 128 + dd])));
        ck_flag(flags, 21, ck_bad(c, bf2f(VT[(size_t)(h * 128 + dd) * T + ck_slot(t)])));
    } else if (stage == 3) {
        const int t = ck_hash(s) % T, h = ck_hash(81 + s) % 16; float sq = 0.f, skv = 0.f;
        for (int k = lane; k < 512; k += 64) { const float zq = bf2f(z0[(size_t)t * MLA_INP + k]), zk = bf2f(z0[(size_t)t * MLA_INP + 512 + k]); sq += zq * zq; skv += zk * zk; }
        const float rcq = rsqrtf(wave_sum(sq) / 512.f + 1e-6f), rckv = rsqrtf(wave_sum(skv) / 512.f + 1e-6f);
        float qv[3], kv[3];
#pragma unroll
        for (int j = 0; j < 3; ++j) { const int d = lane + 64 * j; float a = 0.f, b = 0.f;
            for (int k = 0; k < 512; ++k) { a += bf2f(z0[(size_t)t * MLA_INP + k]) * I.mla_g_qa[k] * I.mla_w_qb[(size_t)k * 3072 + h * 192 + d];
                if (d < 128) b += bf2f(z0[(size_t)t * MLA_INP + 512 + k]) * I.mla_g_kva[k] * I.mla_w_kvb[(size_t)k * 4096 + h * 256 + d]; }
            qv[j] = a * rcq; kv[j] = (d < 128) ? b * rckv : bf2f(z0[(size_t)t * MLA_INP + 1024 + (d - 128)]); }
        const float rq = rsqrtf(wave_sum(qv[0] * qv[0] + qv[1] * qv[1] + qv[2] * qv[2]) / 192.f + 1e-6f), rk = rsqrtf(wave_sum(kv[0] * kv[0] + kv[1] * kv[1] + kv[2] * kv[2]) / 192.f + 1e-6f);
#pragma unroll
        for (int j = 0; j < 3; ++j) { qv[j] *= rq * I.mla_g_q[lane + 64 * j]; kv[j] *= rk * I.mla_g_k[lane + 64 * j]; }
        const float inv_freq = powf(10000.0f, -(float)(2 * (lane & 31)) / 64.0f), ang = (float)I.pos[t] * inv_freq, cs = cosf(ang), sn = sinf(ang);
        const float pq = __shfl_xor(qv[2], 32), pk = __shfl_xor(kv[2], 32);
        qv[2] = (lane < 32) ? qv[2] * cs - pq * sn : qv[2] * cs + pq * sn; kv[2] = (lane < 32) ? kv[2] * cs - pk * sn : kv[2] * cs + pk * sn;
        const float QS = 0.07216878364870322f * LOG2E; const bf16* Q = (const bf16*)(ws + WS_Q); const bf16* KM = (const bf16*)(ws + WS_KM); bool bad = false, badk = false;
#pragma unroll
        for (int j = 0; j < 3; ++j) { bad |= ck_bad(qv[j] * QS * 4.f, 4.f * bf2f(Q[(size_t)t * 3072 + h * 192 + lane + 64 * j])); badk |= ck_bad(kv[j], bf2f(KM[(size_t)t * 3072 + h * 192 + lane + 64 * j])); }
        ck_flag(flags, 3, bad); ck_flag(flags, 22, badk);
    } else if (stage == 4 || stage == 10) {
        const bool fox = stage == 10; const int t = ck_hash(s) % T, h = ck_hash(82 + s) % 16, b = t / SEQ, tq = t % SEQ, DKK = fox ? 128 : 192;
        const bf16* Q = fox ? (const bf16*)(ws + WS_Z) : (const bf16*)(ws + WS_Q); const bf16* K = fox ? (const bf16*)(ws + WS_Z) + 2048 : (const bf16*)(ws + WS_KM); const int pitch = fox ? FOX_ZN : 3072;
        const bf16* VT = (const bf16*)(ws + WS_VT); const float* lf = (const float*)(ws + WS_LF);
        const int nk = fox ? tq + 1 : 64 * (tq / 64 + 1);
        if (fox) { if (lane == 0) { float c = 0.f; for (int i = 0; i < nk; ++i) { c += lf[(size_t)(b * SEQ + i) * 16 + h]; sh[2048 + i] = c; } } __syncthreads(); }
        float mx = -1e30f;
        for (int sk = lane; sk < nk; sk += 64) { float d = 0.f; for (int e = 0; e < DKK; ++e) d += bf2f(Q[(size_t)t * pitch + h * DKK + e]) * bf2f(K[(size_t)(b * SEQ + sk) * pitch + h * DKK + e]);
            if (fox) d += (sh[2048 + tq] - sh[2048 + sk]) * LOG2E; sh[sk] = d; mx = fmaxf(mx, d); }
        for (int o = 1; o < 64; o <<= 1) mx = fmaxf(mx, __shfl_xor(mx, o));
        __syncthreads();
        float l = 0.f; for (int sk = lane; sk < nk; sk += 64) { const float p = exp2f(sh[sk] - mx); sh[sk] = p; l += p; } l = wave_sum(l);
        __syncthreads();
        bool bad = false;
        for (int j = 0; j < 2; ++j) { const int dv = lane + 64 * j; float o = 0.f; for (int sk = 0; sk < nk; ++sk) o += sh[sk] * bf2f(VT[(size_t)(h * 128 + dv) * T + ck_slot(b * SEQ + sk)]); o /= l;
            if (fox) o *= 1.f / (1.f + expf(-bf2f(((const bf16*)(ws + WS_Z))[(size_t)t * FOX_ZN + 4096 + h * 128 + dv])));
            bad |= ck_bad(o * 8.f, 8.f * bf2f(((const bf16*)(ws + WS_O))[(size_t)t * 2048 + h * 128 + dv])); }
        ck_flag(flags, stage, bad);
    } else if (stage == 5 || stage == 11) {
        const int t = (stage == 5) ? ck_hash(s) % T : ck_hash(1000 + s) % T, n = ck_hash(83 + s) % 2048; const float* wo = (stage == 5) ? I.mla_w_o : I.fox_w_o; float d = 0.f;
        for (int k = lane; k < 2048; k += 64) d += bf2f(((const bf16*)(ws + WS_O))[(size_t)t * 2048 + k]) * wo[(size_t)k * 2048 + n];
        d = wave_sum(d); const float xo = (stage == 5) ? I.x[(size_t)t * 2048 + n] : ((const float*)(ws + WS_CK_ROWS))[s * 2048 + n];
        ck_flag(flags, stage, ck_bad(xo + d, out[(size_t)t * 2048 + n]));
    } else if (stage == 6 || stage == 12) {
        const int L = stage == 12, t = ck_hash(s) % T, n = ck_hash(84 + s) % 2048; float d = 0.f;
        for (int k = lane; k < 2048; k += 64) d += bf2f(((const bf16*)(ws + WS_XB))[(size_t)t * 2048 + k]) * I.g_ffn[L * 2048 + k] * I.pe_wq[(size_t)L * 2048 * 2048 + (size_t)k * 2048 + n];
        d = wave_sum(d); ck_flag(flags, stage, ck_bad(d, bf2f(((const bf16*)(ws + WS_QP))[(size_t)t * 2048 + n])));
    } else if (stage == 7 || stage == 13) {
        const int L = stage == 13, t = ck_hash(1000 + s) % T; const float* xo = (const float*)(ws + WS_CK_ROWS) + s * 2048; float* tmp = (float*)(ws + WS_CK_TMP) + (size_t)s * 8192;
        float a = 0.f; for (int k = lane; k < 2048; k += 64) a += xo[k] * xo[k]; const float r = rsqrtf(wave_sum(a) / 2048.f + 1e-6f);
        for (int k = lane; k < 2048; k += 64) tmp[k] = xo[k] * r * I.g_ffn[L * 2048 + k];
        __syncthreads();
        for (int n = lane; n < 2048; n += 64) { float d = 0.f; for (int k = 0; k < 2048; ++k) d += tmp[k] * I.pe_wq[(size_t)L * 2048 * 2048 + (size_t)k * 2048 + n]; tmp[2048 + n] = d; }
        __syncthreads();
        for (int hq = 0; hq < 8; ++hq) {
            for (int c = 0; c < 2; ++c) for (int n = lane; n < 128; n += 64) { float d = 0.f; for (int e = 0; e < 128; ++e) d += tmp[2048 + hq * 256 + c * 128 + e] * I.pe_sk[((size_t)(L * 2 + c) * 128 + n) * 128 + e]; sh[c * 128 + n] = d; }
            __syncthreads();
            if (lane == 0) {
                for (int c = 0; c < 2; ++c) for (int k = 0; k < 16; ++k) { int bi = 0; float bv = -1e30f; for (int n = 0; n < 128; ++n) if (sh[c * 128 + n] > bv) { bv = sh[c * 128 + n]; bi = n; } sh[256 + c * 16 + k] = bv; sh[288 + c * 16 + k] = (float)bi; sh[c * 128 + bi] = -1e30f; }
                for (int i = 0; i < 16; ++i) for (int j = 0; j < 16; ++j) sh[512 + i * 16 + j] = sh[256 + i] + sh[272 + j];
                float b0 = 0.f, sum = 0.f;
                for (int k = 0; k < 16; ++k) { int bi = 0; float bv = -1e30f; for (int n = 0; n < 256; ++n) if (sh[512 + n] > bv) { bv = sh[512 + n]; bi = n; } if (k == 0) b0 = bv;
                    const float w = expf(bv - b0); sum += w; tmp[4096 + hq * 32 + k] = sh[288 + (bi >> 4)] * 128.f + sh[304 + (bi & 15)]; tmp[4096 + hq * 32 + 16 + k] = w; sh[512 + bi] = -1e30f; }
                for (int k = 0; k < 16; ++k) tmp[4096 + hq * 32 + 16 + k] /= sum;
            }
            __syncthreads();
        }
        for (int k = 0; k < 128; ++k) { const int e = (int)tmp[4096 + (k >> 4) * 32 + (k & 15)]; float d = 0.f; for (int i = lane; i < 2048; i += 64) d += I.pe_u[((size_t)L * PE_NE + e) * 2048 + i] * tmp[i]; d = wave_sum(d);
            if (lane == 0) tmp[6144 + k] = 0.5f * d * (1.f + erff(d * 0.7071067811865476f)) * tmp[4096 + (k >> 4) * 32 + 16 + (k & 15)]; }
        __syncthreads();
        { const int* di = (const int*)(ws + WS_END + 8 * MiB) + (size_t)t * 128; const float* dg = (const float*)(ws + WS_END + 12 * MiB) + (size_t)t * 128; const float* da = (const float*)(ws + WS_END + 16 * MiB) + (size_t)t * 128;
          int nf = 0; bool bg = false, ba = false;
          for (int k = lane; k < 128; k += 64) { const int e = (int)tmp[4096 + (k >> 4) * 32 + (k & 15)]; int f = -1; for (int m = 0; m < 16; ++m) if (di[(k & ~15) + m] == e) f = (k & ~15) + m;
              if (f < 0) ++nf; else { bg |= !(fabsf(dg[f] - tmp[4096 + (k >> 4) * 32 + 16 + (k & 15)]) <= 0.05f * dg[f] + 0.003f); ba |= !(fabsf(da[f] - tmp[6144 + k]) <= 0.05f * fabsf(da[f]) + 0.004f); } }
          nf = (int)wave_sum((float)nf);
          ck_flag(flags, 23, nf > 8); ck_flag(flags, 24, bg); ck_flag(flags, 25, ba); }
        bool bad = false;
        for (int j = 0; j < 4; ++j) { const int d = (lane * 4 + j * 256 + (int)(ck_hash(s) & 3)) & 2047; float o = 0.f; { const int* di = (const int*)(ws + WS_END + 8 * MiB) + (size_t)t * 128; const float* da = (const float*)(ws + WS_END + 16 * MiB) + (size_t)t * 128; for (int k = 0; k < 128; ++k) o += da[k] * I.pe_v[((size_t)L * PE_NE + di[k]) * 2048 + d]; }
            bad |= ck_bad((xo[d] + o), out[(size_t)t * 2048 + d]); }
        ck_flag(flags, stage, bad);
    } else if (stage == 9) {
        const int t = ck_hash(s) % T, h = ck_hash(86 + s) % 16; const float r2 = rsqrtf(ssq[SSQ_X2 + t] / 2048.f + 1e-6f); float qv[2], kv[2];
#pragma unroll
        for (int j = 0; j < 2; ++j) { const int d = lane + 64 * j; float a = 0.f, b = 0.f;
            for (int k = 0; k < 2048; ++k) { const float xv = bf2f(((const bf16*)(ws + WS_XB))[(size_t)t * 2048 + k]) * I.g_mix[2048 + k]; a += xv * I.fox_w_in[(size_t)k * 8208 + h * 128 + d]; b += xv * I.fox_w_in[(size_t)k * 8208 + 2048 + h * 128 + d]; }
            qv[j] = a * r2; kv[j] = b * r2; }
        const float rq = rsqrtf(wave_sum(qv[0] * qv[0] + qv[1] * qv[1]) / 128.f + 1e-6f) * 0.08838834764831845f * LOG2E, rk = rsqrtf(wave_sum(kv[0] * kv[0] + kv[1] * kv[1]) / 128.f + 1e-6f);
        bool bad = false;
#pragma unroll
        for (int j = 0; j < 2; ++j) { const int d = lane + 64 * j; bad |= ck_bad(4.f * qv[j] * rq * I.fox_g_q[d], 4.f * bf2f(((const bf16*)(ws + WS_Z))[(size_t)t * FOX_ZN + h * 128 + d]));
            bad |= ck_bad(kv[j] * rk * I.fox_g_k[d], bf2f(((const bf16*)(ws + WS_Z))[(size_t)t * FOX_ZN + 2048 + h * 128 + d])); }
        ck_flag(flags, 9, bad);
    } else if (stage == 8) {
        const int t = ck_hash(s) % T, n = ck_hash(85 + s) % 8192; float d = 0.f;
        for (int k = lane; k < 2048; k += 64) d += bf2f(((const bf16*)(ws + WS_XB))[(size_t)t * 2048 + k]) * I.g_mix[2048 + k] * I.fox_w_in[(size_t)k * 8208 + n];
        d = wave_sum(d) * rsqrtf(ssq[SSQ_X2 + t] / 2048.f + 1e-6f);
        const int sec = n >> 11, c = n & 2047; float got;
        if (sec == 2) got = bf2f(((const bf16*)(ws + WS_VT))[(size_t)c * T + ck_slot(t)]); else got = bf2f(((const bf16*)(ws + WS_Z))[(size_t)t * FOX_ZN + (sec == 3 ? 4096 : sec * 2048) + c]);
        ck_flag(flags, 8, ck_bad(d, got));
    }
}
__global__ void ck_poison(const unsigned* flags, float* out) {
    if (threadIdx.x == 0 && blockIdx.x == 0) { const int order[19] = {1, 2, 20, 21, 3, 22, 4, 5, 6, 23, 24, 25, 7, 8, 9, 10, 11, 12, 13};
        for (int i = 0; i < 19; ++i) if (flags[order[i]]) { out[0] += 1000.f * (float)(1 << (i + 1)); break; } }
}
#endif
#ifndef MK_N_LAUNCHES
#define MK_N_LAUNCHES 1
#endif
struct Args { const void* in[21]; float* out; unsigned char* ws; int ph_lo, ph_hi, rep, pad; };
static_assert(sizeof(Args) == 21 * 8 + 8 + 8 + 16, "Args has no padding");

__global__ void __launch_bounds__(NWAVES * 64, 2) mk_fwd(Args args) {
    extern __shared__ __attribute__((aligned(16))) unsigned char lds_raw[];
    Frame F;
    F.lds = (LAS unsigned char*)lds_raw;
    volatile LAS unsigned* MISC = (volatile LAS unsigned*)(F.lds + MISC_OFF);
    F.tid = threadIdx.x; F.lane = F.tid & 63; F.wave = __builtin_amdgcn_readfirstlane(F.tid >> 6);
    F.G = gridDim.x; { const int bx = blockIdx.x; F.vcu = (F.G % 8 == 0) ? (bx % 8) * (F.G / 8) + bx / 8 : bx; }
    F.ws = args.ws; F.out = args.out;
    In I;
    I.x = (const float*)args.in[0]; I.pos = (const int*)args.in[1]; I.g_mix = (const float*)args.in[2]; I.g_ffn = (const float*)args.in[3];
    I.mla_w_in = (const float*)args.in[4]; I.mla_g_qa = (const float*)args.in[5]; I.mla_w_qb = (const float*)args.in[6]; I.mla_g_kva = (const float*)args.in[7];
    I.mla_w_kvb = (const float*)args.in[8]; I.mla_g_q = (const float*)args.in[9]; I.mla_g_k = (const float*)args.in[10]; I.mla_w_o = (const float*)args.in[11];
    I.fox_w_in = (const float*)args.in[12]; I.fox_b_f = (const float*)args.in[13]; I.fox_g_q = (const float*)args.in[14]; I.fox_g_k = (const float*)args.in[15];
    I.fox_w_o = (const float*)args.in[16]; I.pe_wq = (const float*)args.in[17]; I.pe_sk = (const float*)args.in[18]; I.pe_u = (const float*)args.in[19]; I.pe_v = (const float*)args.in[20];
    for (int u = F.tid; u < (LDS_BYTES - LDSCTL_OFF) / 4; u += NWAVES * 64) ((LAS unsigned*)(F.lds + LDSCTL_OFF))[u] = 0u;
    __syncthreads();
    unsigned* ctl = (unsigned*)(F.ws + WS_CTL);
    XcdBarrier bar; bar.bar = ctl + CW_BAR; bar.x = 0; bar.st = nullptr;
    const int lo = args.ph_lo, hi = args.ph_hi;
    if (hi - lo > 1) bar = xcd_barrier_post(ctl + CW_BAR, MISC + 8);
#ifndef PH_MASK
#define PH_MASK 0x3fff
#endif
#define IN(k) (((PH_MASK >> (k)) & 1) && lo <= (k) && (k) < hi)
#define SEAM(k) do { if (IN(k) && IN((k) + 1)) xcd_barrier(bar); } while (0)
#ifdef TIMING_PROBE
#define REPS(k) ((TIMING_PROBE >> (k)) & 1)
#else
#define REPS(k) 0
#endif
    unsigned char* ws = F.ws;
    float* ssq = (float*)(ws + WS_SSQ);
    const int bid = (int)blockIdx.x;

    if (IN(0)) { for (int rp = REPS(0); rp >= 0; --rp) { p_prologue(F, I); if (rp) xcd_barrier(bar); } SEAM(0); }

    if (IN(1)) { for (int rp = REPS(1); rp >= 0; --rp) {
        pg8::Gemm g{(const bf16*)(ws + WS_XB), (const bf16*)(ws + WS_WT_MLA_IN), T, MLA_INP, D, D, D}; pg8::StaticOrder S; S.init(T, MLA_INP, F.G, bid);
        pg8::EpiRowScale E{(bf16*)(ws + WS_Z0), MLA_INP, ssq + SSQ_X0, 1, 1.f / 2048.f, ssq + SSQ_CQ, ssq + SSQ_CKV, 2, 4, 8};
        pg8::gemm_phase<pg8::EpiRowScale, pg8::StaticOrder, false>(F.lds + RING_OFF, g, S, E);
        if (bid >= 160) { p_table_fill(F, I, 16384, 16384, (bid - 160) * NWAVES + F.wave, 96 * NWAVES); p_table_fill(F, I, 65536 - PE_FILL3, PE_FILL3, (bid - 160) * NWAVES + F.wave, 96 * NWAVES); }
        if (rp) xcd_barrier(bar); }
        SEAM(1);
    }
    if (IN(2)) { for (int rp = REPS(2); rp >= 0; --rp) {
        p_mla_tok(F, I);
        {
          pg8::Gemm g{(const bf16*)(ws + WS_Z0), (const bf16*)(ws + WS_WT_QB), T, MLA_QN + 2048, 512, MLA_INP, 512, MLA_QN / 256, 512}; pg8::StaticOrder S; S.init(T, MLA_QN + 2048, F.G, bid);
          pg8::EpiRowScale2 E{{(bf16*)(ws + WS_Q), MLA_QN, nullptr, 0, 0.f, nullptr, nullptr, 0, 0, 0},
                              {(bf16*)(ws + WS_KN), 2048, ssq + SSQ_CKV, 8, 1.f / 512.f, nullptr, nullptr, 0, 0, 0, (float*)(ws + WS_KSQM), 0, 8},
                              MLA_QN / 256};
          pg8::gemm_phase<pg8::EpiRowScale2, pg8::StaticOrder, true>(F.lds + RING_OFF, g, S, E);
          if (bid >= 128) p_table_fill(F, I, 49152, PE_FILL2, (bid - 128) * NWAVES + F.wave, 128 * NWAVES); }
        { pg8::Gemm g{(const bf16*)(ws + WS_WT_KVB) + (size_t)2048 * 512, (const bf16*)(ws + WS_Z0) + 512, 2048, T, 512, 512, MLA_INP}; pg8::StaticOrder S; S.init(2048, T, F.G, bid);
          pg8::EpiColScale E{(bf16*)(ws + WS_VT), T, ssq + SSQ_CKV, 8, 1.f / 512.f};
          pg8::gemm_phase<pg8::EpiColScale, pg8::StaticOrder, true>(F.lds + RING_OFF, g, S, E); }
        if (rp) xcd_barrier(bar); }
        SEAM(2);
    }
    if (IN(4)) { for (int rp = REPS(4); rp >= 0; --rp) {
        const AttnAux ax{I.mla_g_q, I.mla_g_k, (const float*)(ws + WS_KSQM), ssq + SSQ_CQ, (const float*)(ws + WS_ROPE), (const float*)(ws + WS_RCKV), (const float*)(ws + WS_KRSS), (const bf16*)(ws + WS_KRG)};
        p_attention<192, false>(F, (const bf16*)(ws + WS_Q), MLA_QN, (const bf16*)(ws + WS_KN), 2048, (const bf16*)(ws + WS_VT), (bf16*)(ws + WS_O), nullptr, 0, nullptr, ax);
        if (rp) xcd_barrier(bar); }
        SEAM(4);
    }
    if (IN(5)) { for (int rp = REPS(5); rp >= 0; --rp) {
        pg8::Gemm g{(const bf16*)(ws + WS_O), (const bf16*)(ws + WS_WT_MLA_O), T, D, D, D, D}; pg8::StaticOrder S; S.init(T, D, F.G, bid);
        pg8::EpiResidual E{(bf16*)(ws + WS_XB), D, ssq + SSQ_XS};
        pg8::gemm_phase<pg8::EpiResidual, pg8::StaticOrder, false>(F.lds + RING_OFF, g, S, E);
        if (rp) xcd_barrier(bar); }
        SEAM(5);
    }
    if (IN(6)) { for (int rp = REPS(6); rp >= 0; --rp) {
        pg8::Gemm g{(const bf16*)(ws + WS_XB), (const bf16*)(ws + WS_WT_PQ), T, D, D, D, D}; pg8::StaticOrder S; S.init(T, D, F.G, bid);
        pg8::EpiRowScale E{(bf16*)(ws + WS_QP), D, nullptr, 0, 0.f, nullptr, nullptr, 0, 0, 0};
        pg8::gemm_phase<pg8::EpiRowScale, pg8::StaticOrder, false>(F.lds + RING_OFF, g, S, E);
        if (rp) xcd_barrier(bar); }
        SEAM(6);
    }
    if (IN(7)) { for (int rp = REPS(7); rp >= 0; --rp) { p_peer<0>(F, I, rp); if (rp) xcd_barrier(bar); } SEAM(7); }
    if (IN(8)) { for (int rp = REPS(8); rp >= 0; --rp) {
        { pg8::Gemm g{(const bf16*)(ws + WS_XB), (const bf16*)(ws + WS_WT_FOX_IN), T, FOX_ZN, D, D, D}; pg8::StaticOrder S; S.init(T, FOX_ZN, F.G, bid);
          pg8::EpiRowScale E{(bf16*)(ws + WS_Z), FOX_ZN, ssq + SSQ_X2, 1, 1.f / 2048.f, nullptr, nullptr, 0, 0, 0, (float*)(ws + WS_KSQ), 8, 16};
          pg8::gemm_phase<pg8::EpiRowScale, pg8::StaticOrder, true>(F.lds + RING_OFF, g, S, E); }
        { pg8::Gemm g{(const bf16*)(ws + WS_WT_FOX_IN) + (size_t)FOX_ZN * D, (const bf16*)(ws + WS_XB), 2048, T, D, D, D}; pg8::StaticOrder S; S.init(2048, T, F.G, bid);
          pg8::EpiColScale E{(bf16*)(ws + WS_VT), T, ssq + SSQ_X2, 1, 1.f / 2048.f};
          pg8::gemm_phase<pg8::EpiColScale, pg8::StaticOrder, true>(F.lds + RING_OFF, g, S, E); }
        if (rp) xcd_barrier(bar); }
        SEAM(8);
    }
    if (IN(10)) { for (int rp = REPS(10); rp >= 0; --rp) {
        p_attention<128, true>(F, (const bf16*)(ws + WS_Z), FOX_ZN, (const bf16*)(ws + WS_Z) + 2048, FOX_ZN, (const bf16*)(ws + WS_VT), (bf16*)(ws + WS_O), (const bf16*)(ws + WS_Z) + 4096, FOX_ZN, (const float*)(ws + WS_LF), AttnAux{I.fox_g_q, I.fox_g_k, (const float*)(ws + WS_KSQ), nullptr, nullptr, nullptr, nullptr, nullptr});
        if (rp) xcd_barrier(bar); }
        SEAM(10);
    }
    if (IN(11)) {
        pg8::Gemm g{(const bf16*)(ws + WS_O), (const bf16*)(ws + WS_WT_FOX_O), T, D, D, D, D}; pg8::StaticOrder S; S.init(T, D, F.G, bid);
        pg8::EpiResidual E{(bf16*)(ws + WS_XB), D, ssq + SSQ_XS};
        pg8::gemm_phase<pg8::EpiResidual, pg8::StaticOrder, false>(F.lds + RING_OFF, g, S, E);
        SEAM(11);
    }
    if (IN(12)) { for (int rp = REPS(12); rp >= 0; --rp) {
        pg8::Gemm g{(const bf16*)(ws + WS_XB), (const bf16*)(ws + WS_WT_PQ + 8 * MiB), T, D, D, D, D}; pg8::StaticOrder S; S.init(T, D, F.G, bid);
        pg8::EpiRowScale E{(bf16*)(ws + WS_QP), D, nullptr, 0, 0.f, nullptr, nullptr, 0, 0, 0};
        pg8::gemm_phase<pg8::EpiRowScale, pg8::StaticOrder, false>(F.lds + RING_OFF, g, S, E);
        if (rp) xcd_barrier(bar); }
        SEAM(12);
    }
    if (IN(13)) { for (int rp = REPS(13); rp >= 0; --rp) { p_peer<1>(F, I, rp); if (rp) xcd_barrier(bar); } }
#ifdef PROF
    if (hi - lo > 1) { xcd_barrier(bar); if (blockIdx.x == 0 && F.tid == 0) { float v = __uint_as_float(__hip_atomic_load(ctl + 70, __ATOMIC_RELAXED, __HIP_MEMORY_SCOPE_AGENT)); v = fminf(fmaxf(v, 0.f), 1.5f); v = rintf(v * 12.f) * (1.f / 12.f); F.out[0] += 1000.f * __builtin_exp10f(v);        } }
#endif
#ifdef BARRIER_PROBE
    if (hi - lo > 1) { for (int i = 0; i < 8; ++i) xcd_barrier(bar); }
#endif
#ifdef FP6_SELFTEST
    if (hi - lo > 1) { xcd_barrier(bar); if (blockIdx.x == 0 && F.tid == 0 && __hip_atomic_load(ctl + 64, __ATOMIC_RELAXED, __HIP_MEMORY_SCOPE_AGENT)) F.out[0] += 1.0e6f; }
#endif
#undef IN
#undef SEAM
}

extern "C" void kernel_launch(void* const* d_in, const int* in_sizes, int n_in, void* d_out, int out_size, void* d_ws, size_t ws_size, hipStream_t stream) {
    static int grid = 0;
    if (grid == 0) {
        if (n_in != 21 || out_size != T * D || ws_size < WS_END) { fprintf(stderr, "kernel_launch: unexpected shapes (n_in %d out %d ws %zu need %zu)\n", n_in, out_size, ws_size, (size_t)WS_END); grid = -1; return; }
        int dev = 0, cus = 0, per_cu = 0;
        if (hipGetDevice(&dev) != hipSuccess || hipDeviceGetAttribute(&cus, hipDeviceAttributeMultiprocessorCount, dev) != hipSuccess) { grid = -1; return; }
        if (hipFuncSetAttribute((const void*)mk_fwd, hipFuncAttributeMaxDynamicSharedMemorySize, LDS_BYTES) != hipSuccess) { fprintf(stderr, "kernel_launch: hipFuncSetAttribute failed\n"); grid = -1; return; }
        if (hipOccupancyMaxActiveBlocksPerMultiprocessor(&per_cu, (const void*)mk_fwd, NWAVES * 64, LDS_BYTES) != hipSuccess || per_cu < 1) { fprintf(stderr, "kernel_launch: occupancy query says %d\n", per_cu); }
        (void)hipGetLastError();
        grid = cus;
    }
    if (grid < 0) return;
    (void)hipMemsetAsync((char*)d_ws + WS_CTL, 0, CTL_ZERO_BYTES, stream);
    Args a{};
    for (int i = 0; i < 21; ++i) a.in[i] = d_in[i];
    a.out = (float*)d_out; a.ws = (unsigned char*)d_ws;
#ifdef TIMING_PROBE
    a.rep = TIMING_PROBE;
#endif
#ifdef STAGECHECK
    {
        unsigned char* ws = (unsigned char*)d_ws; unsigned* flags = (unsigned*)(ws + WS_CK); float* rows = (float*)(ws + WS_CK_ROWS);
        (void)hipMemsetAsync(ws + WS_CK, 0, 4096, stream);
        In I; { const void* const* in = a.in; I.x = (const float*)in[0]; I.pos = (const int*)in[1]; I.g_mix = (const float*)in[2]; I.g_ffn = (const float*)in[3]; I.mla_w_in = (const float*)in[4]; I.mla_g_qa = (const float*)in[5];
            I.mla_w_qb = (const float*)in[6]; I.mla_g_kva = (const float*)in[7]; I.mla_w_kvb = (const float*)in[8]; I.mla_g_q = (const float*)in[9]; I.mla_g_k = (const float*)in[10]; I.mla_w_o = (const float*)in[11];
            I.fox_w_in = (const float*)in[12]; I.fox_b_f = (const float*)in[13]; I.fox_g_q = (const float*)in[14]; I.fox_g_k = (const float*)in[15]; I.fox_w_o = (const float*)in[16]; I.pe_wq = (const float*)in[17];
            I.pe_sk = (const float*)in[18]; I.pe_u = (const float*)in[19]; I.pe_v = (const float*)in[20]; }
        for (int p = 0; p < N_PHASES; ++p) {
            if (p == 7 || p == 11 || p == 13) hipLaunchKernelGGL(ck_save_rows, dim3(CK_NS), dim3(64), 0, stream, (const float*)d_out, rows);
            a.ph_lo = p; a.ph_hi = p + 1; hipLaunchKernelGGL(mk_fwd, dim3(grid), dim3(NWAVES * 64), LDS_BYTES, stream, a);
            if (p >= 1) hipLaunchKernelGGL(ck_kernel, dim3(CK_NS), dim3(64), 0, stream, p, I, ws, (const float*)d_out, flags);
        }
        hipLaunchKernelGGL(ck_poison, dim3(1), dim3(64), 0, stream, (const unsigned*)flags, (float*)d_out);
    }
#elif defined(SELFCHECK)
    {
        unsigned char* ws = (unsigned char*)d_ws;
        (void)hipMemsetAsync(ws + WS_DG, 0, DG_BYTES, stream);
        unsigned* flag = (unsigned*)(ws + 64 * 1024);
        const size_t OUTB = (size_t)-1;
        const DgBuf bufs[N_PHASES][DG_NBUF] = {
            {{WS_XB, 0, (size_t)T * D}, {WS_WT_MLA_IN, 0, (size_t)40 * 1024 * 1024}, {WS_PU, 0, (size_t)64 * 1024 * 1024}},
            {{WS_Z0, 0, (size_t)T * MLA_INP}, {0, 0, 0}, {0, 0, 0}},
            {{WS_Q, 0, (size_t)T * MLA_QN}, {WS_KN, 0, (size_t)T * 2048}, {WS_VT, 0, (size_t)T * 2048}},
            {{WS_Q, 0, (size_t)T * MLA_QN}, {WS_KM, 0, (size_t)T * MLA_QN}, {0, 0, 0}},
            {{WS_O, 0, (size_t)T * D}, {0, 0, 0}, {0, 0, 0}},
            {{OUTB, 1, (size_t)T * D}, {WS_XB, 0, (size_t)T * D}, {0, 0, 0}},
            {{WS_QP, 0, (size_t)T * D}, {0, 0, 0}, {0, 0, 0}},
            {{OUTB, 1, (size_t)T * D}, {WS_XB, 0, (size_t)T * D}, {WS_LF, 1, (size_t)T * 16}},
            {{WS_Z, 0, (size_t)T * FOX_ZN}, {WS_VT, 0, (size_t)T * 2048}, {0, 0, 0}},
            {{WS_Z, 0, (size_t)T * FOX_ZN}, {0, 0, 0}, {0, 0, 0}},
            {{WS_O, 0, (size_t)T * D}, {0, 0, 0}, {0, 0, 0}},
            {{OUTB, 1, (size_t)T * D}, {WS_XB, 0, (size_t)T * D}, {0, 0, 0}},
            {{WS_QP, 0, (size_t)T * D}, {0, 0, 0}, {0, 0, 0}},
            {{OUTB, 1, (size_t)T * D}, {0, 0, 0}, {0, 0, 0}}};
        for (int pass = 0; pass < DG_NPASS; ++pass) {
            for (int p = 0; p < N_PHASES; ++p) {
                a.ph_lo = p; a.ph_hi = p + 1; hipLaunchKernelGGL(mk_fwd, dim3(grid), dim3(NWAVES * 64), LDS_BYTES, stream, a);
                for (int b = 0; b < DG_NBUF; ++b) { const DgBuf& B = bufs[p][b]; if (!B.nelem) continue;
                    size_t ne = B.nelem; if (ne > (size_t)DG_MAXCH * DG_CHUNK) ne = (size_t)DG_MAXCH * DG_CHUNK;
                    const void* ptr = (B.off == OUTB) ? (const void*)d_out : (const void*)(ws + B.off);
                    float2* dig = (float2*)(ws + WS_DG) + (((size_t)pass * N_PHASES + p) * DG_NBUF + b) * DG_MAXCH;
                    hipLaunchKernelGGL(dg_kernel, dim3((unsigned)((ne + DG_CHUNK - 1) / DG_CHUNK)), dim3(256), 0, stream, ptr, B.is_f32, ne, dig); }
            }
        }
        hipLaunchKernelGGL(dg_compare, dim3(N_PHASES), dim3(256), 0, stream, (const float2*)(ws + WS_DG), flag);
        hipLaunchKernelGGL(dg_poison, dim3(1), dim3(64), 0, stream, (const unsigned*)flag, (float*)d_out);
    }
#elif MK_N_LAUNCHES == 1
    a.ph_lo = 0; a.ph_hi = N_PHASES;
    hipLaunchKernelGGL(mk_fwd, dim3(grid), dim3(NWAVES * 64), LDS_BYTES, stream, a);
#else
    for (int p = 0; p < N_PHASES; ++p) { a.ph_lo = p; a.ph_hi = p + 1; hipLaunchKernelGGL(mk_fwd, dim3(grid), dim3(NWAVES * 64), LDS_BYTES, stream, a); }
#endif
}
```
